# Optimizing an MI355X kernel written in HIP

```python
import jax
import jax.numpy as jnp
from jax import lax
import numpy as np

D_MODEL = 1024
BATCH = 4
SEQ = 8192
DEPTH = 4

GRID_W = 64
CTX_LEN = 256
D_CONV = 512
N_CONV_GROUPS = 8
D_REC = 512
N_REC_HEADS = 8
REC_HEAD_DIM = D_REC // N_REC_HEADS
CONV_W = 3
REC_CONV_W = 4
LRU_C = 8.0
D_IN = 3 * D_CONV + 2 * D_REC
D_MIX = D_CONV + D_REC
F_DENSE = 2816
F_MOE = 3584
N_EXPERTS = 8
TOP_K = 2
EPS = 1e-6
N_DENSE = (DEPTH + 1) // 2
N_MOE = DEPTH // 2

kernel_name = "hybrid_conv_rglru_moe_dit"


def rmsnorm(x, g):
    x32 = x.astype(jnp.float32)
    y = x32 * lax.rsqrt(jnp.mean(x32 * x32, axis=-1, keepdims=True) + EPS)
    return (y * g.astype(jnp.float32)).astype(x.dtype)


def modulate(h, shift, scale):
    return h * (1 + scale) + shift


def shift_conv(u, w, axis, pad_left):
    k_w = w.shape[0]
    n = u.shape[axis]
    pad = [(0, 0)] * u.ndim
    pad[axis] = (pad_left, k_w - 1 - pad_left)
    up = jnp.pad(u, pad)
    out = w[0] * lax.slice_in_dim(up, 0, n, axis=axis)
    for k in range(1, k_w):
        out = out + w[k] * lax.slice_in_dim(up, k, k + n, axis=axis)
    return out


def split_proj(p):
    return jnp.split(p, [D_CONV, 2 * D_CONV, 3 * D_CONV, 3 * D_CONV + D_REC], axis=-1)


def short_conv_latent(u, w):
    b, n, ch = u.shape
    rows = n // GRID_W
    g = u.reshape(b, rows, GRID_W, ch)
    half = ch // 2
    horiz = shift_conv(g[..., :half], w[:, :half], axis=2, pad_left=1)
    vert = shift_conv(g[..., half:], w[:, half:], axis=1, pad_left=1)
    return jnp.concatenate([horiz, vert], axis=-1).reshape(b, n, ch)


def block_diag(x, w):
    b, t, _ = x.shape
    xh = x.reshape(b, t, N_REC_HEADS, REC_HEAD_DIM)
    return jnp.einsum("bthi,hij->bthj", xh, w).reshape(b, t, D_REC)


def lru_coeffs(xr, w_a, b_a, w_i, b_i, lam):
    f32 = jnp.float32
    x32 = xr.astype(f32)
    r = jax.nn.sigmoid(block_diag(x32, w_a.astype(f32)) + b_a.astype(f32))
    i = jax.nn.sigmoid(block_diag(x32, w_i.astype(f32)) + b_i.astype(f32))
    log_a = -LRU_C * r * jax.nn.softplus(-lam.astype(f32))
    a = jnp.exp(log_a)
    mult = jnp.sqrt(-jnp.expm1(2.0 * log_a))
    return a, mult * i * x32


def linear_scan(a, b, h0, reverse):
    if reverse:
        b = b.at[:, -1].add(a[:, -1] * h0)
    else:
        b = b.at[:, 0].add(a[:, 0] * h0)

    def combine(lft, rgt):
        return (lft[0] * rgt[0], rgt[0] * lft[1] + rgt[1])

    _, h = lax.associative_scan(combine, (a, b), reverse=reverse, axis=1)
    return h


def bidir_rglru(xr_c, xr_l, wa, ba, wi, bi, lam, need_ctx):
    zero = jnp.zeros((xr_c.shape[0], D_REC), jnp.float32)
    h_c_sum = None
    h_l_sum = None
    for d, rev in ((0, False), (1, True)):
        a, b = lru_coeffs(xr_c, wa[d], ba[d], wi[d], bi[d], lam[d])
        h_c = linear_scan(a, b, zero, rev)
        state = h_c[:, 0] if rev else h_c[:, -1]
        a, b = lru_coeffs(xr_l, wa[d], ba[d], wi[d], bi[d], lam[d])
        h_l = linear_scan(a, b, state, rev)
        h_l_sum = h_l if h_l_sum is None else h_l_sum + h_l
        if need_ctx:
            h_c_sum = h_c if h_c_sum is None else h_c_sum + h_c
    return h_c_sum, h_l_sum


def swiglu(h, wg, wu, wd):
    return (jax.nn.silu(h @ wg) * (h @ wu)) @ wd


def moe(h, router_w, router_b, wg, wu, wd):
    logits = (h @ router_w).astype(jnp.float32) + router_b.astype(jnp.float32)
    top_v, top_i = lax.top_k(logits, TOP_K)
    probs = jax.nn.softmax(top_v, axis=-1)
    gates = jnp.sum(jax.nn.one_hot(top_i, N_EXPERTS, dtype=jnp.float32) * probs[..., None], axis=-2)
    gates = gates.astype(h.dtype)
    y = jnp.zeros_like(h)
    for e in range(N_EXPERTS):
        y = y + gates[..., e:e + 1] * swiglu(h, wg[e], wu[e], wd[e])
    return y


def setup_inputs(seed: int = 0) -> dict:
    key = jax.random.key(seed)
    ks = iter(jax.random.split(key, 40))
    f32 = jnp.float32
    D = D_MODEL

    def nrm(shape, scale):
        return jax.random.normal(next(ks), shape, f32) * scale

    u = jax.random.uniform(next(ks), (DEPTH, 2, D_REC), f32, 0.9, 0.999)
    a0 = u ** (1.0 / LRU_C)
    lam = jnp.log(a0) - jnp.log1p(-a0)
    return {
        "x": nrm((BATCH, SEQ, D), 1.0),
        "c": nrm((BATCH, D), 1.0),
        "ctx": nrm((BATCH, CTX_LEN, D), 1.0),
        "c_ctx": nrm((D,), 1.0),
        "ada_w": nrm((DEPTH, D, 6 * D), 0.5 * D ** -0.5),
        "ada_b": nrm((DEPTH, 6 * D), 0.02),
        "norm_mix_g": 1.0 + nrm((DEPTH, D), 0.02),
        "norm_ffn_g": 1.0 + nrm((DEPTH, D), 0.02),
        "w_in": nrm((DEPTH, D, D_IN), D ** -0.5),
        "w_out": nrm((DEPTH, D_MIX, D), D_MIX ** -0.5),
        "conv_w": nrm((DEPTH, CONV_W, D_CONV), CONV_W ** -0.5),
        "rec_conv_w": nrm((DEPTH, REC_CONV_W, D_REC), REC_CONV_W ** -0.5),
        "rec_conv_b": nrm((DEPTH, D_REC), 0.02),
        "lru_wa": nrm((DEPTH, 2, N_REC_HEADS, REC_HEAD_DIM, REC_HEAD_DIM), REC_HEAD_DIM ** -0.5),
        "lru_ba": nrm((DEPTH, 2, D_REC), 0.02),
        "lru_wi": nrm((DEPTH, 2, N_REC_HEADS, REC_HEAD_DIM, REC_HEAD_DIM), REC_HEAD_DIM ** -0.5),
        "lru_bi": nrm((DEPTH, 2, D_REC), 0.02),
        "lru_lam": lam,
        "dense_wg": nrm((N_DENSE, D, F_DENSE), D ** -0.5),
        "dense_wu": nrm((N_DENSE, D, F_DENSE), D ** -0.5),
        "dense_wd": nrm((N_DENSE, F_DENSE, D), F_DENSE ** -0.5),
        "router_w": nrm((N_MOE, D, N_EXPERTS), D ** -0.5),
        "router_b": nrm((N_MOE, N_EXPERTS), 0.01),
        "moe_wg": nrm((N_MOE, N_EXPERTS, D, F_MOE), D ** -0.5),
        "moe_wu": nrm((N_MOE, N_EXPERTS, D, F_MOE), D ** -0.5),
        "moe_wd": nrm((N_MOE, N_EXPERTS, F_MOE, D), F_MOE ** -0.5),
        "final_g": 1.0 + nrm((D,), 0.02),
    }


def reference(x, c, ctx, c_ctx, ada_w, ada_b, norm_mix_g, norm_ffn_g, w_in, w_out, conv_w,
              rec_conv_w, rec_conv_b, lru_wa, lru_ba, lru_wi, lru_bi, lru_lam,
              dense_wg, dense_wu, dense_wd, router_w, router_b, moe_wg, moe_wu, moe_wd, final_g):
    rec_x_lo = 3 * D_CONV
    xl = x
    xc = ctx
    silu_c = jax.nn.silu(c)
    silu_cc = jax.nn.silu(c_ctx)

    for l in range(DEPTH):
        last = l == DEPTH - 1
        mod_l = silu_c @ ada_w[l] + ada_b[l]
        mod_c = silu_cc @ ada_w[l] + ada_b[l]
        shm_l, scm_l, gm_l, shf_l, scf_l, gf_l = [m[:, None] for m in jnp.split(mod_l, 6, axis=-1)]
        shm_c, scm_c, gm_c, shf_c, scf_c, gf_c = jnp.split(mod_c, 6, axis=-1)

        hl = modulate(rmsnorm(xl, norm_mix_g[l]), shm_l, scm_l)
        hc = modulate(rmsnorm(xc, norm_mix_g[l]), shm_c, scm_c)
        cb_l, cc_l, cv_l, rx_l, rg_l = split_proj(hl @ w_in[l])
        if last:
            rx_c = hc @ w_in[l][:, rec_x_lo:rec_x_lo + D_REC]
        else:
            cb_c, cc_c, cv_c, rx_c, rg_c = split_proj(hc @ w_in[l])

        xr_l = shift_conv(rx_l, rec_conv_w[l], axis=1, pad_left=2) + rec_conv_b[l]
        xr_c = shift_conv(rx_c, rec_conv_w[l], axis=1, pad_left=2) + rec_conv_b[l]
        h_c, h_l = bidir_rglru(xr_c, xr_l, lru_wa[l], lru_ba[l], lru_wi[l], lru_bi[l], lru_lam[l],
                               need_ctx=not last)

        conv_out_l = cb_l * short_conv_latent(cc_l * cv_l, conv_w[l])
        rec_out_l = h_l.astype(xl.dtype) * jax.nn.gelu(rg_l)
        out_l = jnp.concatenate([conv_out_l, rec_out_l], axis=-1) @ w_out[l]
        xl = xl + gm_l * out_l
        if not last:
            conv_out_c = cb_c * shift_conv(cc_c * cv_c, conv_w[l], axis=1, pad_left=1)
            rec_out_c = h_c.astype(xc.dtype) * jax.nn.gelu(rg_c)
            out_c = jnp.concatenate([conv_out_c, rec_out_c], axis=-1) @ w_out[l]
            xc = xc + gm_c * out_c

        def channel_mix(h):
            if l % 2 == 0:
                j = l // 2
                return swiglu(h, dense_wg[j], dense_wu[j], dense_wd[j])
            j = l // 2
            return moe(h, router_w[j], router_b[j], moe_wg[j], moe_wu[j], moe_wd[j])

        hl2 = modulate(rmsnorm(xl, norm_ffn_g[l]), shf_l, scf_l)
        xl = xl + gf_l * channel_mix(hl2)
        if not last:
            hc2 = modulate(rmsnorm(xc, norm_ffn_g[l]), shf_c, scf_c)
            xc = xc + gf_c * channel_mix(hc2)

    return rmsnorm(xl, final_g)
```

```cpp
#include <hip/hip_runtime.h>
#include <cstdio>
#include <cstdint>

#ifndef FAST_GEMM
#define FAST_GEMM 63
#endif
#ifndef FAST_SCAN
#define FAST_SCAN 1
#endif
#ifndef ALT_MOD
#define ALT_MOD 0
#endif
#ifndef REPEAT
#define REPEAT 0
#endif
#ifndef EPI2
#define EPI2 0
#endif
#ifndef STORE_AB
#define STORE_AB 1
#endif
#ifndef MOE_GATHER
#define MOE_GATHER 1
#endif
#ifndef WGM_DEEPK
#define WGM_DEEPK 2
#endif
#ifndef WGM_WIDE
#define WGM_WIDE 4
#endif
#ifndef PG8_SP2
#define PG8_SP2 1
#endif
#ifndef WGM_G1
#define WGM_G1 2
#endif
#ifndef WGM_G2
#define WGM_G2 4
#endif
#ifndef WGM_G4
#define WGM_G4 8
#endif
#ifndef MK_ONE_LAUNCH
#define MK_ONE_LAUNCH 1
#endif

constexpr int D = 1024, NB = 4, SEQ = 8192, CTXL = 256, ML = NB * SEQ, MC = NB * CTXL, M = ML + MC;
constexpr int DIN = 2560, PW = 2048, FD = 2816, FM = 3584, NE = 8, DEPTH = 4;
constexpr int DR = 512;
constexpr int NSLOT = 69632;
constexpr float EPS = 1e-6f;
constexpr int NWAVES = 8, NTHREADS = 512;
constexpr int ROWS_PER_WG = 132;

constexpr size_t MiB = 1u << 20;
constexpr size_t WS_CTL = 0, CTL_ZERO_BYTES = (REPEAT == 20 || REPEAT == 21) ? 256 * 1024 : 64 * 1024;
constexpr size_t WS_MOD = 1 * MiB;
constexpr size_t WS_LRUK = 1 * MiB + 512 * 1024;
constexpr size_t WS_INFO = 2 * MiB;
constexpr size_t WS_LIST = 5 * MiB;
constexpr size_t WS_AGG = 7 * MiB;
constexpr size_t WS_XC = 10 * MiB;
constexpr size_t WS_WGATE = 14 * MiB;
constexpr size_t WS_WIN = 15 * MiB;
constexpr size_t WS_WOUT = 35 * MiB;
constexpr size_t WS_WDGU = 43 * MiB;
constexpr size_t WS_WDD = 65 * MiB;
constexpr size_t WS_WMGU = 76 * MiB;
constexpr size_t WS_WMD = 188 * MiB;
constexpr size_t WS_HN = 244 * MiB;
constexpr size_t WS_Y = 310 * MiB;
constexpr size_t WS_BIG = 446 * MiB;
constexpr size_t WS_P = WS_BIG;
constexpr size_t WS_MIX = WS_BIG + 132 * MiB;
constexpr size_t WS_AB = WS_BIG + 198 * MiB;
constexpr size_t WS_XR = WS_BIG + 198 * MiB;
constexpr size_t WS_HF = WS_BIG + 264 * MiB;
constexpr size_t WS_HB = WS_BIG + 330 * MiB;
constexpr size_t WS_CAR = 922 * MiB;
constexpr size_t WS_XB = 924 * MiB;
constexpr size_t WS_END = 990 * MiB;
constexpr int CW_TMO = 0;
constexpr int CW_CNT = 1024;
constexpr int CW_BAR = 4096;

constexpr int LDS_BYTES = 147456;
constexpr int MISC_OFF = 131072 + 8192;

#define GAS __attribute__((address_space(1)))
#define LAS __attribute__((address_space(3)))
typedef unsigned short bf16;
typedef unsigned v4u __attribute__((ext_vector_type(4)));
typedef unsigned v2u __attribute__((ext_vector_type(2)));
typedef float f32x4 __attribute__((ext_vector_type(4)));
typedef short bf16x8 __attribute__((ext_vector_type(8)));
typedef GAS unsigned gu32;
#define RLX_AGENT __ATOMIC_RELAXED, __HIP_MEMORY_SCOPE_AGENT
#define LDS_WAIT() asm volatile("s_waitcnt lgkmcnt(0)" ::: "memory")
#define VM_WAIT() asm volatile("s_waitcnt vmcnt(0)" ::: "memory")
typedef float f32x2_t __attribute__((ext_vector_type(2)));
typedef __bf16 bf16x2_t __attribute__((ext_vector_type(2)));
__device__ __forceinline__ unsigned f2bf(float f) { return (unsigned)__builtin_bit_cast(unsigned short, (__bf16)f); }
__device__ __forceinline__ unsigned pk2(float lo, float hi) { const f32x2_t v = {lo, hi}; return __builtin_bit_cast(unsigned, __builtin_convertvector(v, bf16x2_t)); }
__device__ __forceinline__ float bf2f(unsigned b) { return __builtin_bit_cast(float, b << 16); }
__device__ __forceinline__ float bflo(unsigned w) { return __builtin_bit_cast(float, w << 16); }
__device__ __forceinline__ float bfhi(unsigned w) { return __builtin_bit_cast(float, w & 0xffff0000u); }
__device__ __forceinline__ float sigm(float x) { return __builtin_amdgcn_rcpf(1.f + __builtin_amdgcn_exp2f(-1.44269504089f * x)); }
__device__ __forceinline__ float sigm_p(float x) { return 1.0f / (1.0f + expf(-x)); }
__device__ __forceinline__ float silu_f(float x) { return x * sigm(x); }
__device__ __forceinline__ float gelu_tanh_f(float x) { return x * sigm(1.5957691216057308f * (x + 0.044715f * x * x * x)); }
__device__ __forceinline__ float wave_sum(float v) {
#pragma unroll
    for (int o = 1; o < 64; o <<= 1) v += __shfl_xor(v, o);
    return v;
}

#define XB_TMO      128
#define XB_XCNT(j)  (256  + 64 * (j))
#define XB_XSUB(j)  (1280 + 64 * (j))
#define XB_XGEN(j)  (2304 + 64 * (j))
#define XB_TOP      3328
#define XB_TOPGEN   3392
#define XCD_BAR_WORDS 3456
#define XB_SPIN_CAP (1u << 21)
__device__ __forceinline__ unsigned xb_ld(unsigned* p)              { return __hip_atomic_load(p, __ATOMIC_RELAXED, __HIP_MEMORY_SCOPE_AGENT); }
__device__ __forceinline__ unsigned xb_add(unsigned* p, unsigned v) { return __hip_atomic_fetch_add(p, v, __ATOMIC_RELAXED, __HIP_MEMORY_SCOPE_AGENT); }
__device__ __forceinline__ unsigned xb_xcc_id() { return (unsigned)__builtin_amdgcn_s_getreg((3 << 11) | 20) & 0xFu; }
#define XB_SPIN(cond, bar) do { unsigned _sp = 0; while (cond) { __builtin_amdgcn_s_sleep(1); \
    if ((++_sp & 255u) == 0u) { if (xb_ld(&(bar)[XB_TMO])) break; if (_sp > XB_SPIN_CAP) { atomicAdd(&(bar)[XB_TMO], 1u); break; } } } } while (0)
struct XcdBarrier { unsigned* bar; unsigned x; volatile LAS unsigned* st; };
__device__ __forceinline__ XcdBarrier xcd_barrier_post(unsigned* bar, volatile LAS unsigned* st) {
    XcdBarrier b; b.bar = bar; b.x = xb_xcc_id(); b.st = st;
    if (threadIdx.x == 0) (void)xb_add(&bar[XB_XCNT(b.x)], 1u);
    return b;
}
__device__ __forceinline__ void xcd_barrier_complete(unsigned* bar, unsigned x, unsigned& nloc, unsigned& nx) {
    const unsigned G = gridDim.x * gridDim.y * gridDim.z;
    unsigned sum, cnt, mine, sp = 0u;
    for (;;) {
        sum = 0u; cnt = 0u; mine = 0u;
#pragma unroll
        for (unsigned j = 0; j < 16; ++j) { const unsigned c = xb_ld(&bar[XB_XCNT(j)]); sum += c; cnt += (c > 0u) ? 1u : 0u; mine = (j == x) ? c : mine; }
        if (sum == G) break;
        __builtin_amdgcn_s_sleep(1);
        if ((++sp & 255u) == 0u) { if (xb_ld(&bar[XB_TMO])) break; if (sp > XB_SPIN_CAP) { atomicAdd(&bar[XB_TMO], 1u); break; } }
    }
    nloc = mine > 0u ? mine : 1u; nx = cnt > 0u ? cnt : 1u;
}
__device__ __forceinline__ void xcd_barrier(const XcdBarrier& b) {
    asm volatile("s_waitcnt vmcnt(0)" ::: "memory");
    __syncthreads();
    if (threadIdx.x == 0) {
        unsigned* bar = b.bar;
        __builtin_amdgcn_s_waitcnt(0);
        unsigned nloc = b.st[0], nx = b.st[1];
        if (nloc == 0u) { xcd_barrier_complete(bar, b.x, nloc, nx); b.st[0] = nloc; b.st[1] = nx; }
        const unsigned old = xb_add(&bar[XB_XSUB(b.x)], 1u);
        const unsigned gen = old / nloc;
        if (old + 1u == (gen + 1u) * nloc) {
            __builtin_amdgcn_fence(__ATOMIC_RELEASE, "agent");
            asm volatile("s_waitcnt vmcnt(0)" ::: "memory");
            const unsigned og = xb_add(&bar[XB_TOP], 1u);
            const unsigned tg = og / nx;
            if (og + 1u == (tg + 1u) * nx) xb_add(&bar[XB_TOPGEN], 1u);
            else XB_SPIN(xb_ld(&bar[XB_TOPGEN]) == tg, bar);
            __builtin_amdgcn_fence(__ATOMIC_ACQUIRE, "agent");
            xb_add(&bar[XB_XGEN(b.x)], 1u);
            asm volatile("s_waitcnt vmcnt(0)" ::: "memory");
        } else {
            XB_SPIN(xb_ld(&bar[XB_XGEN(b.x)]) == gen, bar);
            __builtin_amdgcn_fence(__ATOMIC_ACQUIRE, "agent");
            asm volatile("s_waitcnt vmcnt(0)" ::: "memory");
        }
    }
    __syncthreads();
}

enum { I_X = 0, I_C, I_CTX, I_CCTX, I_ADAW, I_ADAB, I_GMIX, I_GFFN, I_WIN, I_WOUT, I_CONVW, I_RCW, I_RCB, I_LWA, I_LBA, I_LWI, I_LBI, I_LAM,
       I_DWG, I_DWU, I_DWD, I_RW, I_RB, I_MWG, I_MWU, I_MWD, I_FG, N_IN };
struct Args { const float* in[N_IN]; float* out; unsigned char* ws; int ph_lo, ph_hi; };
struct Frame {
    LAS unsigned char* lds; volatile LAS unsigned* MISC; gu32* ctl;
    int tid, lane, wave, wave0, bid, G;
    GAS float* out_g; GAS unsigned char* ws_g;
};
constexpr int INTAB_OFF = MISC_OFF + 512;
__device__ __forceinline__ const float* in_ptr(const Frame& F, int i) { unsigned ad_ = (unsigned)(INTAB_OFF + 8 * i); asm volatile("" : "+v"(ad_));     const volatile LAS unsigned* t = (const volatile LAS unsigned*)(unsigned long)ad_; const unsigned lo = __builtin_amdgcn_readfirstlane(t[0]), hi = __builtin_amdgcn_readfirstlane(t[1]); return (const float*)(const GAS float*)(((unsigned long long)hi << 32) | lo); }
#define INP(i) in_ptr(F, (i))
#define WSP(T, off) ((T*)(F.ws_g + (off)))
#define F_MOD WSP(float, WS_MOD)
#define F_LRUK WSP(float, WS_LRUK)
#define F_INFO WSP(unsigned, WS_INFO)
#define F_LIST WSP(int, WS_LIST)
#define F_AGG WSP(float, WS_AGG)
#define F_XC WSP(float, WS_XC)
#define F_WGATE WSP(bf16, WS_WGATE)
#define F_WIN WSP(bf16, WS_WIN)
#define F_WOUT WSP(bf16, WS_WOUT)
#define F_WDGU WSP(bf16, WS_WDGU)
#define F_WDD WSP(bf16, WS_WDD)
#define F_WMGU WSP(bf16, WS_WMGU)
#define F_WMD WSP(bf16, WS_WMD)
#define F_HN WSP(bf16, WS_HN)
#define F_Y WSP(bf16, WS_Y)
#define F_HID WSP(bf16, WS_BIG)
#define F_P WSP(bf16, WS_P)
#define F_MIX WSP(bf16, WS_MIX)
#define F_XR WSP(float, WS_XR)
#define F_HF WSP(float, WS_HF)
#define F_HB WSP(float, WS_HB)
#define F_CAR WSP(float, WS_CAR)
#define F_AB WSP(unsigned, WS_AB)
#define F_XB WSP(bf16, WS_XB)

__device__ __forceinline__ void transpose_item(const float* W, int K, int N, bf16* WT, int k0, int n0, int dst_row0, LAS float* scr, int lane) {
    const int n4 = lane & 15, kr = lane >> 4;
    f32x4 v[16];
#pragma unroll
    for (int i = 0; i < 16; ++i) v[i] = *(const f32x4*)(W + (size_t)(k0 + 4 * i + kr) * N + n0 + 4 * n4);
#pragma unroll
    for (int i = 0; i < 16; ++i) { LAS float* p = scr + (4 * i + kr) * 65 + 4 * n4; p[0] = v[i].x; p[1] = v[i].y; p[2] = v[i].z; p[3] = v[i].w; }
    LDS_WAIT(); asm volatile("" ::: "memory");
    const int c = lane & 7, nn = lane >> 3;
#pragma unroll
    for (int j = 0; j < 8; ++j) { const int n = nn + 8 * j; const LAS float* s = scr + (8 * c) * 65 + n;
        v4u o; o.x = pk2(s[0 * 65], s[1 * 65]); o.y = pk2(s[2 * 65], s[3 * 65]); o.z = pk2(s[4 * 65], s[5 * 65]); o.w = pk2(s[6 * 65], s[7 * 65]);
        *(GAS v4u*)(WT + (size_t)(dst_row0 + n) * K + k0 + 8 * c) = o; }
    LDS_WAIT(); asm volatile("" ::: "memory");
}
__device__ __forceinline__ int map_win(int n) { if (n < 512) return n; if (n < 1024) { const int j = n - 512; return 512 + 256 * (j >> 7) + (j & 127); } if (n < 1536) { const int j = n - 1024; return 512 + 256 * (j >> 7) + 128 + (j & 127); } return n; }
__device__ __forceinline__ int map_g(int n) { return 256 * (n >> 7) + (n & 127); }
__device__ __forceinline__ int map_u(int n) { return 256 * (n >> 7) + 128 + (n & 127); }

__device__ __forceinline__ bool transpose_group(int& it, const float* src, int nmat, int K, int N, bf16* dst, size_t dst_mat_stride, int mapkind, LAS float* scr, int lane) {
    const int nkb = K / 64, nnb = N / 64, per = nkb * nnb, tot = nmat * per;
    if (it >= tot) { it -= tot; return false; }
    const int mi = it / per, r = it % per, kb = r / nnb, nb = r % nnb, n0 = 64 * nb;
    const int d0 = mapkind == 0 ? n0 : (mapkind == 1 ? map_win(n0) : (mapkind == 2 ? map_g(n0) : map_u(n0)));
    transpose_item(src + (size_t)mi * K * N, K, N, dst + (size_t)mi * dst_mat_stride, 64 * kb, n0, d0, scr, lane);
    return true;
}
constexpr int TAIL0_A = 4200, TAIL0_B = 7600, TAIL0_END = 11800, TAIL1_A = 12000, TAIL1_B = 16200, TAIL1_C = 19600;
constexpr int MOE_ITEMS = 3 * NE * (D / 64) * (FM / 64);
__device__ __forceinline__ void convert_moe_range(Frame& F, int j, int lo, int hi, int kblk, int nblk) {
    LAS float* scr = (LAS float*)(F.lds + F.wave * 16640);
    constexpr int I_GU = NE * (D / 64) * (FM / 64);
    for (int it0 = lo + kblk * NWAVES + F.wave; it0 < hi; it0 += nblk * NWAVES) {
        int it = it0;
        if (transpose_group(it, INP(I_MWG) + (size_t)j * NE * D * FM, NE, D, FM, F_WMGU, (size_t)2 * FM * D, 2, scr, F.lane)) continue;
        if (transpose_group(it, INP(I_MWU) + (size_t)j * NE * D * FM, NE, D, FM, F_WMGU, (size_t)2 * FM * D, 3, scr, F.lane)) continue;
        transpose_group(it, INP(I_MWD) + (size_t)j * NE * FM * D, NE, FM, D, F_WMD, (size_t)D * FM, 0, scr, F.lane);
    }
}
__device__ __forceinline__ void tail_convert(Frame& F, int nwg, int j, int lo, int hi) {
    const int rem = nwg % F.G;
    if (rem == 0) convert_moe_range(F, j, lo, hi, F.bid, F.G);
    else if (F.bid >= rem) convert_moe_range(F, j, lo, hi, F.bid - rem, F.G - rem);
}
__device__ __forceinline__ void p0_prologue(Frame& F) {
    LAS float* S5 = (LAS float*)(F.lds + 0);
    LAS float* RED = (LAS float*)(F.lds + 20480);
    for (int i = F.tid; i < 5 * D; i += NTHREADS) { const float v = i < 4 * D ? INP(I_C)[i] : INP(I_CCTX)[i - 4 * D]; S5[i] = silu_f(v); }
    __syncthreads();
    for (int item = F.bid; item < DEPTH * 24; item += F.G) {
        const int l = item / 24, strip = item % 24;
        const float* wp = INP(I_ADAW) + ((size_t)l * D + 128 * F.wave) * (6 * D) + strip * 256 + 4 * F.lane;
        f32x4 a0 = (f32x4){0.f, 0.f, 0.f, 0.f}, a1 = a0, a2 = a0, a3 = a0, a4 = a0;
        const LAS float* s = S5 + 128 * F.wave;
#pragma unroll 16
        for (int kk = 0; kk < 128; ++kk) { const f32x4 wv = *(const f32x4*)(wp + (size_t)kk * (6 * D));
            a0 = a0 + wv * s[kk]; a1 = a1 + wv * s[D + kk]; a2 = a2 + wv * s[2 * D + kk]; a3 = a3 + wv * s[3 * D + kk]; a4 = a4 + wv * s[4 * D + kk]; }
        LAS f32x4* rw = (LAS f32x4*)RED + F.wave * 320 + F.lane;
        rw[0] = a0; rw[64] = a1; rw[128] = a2; rw[192] = a3; rw[256] = a4;
        __syncthreads();
        if (F.tid < 320) { f32x4 t = (f32x4){0.f, 0.f, 0.f, 0.f};
#pragma unroll
            for (int w = 0; w < 8; ++w) t = t + ((const LAS f32x4*)RED)[w * 320 + F.tid];
            const int r = F.tid >> 6, col = strip * 256 + 4 * (F.tid & 63);
            *(f32x4*)(F_MOD + ((size_t)l * 5 + r) * (6 * D) + col) = t + *(const f32x4*)(INP(I_ADAB) + l * 6 * D + col); }
        __syncthreads();
    }
#if ALT_MOD
    for (int idx = F.bid * NTHREADS + F.tid; idx < DEPTH * 5 * 6 * D; idx += F.G * NTHREADS) {
        const int l = idx / (5 * 6 * D), r = (idx / (6 * D)) % 5, col = idx % (6 * D);
        const float* cv = r < 4 ? INP(I_C) + r * D : INP(I_CCTX); const float* aw = INP(I_ADAW) + (size_t)l * D * (6 * D) + col;
        float acc = INP(I_ADAB)[l * 6 * D + col];
        for (int k = 0; k < D; ++k) { const float x = cv[k]; acc += (x / (1.0f + expf(-x))) * aw[(size_t)k * (6 * D)]; }
        F_MOD[idx] = acc; }
#endif
    { const int g = F.bid * NTHREADS + F.tid; if (g < DEPTH * 2 * DR) { const float lam = INP(I_LAM)[g]; F_LRUK[g] = 8.0f * log1pf(expf(-lam)) * 1.44269504089f; } }
    __syncthreads();
    LAS float* scr = (LAS float*)(F.lds + F.wave * 16640);
    const int gw = F.bid * NWAVES + F.wave, NGW = F.G * NWAVES;
    constexpr int I_IN = DEPTH * (D / 64) * (DIN / 64), I_OUT = DEPTH * (D / 64) * (D / 64), I_DG = 2 * (D / 64) * (FD / 64), I_DD = 2 * (FD / 64) * (D / 64), I_LR = DEPTH * 2 * 8;
    constexpr int NIT = I_IN + I_OUT + 2 * I_DG + I_DD + 2 * I_LR;
    for (int it0 = gw; it0 < NIT; it0 += NGW) {
        int it = it0;
        if (transpose_group(it, INP(I_WIN), DEPTH, D, DIN, F_WIN, (size_t)DIN * D, 1, scr, F.lane)) continue;
        if (transpose_group(it, INP(I_WOUT), DEPTH, D, D, F_WOUT, (size_t)D * D, 0, scr, F.lane)) continue;
        if (transpose_group(it, INP(I_DWG), 2, D, FD, F_WDGU, (size_t)2 * FD * D, 2, scr, F.lane)) continue;
        if (transpose_group(it, INP(I_DWU), 2, D, FD, F_WDGU, (size_t)2 * FD * D, 3, scr, F.lane)) continue;
        if (transpose_group(it, INP(I_DWD), 2, FD, D, F_WDD, (size_t)D * FD, 0, scr, F.lane)) continue;
        if (transpose_group(it, INP(I_LWA), DEPTH * 2 * 8, 64, 64, F_WGATE, (size_t)2 * 64 * 64, 0, scr, F.lane)) continue;
        transpose_group(it, INP(I_LWI), DEPTH * 2 * 8, 64, 64, F_WGATE + 64 * 64, (size_t)2 * 64 * 64, 0, scr, F.lane);
    }
    convert_moe_range(F, 0, TAIL0_END, MOE_ITEMS, F.bid, F.G);
}

template <bool ROUTE>
__device__ __forceinline__ void n_phase(Frame& F, int l, int kind, int moe, bool first) {
    LAS float* RWl = (LAS float*)(F.lds + 0);
    LAS float* RT = (LAS float*)(F.lds + 32768);
    LAS int* RK = (LAS int*)(F.lds + 32768 + 4096);
    LAS int* BASE = (LAS int*)(F.lds + 32768 + 8192);
    if (ROUTE) { const float* rw = INP(I_RW) + (size_t)moe * D * NE; for (int i = F.tid; i < D * NE; i += NTHREADS) RWl[i] = rw[i]; }
    __syncthreads();
    const float* gvec = kind == 2 ? INP(I_FG) : (kind == 0 ? INP(I_GMIX) + l * D : INP(I_GFFN) + l * D);
    const float* xin = INP(I_X); const float* cin = INP(I_CTX); const bf16* XBb = F_XB; float* outp = (float*)F.out_g;
    f32x4 mul[4], add[4], vn[4]; v2u vb[4];
    int cur_bb = -1; bool have_vn = false;
    const int row_base = F.bid * ROWS_PER_WG;
    for (int i = F.wave; i < ROWS_PER_WG; i += NWAVES) {
        const int r = row_base + i; const bool lat = r < ML;
        if (kind == 2 && !lat) { have_vn = false; continue; }
        if (ROUTE && l == DEPTH - 1 && !lat) {
            if (F.lane == 0) { int m1 = -1; asm volatile("" : "+v"(m1)); RT[i * 4 + 0] = __builtin_bit_cast(float, m1); RT[i * 4 + 1] = __builtin_bit_cast(float, m1); } have_vn = false; continue; }
        const int bb = lat ? (r >> 13) : 4;
        if (bb != cur_bb) { cur_bb = bb;
#pragma unroll
            for (int j = 0; j < 4; ++j) { const int col = 4 * F.lane + 256 * j; const f32x4 g = *(const f32x4*)(gvec + col);
                if (kind == 2) { mul[j] = g; add[j] = (f32x4){0.f, 0.f, 0.f, 0.f}; }
                else { const float* mp = F_MOD + ((size_t)l * 5 + bb) * (6 * D) + (kind == 0 ? 0 : 3) * D; const f32x4 sh = *(const f32x4*)(mp + col), sc = *(const f32x4*)(mp + D + col);
                    mul[j] = g * (sc + 1.0f); add[j] = sh; } } }
        f32x4 v[4];
        if (!have_vn) {
            if (first) { const float* xs = lat ? xin + (size_t)r * D : cin + (size_t)(r - ML) * D;
#pragma unroll
                for (int j = 0; j < 4; ++j) v[j] = *(const f32x4*)(xs + 4 * F.lane + 256 * j); }
            else {
#pragma unroll
                for (int j = 0; j < 4; ++j) { const v2u w = *(const v2u*)(XBb + (size_t)r * D + 4 * F.lane + 256 * j); v[j] = (f32x4){bflo(w.x), bfhi(w.x), bflo(w.y), bfhi(w.y)}; } } }
        else if (first) {
#pragma unroll
            for (int j = 0; j < 4; ++j) v[j] = vn[j]; }
        else {
#pragma unroll
            for (int j = 0; j < 4; ++j) v[j] = (f32x4){bflo(vb[j].x), bfhi(vb[j].x), bflo(vb[j].y), bfhi(vb[j].y)}; }
        { const int i2 = i + NWAVES, r2 = row_base + i2; have_vn = (i2 < ROWS_PER_WG) && !((kind == 2 || (ROUTE && l == DEPTH - 1)) && r2 >= ML);
          if (have_vn) {
              if (first) { const float* xs2 = r2 < ML ? xin + (size_t)r2 * D : cin + (size_t)(r2 - ML) * D;
#pragma unroll
                  for (int j = 0; j < 4; ++j) vn[j] = *(const f32x4*)(xs2 + 4 * F.lane + 256 * j); }
              else {
#pragma unroll
                  for (int j = 0; j < 4; ++j) vb[j] = *(const v2u*)(XBb + (size_t)r2 * D + 4 * F.lane + 256 * j); } } }
        float ss = 0.f;
#pragma unroll
        for (int j = 0; j < 4; ++j) ss += (v[j].x * v[j].x + v[j].y * v[j].y) + (v[j].z * v[j].z + v[j].w * v[j].w);
        const float rstd = 1.0f / sqrtf(wave_sum(ss) * (1.0f / D) + EPS);
        f32x4 hv[4];
#pragma unroll
        for (int j = 0; j < 4; ++j) hv[j] = v[j] * rstd * mul[j] + add[j];
        if (kind == 2) {
#pragma unroll
            for (int j = 0; j < 4; ++j) *(f32x4*)(outp + (size_t)r * D + 4 * F.lane + 256 * j) = hv[j];
        } else {
            bf16* hr = F_HN + (size_t)r * D;
#pragma unroll
            for (int j = 0; j < 4; ++j) { v2u o; o.x = pk2(hv[j].x, hv[j].y); o.y = pk2(hv[j].z, hv[j].w); *(v2u*)(hr + 4 * F.lane + 256 * j) = o; }
        }
        if (ROUTE) {
            float lg[8];
#pragma unroll
            for (int e = 0; e < 8; ++e) lg[e] = 0.f;
#pragma unroll
            for (int j = 0; j < 4; ++j)
#pragma unroll
                for (int q = 0; q < 4; ++q) { const float hx = hv[j][q]; const LAS f32x4* rp = (const LAS f32x4*)(RWl + (4 * F.lane + 256 * j + q) * 8); const f32x4 w0 = rp[0], w1 = rp[1];
                    lg[0] += hx * w0.x; lg[1] += hx * w0.y; lg[2] += hx * w0.z; lg[3] += hx * w0.w; lg[4] += hx * w1.x; lg[5] += hx * w1.y; lg[6] += hx * w1.z; lg[7] += hx * w1.w; }
#pragma unroll
            for (int e = 0; e < 8; ++e) lg[e] = wave_sum(lg[e]) + INP(I_RB)[moe * NE + e];
            int e1 = 0; float v1 = lg[0];
#pragma unroll
            for (int e = 1; e < 8; ++e) if (lg[e] > v1) { v1 = lg[e]; e1 = e; }
            int e2 = -1; float v2 = -3.0e38f;
#pragma unroll
            for (int e = 0; e < 8; ++e) if (e != e1 && lg[e] > v2) { v2 = lg[e]; e2 = e; }
            const float g1 = sigm(v1 - v2), g2 = 1.0f - g1;
            if (F.lane == 0) { RT[i * 4 + 0] = __builtin_bit_cast(float, e1); RT[i * 4 + 1] = __builtin_bit_cast(float, e2); RT[i * 4 + 2] = g1; RT[i * 4 + 3] = g2; }
        }
    }
    if (ROUTE) {
        __syncthreads();
        if (F.tid < NE) { const int e = F.tid; int c = 0;
            for (int i = 0; i < ROWS_PER_WG; ++i) { const int a = __builtin_bit_cast(int, RT[i * 4 + 0]), b = __builtin_bit_cast(int, RT[i * 4 + 1]);
                if (a == e) { RK[i * 2 + 0] = c; ++c; } if (b == e) { RK[i * 2 + 1] = c; ++c; } }
            BASE[e] = (int)__hip_atomic_fetch_add(F.ctl + CW_CNT + moe * 512 + e * 64, (unsigned)c, RLX_AGENT); }
        __syncthreads();
        if (F.tid < ROWS_PER_WG) { const int i = F.tid, r = row_base + i;
            const int e1 = __builtin_bit_cast(int, RT[i * 4 + 0]), e2 = __builtin_bit_cast(int, RT[i * 4 + 1]);
            if (e1 >= 0) {
            const int r1 = BASE[e1] + RK[i * 2 + 0], r2 = BASE[e2] + RK[i * 2 + 1];
            unsigned* inf = F_INFO + ((size_t)moe * M + r) * 8;
            v4u o0; o0.x = (unsigned)e1; o0.y = (unsigned)r1; o0.z = (unsigned)e2; o0.w = (unsigned)r2; *(v4u*)inf = o0;
            v4u o1; o1.x = __builtin_bit_cast(unsigned, RT[i * 4 + 2]); o1.y = __builtin_bit_cast(unsigned, RT[i * 4 + 3]); o1.z = 0u; o1.w = 0u; *(v4u*)(inf + 4) = o1;
            F_LIST[(size_t)e1 * M + r1] = r; F_LIST[(size_t)e2 * M + r2] = r; } }
    }
    __syncthreads();
}

struct NG { const bf16* A; int lda; const int* ridx; int nvalid; int arow0; const bf16* Bt; int K; int nrows, ncols, pcol0; int pair, mode;
            bf16* O; int ldo, orow0, ocol0; const float* xl_src; const float* xc_src; const float* gate; };
__device__ __forceinline__ void gemm_naive(Frame& F, const NG& g) {
    const int ntm = g.nrows / 32, ntn = g.ncols / 32, nt = ntm * ntn;
    const int lr = F.lane & 15, lq = F.lane >> 4;
    for (int t = F.bid * NWAVES + F.wave; t < nt; t += F.G * NWAVES) {
        const int tm = t / ntn, tn = t % ntn;
        const bf16* ap[2]; const bf16* bp[2]; const bf16* bp2[2];
#pragma unroll
        for (int mi = 0; mi < 2; ++mi) { const int i = 32 * tm + 16 * mi + lr; const size_t ar = g.ridx ? (size_t)g.ridx[i < g.nvalid ? i : 0] : (size_t)(g.arow0 + i); ap[mi] = g.A + ar * g.lda + 8 * lq; }
#pragma unroll
        for (int ni = 0; ni < 2; ++ni) { const int j = 32 * tn + 16 * ni + lr; const int pc = g.pair ? g.pcol0 + 256 * (j >> 7) + (j & 127) : g.pcol0 + j;
            bp[ni] = g.Bt + (size_t)pc * g.K + 8 * lq; bp2[ni] = bp[ni] + (size_t)128 * g.K; }
        f32x4 acc[2][2], acc2[2][2];
#pragma unroll
        for (int mi = 0; mi < 2; ++mi)
#pragma unroll
            for (int ni = 0; ni < 2; ++ni) { acc[mi][ni] = (f32x4){0.f, 0.f, 0.f, 0.f}; acc2[mi][ni] = (f32x4){0.f, 0.f, 0.f, 0.f}; }
        for (int k0 = 0; k0 < g.K; k0 += 32) {
            bf16x8 a[2], b[2], b2[2];
#pragma unroll
            for (int mi = 0; mi < 2; ++mi) a[mi] = *(const bf16x8*)(ap[mi] + k0);
#pragma unroll
            for (int ni = 0; ni < 2; ++ni) { b[ni] = *(const bf16x8*)(bp[ni] + k0); if (g.pair) b2[ni] = *(const bf16x8*)(bp2[ni] + k0); else b2[ni] = b[ni]; }
#pragma unroll
            for (int mi = 0; mi < 2; ++mi)
#pragma unroll
                for (int ni = 0; ni < 2; ++ni) { acc[mi][ni] = __builtin_amdgcn_mfma_f32_16x16x32_bf16(a[mi], b[ni], acc[mi][ni], 0, 0, 0);
                    if (g.pair) acc2[mi][ni] = __builtin_amdgcn_mfma_f32_16x16x32_bf16(a[mi], b2[ni], acc2[mi][ni], 0, 0, 0); }
        }
#pragma unroll
        for (int mi = 0; mi < 2; ++mi)
#pragma unroll
            for (int ni = 0; ni < 2; ++ni)
#pragma unroll
                for (int q = 0; q < 4; ++q) {
                    const int i = 32 * tm + 16 * mi + 4 * lq + q, j = 32 * tn + 16 * ni + lr; const float v = acc[mi][ni][q], u = acc2[mi][ni][q];
                    const int row = g.orow0 + i;
                    if (g.mode == 4) { const bool lat = row < ML; const int bb = lat ? (row >> 13) : 4;
                        const float* xs = lat ? g.xl_src + (size_t)row * D : g.xc_src + (size_t)(row - ML) * D; float* xd = lat ? ((float*)F.out_g) + (size_t)row * D : F_XC + (size_t)(row - ML) * D;
                        xd[j] = xs[j] + g.gate[(size_t)bb * (6 * D) + j] * v; }
                    else { float o = v; if (g.mode == 1) o = gelu_tanh_f(v); else if (g.mode == 2) o = v * u; else if (g.mode == 3) o = silu_f(v) * u;
                        g.O[(size_t)row * g.ldo + g.ocol0 + j] = (bf16)f2bf(o); }
                }
    }
}

namespace pg8 {
constexpr int BM = 256, BK = 64, HALF = 128, HTB = HALF * BK * 2, NXCD = 8, WGM = 4;
__device__ __forceinline__ int lds_byte(int r, int c) { const int st = (r >> 4) * 2 + (c >> 5), rr = r & 15, cc = c & 31, ob = rr * 64 + cc * 2; return st * 1024 + (ob ^ (((ob >> 9) & 1) << 5)); }
__device__ __forceinline__ void stage_rc(int b, int& R, int& C) { const int st = b / 1024, sb = b % 1024, swz = sb ^ (((sb >> 9) & 1) << 5); R = (st >> 1) * 16 + swz / 64; C = (st & 1) * 32 + (swz % 64) / 2; }
__device__ __forceinline__ int perm32(int rho) { const int n = rho >> 4, i = rho & 15; return 8 * (i >> 2) + 4 * n + (i & 3); }
struct Unit { int pm, pn, orow0, e; };
struct TileOrder {
    int nM, nN, nwg, G, c, wgm;
    __device__ void init(int nM_, int nN_, int G_, int c_, int wgm_ = WGM) { nM = nM_; nN = nN_; nwg = nM * nN; G = G_; c = c_; wgm = wgm_; }
    __device__ bool next(int i, int& pm, int& pn) const {
        const long L = (long)i * G + c; if (L >= nwg) return false;
        int wgid = (int)L; { const int q = nwg / NXCD, r = nwg % NXCD, xcd = wgid % NXCD, off = wgid / NXCD; wgid = (xcd < r ? xcd * (q + 1) : r * (q + 1) + (xcd - r) * q) + off; }
        const int nig = wgm * nN, gid = wgid / nig, fm = gid * wgm, gsz = (nM - fm) < wgm ? (nM - fm) : wgm;
        pm = fm + ((wgid % nig) % gsz); pn = (wgid % nig) / gsz; return true;
    }
};
__device__ __forceinline__ unsigned cvt_pk_bf16(float lo, float hi) { unsigned r; asm volatile("v_cvt_pk_bf16_f32 %0, %1, %2" : "=v"(r) : "v"(lo), "v"(hi)); return r; }

struct ProbDense {
    static constexpr bool GATHER = false;
    const bf16* A; const bf16* Bt; int K; TileOrder ord;
    __device__ __forceinline__ bool next(int i, Unit& u) const { if (!ord.next(i, u.pm, u.pn)) return false; u.orow0 = u.pm * BM; u.e = 0; return true; }
    __device__ __forceinline__ const char* a_base(const Unit& u) const { return (const char*)A + (size_t)u.pm * BM * K * 2; }
    __device__ __forceinline__ const char* b_base(const Unit& u) const { return (const char*)Bt + (size_t)u.pn * BM * K * 2; }
    __device__ __forceinline__ unsigned row_index(const Unit&, int) const { return 0u; }
};
struct ProbMoe {
    const bf16* A; const bf16* Bt; const int* list; const LAS int* tab_; int K; int bt_rows; bool up; TileOrder ord;
    __device__ __forceinline__ bool next(int i, Unit& u) const {
        if (!ord.next(i, u.pm, u.pn)) return false;
        unsigned ta_ = (unsigned)(unsigned long)tab_; asm volatile("" : "+v"(ta_)); const LAS int* tab = (const LAS int*)(unsigned long)ta_;
        int e = 0;
#pragma unroll
        for (int q = 1; q < NE; ++q) e += (u.pm >= __builtin_amdgcn_readfirstlane(tab[q])) ? 1 : 0;
        u.e = e; u.orow0 = __builtin_amdgcn_readfirstlane(tab[32 + e]) + (u.pm - __builtin_amdgcn_readfirstlane(tab[e])) * BM; return true; }
    __device__ __forceinline__ const char* a_base(const Unit& u) const { return up ? (const char*)A : (const char*)A + (size_t)u.orow0 * K * 2; }
    __device__ __forceinline__ const char* b_base(const Unit& u) const { return (const char*)Bt + ((size_t)u.e * bt_rows + (size_t)u.pn * BM) * K * 2; }
    __device__ __forceinline__ unsigned row_index(const Unit& u, int lr) const {
        unsigned ta_ = (unsigned)(unsigned long)tab_; asm volatile("" : "+v"(ta_)); const LAS int* tab = (const LAS int*)(unsigned long)ta_;
        const int loc = (u.pm - __builtin_amdgcn_readfirstlane(tab[u.e])) * BM + lr; const int c = __builtin_amdgcn_readfirstlane(tab[16 + u.e]); return (unsigned)list[(size_t)u.e * M + (loc < c ? loc : 0)]; }
};
template <bool G> struct ProbMoeT : ProbMoe { static constexpr bool GATHER = G; };

struct EpiP {
    static constexpr bool PERM = true;
    bf16* P;
    __device__ __forceinline__ void operator()(const f32x4 (&acc)[2][2][4][2], const Unit& u, int wr, int wc, int fr, int fq) const {
        int ld = PW; asm volatile("" : "+s"(ld));
        const int pn = u.pn; const unsigned loff = (unsigned)(fr * ld + 8 * fq) * 2u;
        char* base = (char*)(P + (size_t)(u.orow0 + wr * 64) * ld + wc * 32);
#pragma unroll
        for (int ai = 0; ai < 2; ++ai)
#pragma unroll
            for (int m = 0; m < 4; ++m) { char* rowb = base + (size_t)((ai * HALF + m * 16) * ld) * 2;
                if (pn >= 2 && pn < 6) { const f32x4 a0 = acc[ai][0][m][0] * acc[ai][1][m][0], a1 = acc[ai][0][m][1] * acc[ai][1][m][1];
                    v4u w; w.x = cvt_pk_bf16(a0[0], a0[1]); w.y = cvt_pk_bf16(a0[2], a0[3]); w.z = cvt_pk_bf16(a1[0], a1[1]); w.w = cvt_pk_bf16(a1[2], a1[3]);
                    *(v4u*)(rowb + (size_t)(512 + 128 * (pn - 2)) * 2 + loff) = w; }
                else { const int cbase = (pn < 2) ? 256 * pn : 256 * pn - 512;
#pragma unroll
                    for (int bj = 0; bj < 2; ++bj) { f32x4 v0 = acc[ai][bj][m][0], v1 = acc[ai][bj][m][1];
                        if (pn >= 8) {
#pragma unroll
                            for (int q = 0; q < 4; ++q) { v0[q] = gelu_tanh_f(v0[q]); v1[q] = gelu_tanh_f(v1[q]); } }
                        v4u w; w.x = cvt_pk_bf16(v0[0], v0[1]); w.y = cvt_pk_bf16(v0[2], v0[3]); w.z = cvt_pk_bf16(v1[0], v1[1]); w.w = cvt_pk_bf16(v1[2], v1[3]);
                        *(v4u*)(rowb + (size_t)(cbase + bj * HALF) * 2 + loff) = w; } }
            }
    }
};
struct EpiGLU {
    static constexpr bool PERM = true;
    bf16* O; int ldo;
    __device__ __forceinline__ void operator()(const f32x4 (&acc)[2][2][4][2], const Unit& u, int wr, int wc, int fr, int fq) const {
        int ld = ldo; asm volatile("" : "+s"(ld));
        const unsigned loff = (unsigned)(fr * ld + 8 * fq) * 2u;
        char* base = (char*)(O + (size_t)(u.orow0 + wr * 64) * ld + 128 * u.pn + wc * 32);
#pragma unroll
        for (int ai = 0; ai < 2; ++ai)
#pragma unroll
            for (int m = 0; m < 4; ++m) { char* rowb = base + (size_t)((ai * HALF + m * 16) * ld) * 2;
                f32x4 a0, a1;
#pragma unroll
                for (int q = 0; q < 4; ++q) { a0[q] = silu_f(acc[ai][0][m][0][q]) * acc[ai][1][m][0][q]; a1[q] = silu_f(acc[ai][0][m][1][q]) * acc[ai][1][m][1][q]; }
                v4u w; w.x = cvt_pk_bf16(a0[0], a0[1]); w.y = cvt_pk_bf16(a0[2], a0[3]); w.z = cvt_pk_bf16(a1[0], a1[1]); w.w = cvt_pk_bf16(a1[2], a1[3]);
                *(v4u*)(rowb + loff) = w; }
    }
};
struct EpiBf {
    static constexpr bool PERM = true;
    bf16* O; int ldo;
    __device__ __forceinline__ void operator()(const f32x4 (&acc)[2][2][4][2], const Unit& u, int wr, int wc, int fr, int fq) const {
        int ld = ldo; asm volatile("" : "+s"(ld));
        const unsigned loff = (unsigned)(fr * ld + 8 * fq) * 2u;
        char* base = (char*)(O + (size_t)(u.orow0 + wr * 64) * ld + 256 * u.pn + wc * 32);
#pragma unroll
        for (int ai = 0; ai < 2; ++ai)
#pragma unroll
            for (int m = 0; m < 4; ++m) { char* rowb = base + (size_t)((ai * HALF + m * 16) * ld) * 2;
#pragma unroll
                for (int bj = 0; bj < 2; ++bj) { const f32x4 v0 = acc[ai][bj][m][0], v1 = acc[ai][bj][m][1];
                    v4u w; w.x = cvt_pk_bf16(v0[0], v0[1]); w.y = cvt_pk_bf16(v0[2], v0[3]); w.z = cvt_pk_bf16(v1[0], v1[1]); w.w = cvt_pk_bf16(v1[2], v1[3]);
                    *(v4u*)(rowb + (size_t)(bj * HALF) * 2 + loff) = w; } }
    }
};
template <bool SRCF32> struct EpiRes {
    static constexpr bool PERM = true;
    const float* xf; bf16* XB; const float* gate;
    __device__ __forceinline__ void operator()(const f32x4 (&acc)[2][2][4][2], const Unit& u, int wr, int wc, int fr, int fq) const {
        int ld = D; asm volatile("" : "+s"(ld));
        const int bb = u.orow0 >> 13; const size_t e0u = (size_t)(u.orow0 + wr * 64) * ld + u.pn * BM + wc * 32; const unsigned lofe = (unsigned)(fr * ld + 8 * fq);
        const float* gp = gate + (size_t)bb * (6 * D) + u.pn * BM + wc * 32 + 8 * fq;
        f32x4 gv[2][2];
#pragma unroll
        for (int bj = 0; bj < 2; ++bj)
#pragma unroll
            for (int n = 0; n < 2; ++n) gv[bj][n] = *(const f32x4*)(gp + bj * HALF + 4 * n);
#pragma unroll
        for (int ai = 0; ai < 2; ++ai)
#pragma unroll
            for (int m = 0; m < 4; ++m) { const size_t rou = e0u + (size_t)((ai * HALF + m * 16) * ld);
#pragma unroll
                for (int bj = 0; bj < 2; ++bj) { f32x4 x0, x1; bf16* xbp = (bf16*)((char*)(XB + rou + bj * HALF) + (size_t)(lofe * 2u));
                    if (SRCF32) { const float* xfp = (const float*)((const char*)(xf + rou + bj * HALF) + (size_t)(lofe * 4u)); x0 = *(const f32x4*)xfp; x1 = *(const f32x4*)(xfp + 4); }
                    else { const v4u w = *(const v4u*)xbp; x0 = (f32x4){bflo(w.x), bfhi(w.x), bflo(w.y), bfhi(w.y)}; x1 = (f32x4){bflo(w.z), bfhi(w.z), bflo(w.w), bfhi(w.w)}; }
                    const f32x4 v0 = x0 + gv[bj][0] * acc[ai][bj][m][0], v1 = x1 + gv[bj][1] * acc[ai][bj][m][1];
                    v4u o; o.x = cvt_pk_bf16(v0[0], v0[1]); o.y = cvt_pk_bf16(v0[2], v0[3]); o.z = cvt_pk_bf16(v1[0], v1[1]); o.w = cvt_pk_bf16(v1[2], v1[3]);
                    *(v4u*)xbp = o; } }
    }
};

template <class Prob, class Epi>
__device__ __forceinline__ void gemm_phase(LAS unsigned char* lds, const Prob& S, const Epi& E, int tid_in) {
    int tid_ = tid_in; asm volatile("" : "+v"(tid_));
    const int tid = tid_, wid = __builtin_amdgcn_readfirstlane(tid >> 6), lane = tid & 63, wr = wid >> 2, wc = wid & 3, fr = lane & 15, fq = lane >> 4;
    const int K = S.K, nt = K / BK;
    unsigned voffB[2], vA0[2], vA1[2];
#pragma unroll
    for (int i = 0; i < 2; ++i) { int R, C; stage_rc(tid * 16 + i * 8192, R, C); const int Rb = Epi::PERM ? ((R & ~31) + perm32(R & 31)) : R; voffB[i] = (unsigned)(Rb * K + C) * 2u; vA0[i] = (unsigned)(R * K + C) * 2u; vA1[i] = vA0[i]; }
    const size_t kstep = (size_t)(BK * 2);
    const size_t hstep = (size_t)HALF * K * 2;
    const unsigned ldsw = (unsigned)wid * 1024u;
    const int aoff = lds_byte(wr * 64 + fr, fq * 8), boff = lds_byte(wc * 32 + fr, fq * 8);
#define PG8_SA(b, h) (((b) * 2 + (h)) * HTB)
#define PG8_SB(b, h) ((4 + (b) * 2 + (h)) * HTB)
#define PG8_STAGE(bufoff, gbase, voff) do { _Pragma("unroll") for (int _i = 0; _i < 2; ++_i) \
        __builtin_amdgcn_global_load_lds((const unsigned*)((const char*)(gbase) + (voff)[_i]), (LAS unsigned*)(lds + (bufoff) + ldsw + _i * 8192), 16, 0, 0); } while (0)
#define PG8_STAGE_A(bufoff, gbase, h) do { if constexpr (Prob::GATHER) { if (h) PG8_STAGE(bufoff, gbase, vA1); else PG8_STAGE(bufoff, gbase, vA0); } else PG8_STAGE(bufoff, (gbase) + (h) * hstep, vA0); } while (0)
#define PG8_LDA(dst, b, h) do { _Pragma("unroll") for (int m = 0; m < 4; ++m) _Pragma("unroll") for (int k = 0; k < 2; ++k) dst[m][k] = *(const LAS bf16x8*)(lds + PG8_SA(b, h) + aoff + m * 2048 + k * 1024); } while (0)
#define PG8_LDB(dst, b, h) do { _Pragma("unroll") for (int n = 0; n < 2; ++n) _Pragma("unroll") for (int k = 0; k < 2; ++k) dst[n][k] = *(const LAS bf16x8*)(lds + PG8_SB(b, h) + boff + n * 2048 + k * 1024); } while (0)
#define PG8_MMA(ai, bj, At, Bt) do { __builtin_amdgcn_s_setprio(1); _Pragma("unroll") for (int m = 0; m < 4; ++m) _Pragma("unroll") for (int n = 0; n < 2; ++n) _Pragma("unroll") for (int k = 0; k < 2; ++k) \
        acc[ai][bj][m][n] = __builtin_amdgcn_mfma_f32_16x16x32_bf16(Bt[n][k], At[m][k], acc[ai][bj][m][n], 0, 0, 0); __builtin_amdgcn_s_setprio(0); } while (0)
#define PG8_WAIT_V(n) asm volatile("s_waitcnt vmcnt(" #n ")" ::: "memory")
#define PG8_WAIT_L(n) asm volatile("s_waitcnt lgkmcnt(" #n ")" ::: "memory")
#define PG8_BAR __builtin_amdgcn_s_barrier()
#define PG8_SCHED __builtin_amdgcn_sched_barrier(0)
#define PG8_GATHER_VOFF2(u, d0, d1) do { _Pragma("unroll") for (int _i = 0; _i < 2; ++_i) { int R_, C_; stage_rc(tid * 16 + _i * 8192, R_, C_); \
        d0[_i] = (S.row_index(u, R_) * (unsigned)K + (unsigned)C_) * 2u; asm volatile("" : "+v"(d0[_i]) :: "memory"); } \
        _Pragma("unroll") for (int _i = 0; _i < 2; ++_i) { int R_, C_; stage_rc(tid * 16 + _i * 8192, R_, C_); \
        d1[_i] = (S.row_index(u, HALF + R_) * (unsigned)K + (unsigned)C_) * 2u; asm volatile("" : "+v"(d1[_i]) :: "memory"); } } while (0)
#define PG8_GATHER_VOFF(u) PG8_GATHER_VOFF2(u, vA0, vA1)
    Unit cur, nxt; int ui = 0;
    if (!S.next(0, cur)) return;
    f32x4 acc[2][2][4][2];
#pragma unroll
    for (int a = 0; a < 2; ++a)
#pragma unroll
        for (int b = 0; b < 2; ++b)
#pragma unroll
            for (int m = 0; m < 4; ++m)
#pragma unroll
                for (int n = 0; n < 2; ++n) acc[a][b][m][n] = (f32x4){0.f, 0.f, 0.f, 0.f};
    bf16x8 At[4][2], B0[2][2], B1[2][2];
    const char* cA = S.a_base(cur); const char* cB = S.b_base(cur);
    if constexpr (Prob::GATHER) PG8_GATHER_VOFF(cur);
#if PG8_SP2
    PG8_STAGE(PG8_SB(0, 0), cB, voffB); PG8_STAGE(PG8_SB(0, 1), cB + hstep, voffB); PG8_STAGE_A(PG8_SA(0, 0), cA, 0); PG8_STAGE_A(PG8_SA(0, 1), cA, 1);
    if (wr == 1) PG8_BAR;
    PG8_WAIT_V(2); PG8_BAR;
#else
    PG8_STAGE(PG8_SB(0, 0), cB, voffB); PG8_STAGE_A(PG8_SA(0, 0), cA, 0); PG8_STAGE(PG8_SB(0, 1), cB + hstep, voffB); PG8_STAGE_A(PG8_SA(0, 1), cA, 1);
    if (wr == 1) PG8_BAR;
    PG8_WAIT_V(4); PG8_BAR;
#endif
    PG8_STAGE(PG8_SB(1, 0), cB + kstep, voffB); PG8_STAGE_A(PG8_SA(1, 0), cA + kstep, 0); PG8_STAGE(PG8_SB(1, 1), cB + hstep + kstep, voffB);
    PG8_WAIT_V(6); PG8_BAR;
    for (;;) {
        const bool has_next = S.next(ui + 1, nxt);
        const char* nA = has_next ? S.a_base(nxt) : cA; const char* nB = has_next ? S.b_base(nxt) : cB;
        unsigned nA0[2] = {0u, 0u}, nA1[2] = {0u, 0u};
        if constexpr (Prob::GATHER) { if (has_next) PG8_GATHER_VOFF2(nxt, nA0, nA1); }
        for (int t = 0; t < nt; t += 2) {
            const bool last = (t == nt - 2);
            const char* a1 = cA + (size_t)(t + 1) * kstep;
            const char* a2 = last ? nA : cA + (size_t)(t + 2) * kstep; const char* b2 = last ? nB : cB + (size_t)(t + 2) * kstep;
            const char* a3 = a2 + kstep; const char* b3 = b2 + kstep;
#if !PG8_SP2
            PG8_LDB(B0, 0, 0); PG8_SCHED; PG8_LDA(At, 0, 0); PG8_STAGE_A(PG8_SA(1, 1), a1, 1);
            PG8_WAIT_L(8); PG8_BAR; PG8_WAIT_L(0); PG8_MMA(0, 0, At, B0); PG8_BAR; PG8_SCHED;
            if constexpr (Prob::GATHER) { if (last && has_next) PG8_GATHER_VOFF(nxt); }
            PG8_LDB(B1, 0, 1); PG8_STAGE(PG8_SB(0, 0), b2, voffB);
            PG8_BAR; PG8_WAIT_L(0); PG8_MMA(0, 1, At, B1); PG8_BAR;
            PG8_LDA(At, 0, 1); PG8_STAGE_A(PG8_SA(0, 0), a2, 0);
            PG8_BAR; PG8_WAIT_L(0); PG8_MMA(1, 0, At, B0); PG8_BAR; PG8_SCHED;
            PG8_STAGE(PG8_SB(0, 1), b2 + hstep, voffB);
            PG8_WAIT_V(6); PG8_BAR; PG8_MMA(1, 1, At, B1); PG8_BAR;
            PG8_LDB(B0, 1, 0); PG8_SCHED; PG8_LDA(At, 1, 0); PG8_STAGE_A(PG8_SA(0, 1), a2, 1);
            PG8_WAIT_L(8); PG8_BAR; PG8_WAIT_L(0); PG8_MMA(0, 0, At, B0); PG8_BAR; PG8_SCHED;
            PG8_LDB(B1, 1, 1); PG8_STAGE(PG8_SB(1, 0), b3, voffB);
            PG8_BAR; PG8_WAIT_L(0); PG8_MMA(0, 1, At, B1); PG8_BAR;
            PG8_LDA(At, 1, 1); PG8_STAGE_A(PG8_SA(1, 0), a3, 0);
            PG8_BAR; PG8_WAIT_L(0); PG8_MMA(1, 0, At, B0); PG8_BAR; PG8_SCHED;
            PG8_STAGE(PG8_SB(1, 1), b3 + hstep, voffB);
            PG8_WAIT_V(6); PG8_BAR; PG8_MMA(1, 1, At, B1); PG8_BAR;
#else
            PG8_LDB(B0, 0, 0); PG8_LDB(B1, 0, 1); PG8_SCHED; PG8_LDA(At, 0, 0); PG8_STAGE_A(PG8_SA(1, 1), a1, 1);
            PG8_WAIT_V(8); PG8_WAIT_L(0); PG8_BAR; PG8_MMA(0, 0, At, B0); PG8_MMA(0, 1, At, B1); PG8_BAR; PG8_SCHED;
            if constexpr (Prob::GATHER) { if (last && has_next) { vA0[0] = nA0[0]; vA0[1] = nA0[1]; vA1[0] = nA1[0]; vA1[1] = nA1[1]; } }
            PG8_LDA(At, 0, 1); PG8_STAGE(PG8_SB(0, 0), b2, voffB); PG8_STAGE(PG8_SB(0, 1), b2 + hstep, voffB); PG8_STAGE_A(PG8_SA(0, 0), a2, 0);
            PG8_WAIT_V(8); PG8_WAIT_L(0); PG8_BAR; PG8_MMA(1, 0, At, B0); PG8_MMA(1, 1, At, B1); PG8_BAR; PG8_SCHED;
            PG8_LDB(B0, 1, 0); PG8_LDB(B1, 1, 1); PG8_SCHED; PG8_LDA(At, 1, 0); PG8_STAGE_A(PG8_SA(0, 1), a2, 1);
            PG8_WAIT_V(8); PG8_WAIT_L(0); PG8_BAR; PG8_MMA(0, 0, At, B0); PG8_MMA(0, 1, At, B1); PG8_BAR; PG8_SCHED;
            PG8_LDA(At, 1, 1); PG8_STAGE(PG8_SB(1, 0), b3, voffB); PG8_STAGE(PG8_SB(1, 1), b3 + hstep, voffB); PG8_STAGE_A(PG8_SA(1, 0), a3, 0);
            PG8_WAIT_V(8); PG8_WAIT_L(0); PG8_BAR; PG8_MMA(1, 0, At, B0); PG8_MMA(1, 1, At, B1); PG8_BAR; PG8_SCHED;
#endif
        }
        if (wr == 0) PG8_BAR;
        E(acc, cur, wr, wc, fr, fq);
#if EPI2
        if constexpr (Epi::PERM) E(acc, cur, wr, wc, fr, fq);
#endif
        if (!has_next) break;
#pragma unroll
        for (int a = 0; a < 2; ++a)
#pragma unroll
            for (int b = 0; b < 2; ++b)
#pragma unroll
                for (int m = 0; m < 4; ++m)
#pragma unroll
                    for (int n = 0; n < 2; ++n) acc[a][b][m][n] = (f32x4){0.f, 0.f, 0.f, 0.f};
        cur = nxt; cA = nA; cB = nB; ++ui;
        if (wr == 1) PG8_BAR;
    }
    PG8_WAIT_V(0);
    PG8_BAR;
#undef PG8_SA
#undef PG8_SB
#undef PG8_STAGE
#undef PG8_STAGE_A
#undef PG8_LDA
#undef PG8_LDB
#undef PG8_MMA
#undef PG8_WAIT_V
#undef PG8_WAIT_L
#undef PG8_BAR
#undef PG8_SCHED
#undef PG8_GATHER_VOFF
#undef PG8_GATHER_VOFF2
}
}

__device__ __forceinline__ void gemm_ctx_res(Frame& F, const bf16* A, int lda, const bf16* Bt, int K, bool first, const float* gate4) {
    if (F.bid >= 256) return;
    const int tm = F.bid >> 4, tn = F.bid & 15, lr = F.lane & 15, lq = F.lane >> 4;
    const int ks = K / 8, nst = ks / 32;
    const bf16* ap = A + (size_t)(ML + 64 * tm + lr) * lda + F.wave * ks + 8 * lq; const bf16* bp = Bt + (size_t)(64 * tn + lr) * K + F.wave * ks + 8 * lq;
    f32x4 acc[4][4];
#pragma unroll
    for (int mi = 0; mi < 4; ++mi)
#pragma unroll
        for (int ni = 0; ni < 4; ++ni) acc[mi][ni] = (f32x4){0.f, 0.f, 0.f, 0.f};
    bf16x8 a0[4], b0[4], a1[4], b1[4];
#pragma unroll
    for (int q = 0; q < 4; ++q) { a0[q] = *(const bf16x8*)(ap + (size_t)(16 * q) * lda); b0[q] = *(const bf16x8*)(bp + (size_t)(16 * q) * K); }
    for (int st = 0; st < nst; st += 2) {
        const bool h1 = st + 1 < nst, h2 = st + 2 < nst;
        if (h1) {
#pragma unroll
            for (int q = 0; q < 4; ++q) { a1[q] = *(const bf16x8*)(ap + (size_t)(16 * q) * lda + 32 * (st + 1)); b1[q] = *(const bf16x8*)(bp + (size_t)(16 * q) * K + 32 * (st + 1)); } }
#pragma unroll
        for (int mi = 0; mi < 4; ++mi)
#pragma unroll
            for (int ni = 0; ni < 4; ++ni) acc[mi][ni] = __builtin_amdgcn_mfma_f32_16x16x32_bf16(a0[mi], b0[ni], acc[mi][ni], 0, 0, 0);
        if (h2) {
#pragma unroll
            for (int q = 0; q < 4; ++q) { a0[q] = *(const bf16x8*)(ap + (size_t)(16 * q) * lda + 32 * (st + 2)); b0[q] = *(const bf16x8*)(bp + (size_t)(16 * q) * K + 32 * (st + 2)); } }
        if (h1) {
#pragma unroll
            for (int mi = 0; mi < 4; ++mi)
#pragma unroll
                for (int ni = 0; ni < 4; ++ni) acc[mi][ni] = __builtin_amdgcn_mfma_f32_16x16x32_bf16(a1[mi], b1[ni], acc[mi][ni], 0, 0, 0); }
    }
    LAS float* Pl = (LAS float*)(F.lds) + F.wave * 4096;
#pragma unroll
    for (int mi = 0; mi < 4; ++mi)
#pragma unroll
        for (int ni = 0; ni < 4; ++ni)
#pragma unroll
            for (int q = 0; q < 4; ++q) Pl[(16 * mi + 4 * lq + q) * 64 + 16 * ni + lr] = acc[mi][ni][q];
    __syncthreads();
    { const int i = F.tid >> 3, j0 = (F.tid & 7) * 8; const LAS float* Ps = (const LAS float*)(F.lds) + i * 64 + j0;
      f32x4 s0 = (f32x4){0.f, 0.f, 0.f, 0.f}, s1 = s0;
#pragma unroll
      for (int w = 0; w < 8; ++w) { s0 = s0 + *(const LAS f32x4*)(Ps + w * 4096); s1 = s1 + *(const LAS f32x4*)(Ps + w * 4096 + 4); }
      const size_t ro = (size_t)(64 * tm + i) * D + 64 * tn + j0; const float* gp = gate4 + 64 * tn + j0;
      const f32x4 g0 = *(const f32x4*)gp, g1 = *(const f32x4*)(gp + 4); bf16* xd = F_XB + (size_t)ML * D + ro; f32x4 x0, x1;
      if (first) { const float* cin = INP(I_CTX); x0 = *(const f32x4*)(cin + ro); x1 = *(const f32x4*)(cin + ro + 4); }
      else { const v4u w = *(const v4u*)xd; x0 = (f32x4){bflo(w.x), bfhi(w.x), bflo(w.y), bfhi(w.y)}; x1 = (f32x4){bflo(w.z), bfhi(w.z), bflo(w.w), bfhi(w.w)}; }
      const f32x4 v0 = x0 + g0 * s0, v1 = x1 + g1 * s1; v4u o; o.x = pk2(v0.x, v0.y); o.y = pk2(v0.z, v0.w); o.z = pk2(v1.x, v1.y); o.w = pk2(v1.z, v1.w); *(v4u*)xd = o; }
    __syncthreads();
}

__device__ __forceinline__ void sa_xr_conv(Frame& F, int l) {
    const float* cw = INP(I_RCW) + (size_t)l * 4 * DR; const float* cb = INP(I_RCB) + (size_t)l * DR;
    for (size_t idx = (size_t)F.bid * NTHREADS + F.tid; idx < (size_t)M * DR; idx += (size_t)F.G * NTHREADS) {
        const int row = (int)(idx >> 9), c = (int)(idx & 511);
        int t, L; if (row < ML) { t = row & (SEQ - 1); L = SEQ; } else { t = (row - ML) & (CTXL - 1); L = CTXL; }
        float a = cb[c];
#pragma unroll
        for (int k = 0; k < 4; ++k) { const int tt = t + k - 2; if (tt >= 0 && tt < L) a += cw[k * DR + c] * bf2f(F_P[(size_t)(row + k - 2) * PW + 1024 + c]); }
        F_XR[idx] = a;
    }
}
__device__ __forceinline__ void sa_mx(Frame& F, int l) {
    const float* cw = INP(I_CONVW) + (size_t)l * 3 * DR; const bf16* Pb = F_P; bf16* MIXb = F_MIX;
    const int gt = F.bid * NTHREADS + F.tid, c0 = (gt & 63) * 8; const int rstep = (F.G * NTHREADS) >> 6;
    float w0[8], w1[8], w2[8];
#pragma unroll
    for (int q = 0; q < 8; ++q) { w0[q] = cw[c0 + q]; w1[q] = cw[DR + c0 + q]; w2[q] = cw[2 * DR + c0 + q]; }
    for (int row0 = gt >> 6; row0 < M; row0 += 4 * rstep) {
        v4u um[4], u0[4], up[4], cbv[4];
#pragma unroll
        for (int k = 0; k < 4; ++k) { const int row = row0 + k * rstep; const v4u z = (v4u){0u, 0u, 0u, 0u}; um[k] = z; u0[k] = z; up[k] = z; cbv[k] = z;
            if (row < M) { int dlt; bool okm, okp;
                if (row < ML) { const int t = row & (SEQ - 1); if (c0 < 256) { dlt = 1; okm = (t & 63) > 0; okp = (t & 63) < 63; } else { dlt = 64; okm = (t >> 6) > 0; okp = (t >> 6) < 127; } }
                else { const int t = (row - ML) & (CTXL - 1); dlt = 1; okm = t > 0; okp = t < CTXL - 1; }
                if (okm) um[k] = *(const v4u*)(Pb + (size_t)(row - dlt) * PW + 512 + c0);
                u0[k] = *(const v4u*)(Pb + (size_t)row * PW + 512 + c0);
                if (okp) up[k] = *(const v4u*)(Pb + (size_t)(row + dlt) * PW + 512 + c0);
                cbv[k] = *(const v4u*)(Pb + (size_t)row * PW + c0); } }
#pragma unroll
        for (int k = 0; k < 4; ++k) { const int row = row0 + k * rstep;
            if (row < M) { v4u o;
#pragma unroll
                for (int q = 0; q < 4; ++q) {
                    const float r0 = bflo(cbv[k][q]) * (w0[2 * q] * bflo(um[k][q]) + w1[2 * q] * bflo(u0[k][q]) + w2[2 * q] * bflo(up[k][q]));
                    const float r1 = bfhi(cbv[k][q]) * (w0[2 * q + 1] * bfhi(um[k][q]) + w1[2 * q + 1] * bfhi(u0[k][q]) + w2[2 * q + 1] * bfhi(up[k][q]));
                    o[q] = pk2(r0, r1); }
                *(v4u*)(MIXb + (size_t)row * D + c0) = o; } }
    }
}
__device__ __forceinline__ void sa_mx_alt(Frame& F, int l) {
    const float* cw = INP(I_CONVW) + (size_t)l * 3 * DR; const bf16* P = F_P; bf16* MIXb = F_MIX;
    for (size_t idx = (size_t)F.bid * NTHREADS + F.tid; idx < (size_t)M * DR; idx += (size_t)F.G * NTHREADS) {
        const int row = (int)(idx / DR), c = (int)(idx % DR);
        float acc = 0.f;
        if (row < ML) { const int b = row / SEQ, t = row % SEQ, gr = t / 64, gc = t % 64;
            for (int k = 0; k < 3; ++k) {
                if (c < 256) { const int g2 = gc + k - 1; if (g2 >= 0 && g2 < 64) acc += cw[k * DR + c] * bf2f(P[(size_t)(b * SEQ + gr * 64 + g2) * PW + 512 + c]); }
                else { const int r2 = gr + k - 1; if (r2 >= 0 && r2 < SEQ / 64) acc += cw[k * DR + c] * bf2f(P[(size_t)(b * SEQ + r2 * 64 + gc) * PW + 512 + c]); } } }
        else { const int b = (row - ML) / CTXL, t = (row - ML) % CTXL;
            for (int k = 0; k < 3; ++k) { const int t2 = t + k - 1; if (t2 >= 0 && t2 < CTXL) acc += cw[k * DR + c] * bf2f(P[(size_t)(ML + b * CTXL + t2) * PW + 512 + c]); } }
        MIXb[(size_t)row * D + c] = (bf16)f2bf(bf2f(P[(size_t)row * PW + c]) * acc);
    }
}
__device__ __forceinline__ void sb_scan_naive(Frame& F, int l) {
    if (F.bid >= 64 || F.wave != 0) return;
    const int b = F.bid >> 4, h = (F.bid >> 1) & 7, d = F.bid & 1, j = F.lane;
    volatile LAS float* xs = (volatile LAS float*)(F.lds + 0);
    LAS float* WA = (LAS float*)(F.lds + 1024);
    LAS float* WI = (LAS float*)(F.lds + 1024 + 16384);
    { const float* pa = INP(I_LWA) + ((size_t)((l * 2 + d) * 8 + h) * 64) * 64 + j; const float* pi = INP(I_LWI) + ((size_t)((l * 2 + d) * 8 + h) * 64) * 64 + j;
      for (int i = 0; i < 64; ++i) { WA[i * 64 + j] = pa[i * 64]; WI[i * 64 + j] = pi[i * 64]; } }
    LDS_WAIT(); __builtin_amdgcn_wave_barrier();
    const float ba = INP(I_LBA)[(l * 2 + d) * DR + 64 * h + j], bi = INP(I_LBI)[(l * 2 + d) * DR + 64 * h + j], k2 = F_LRUK[(l * 2 + d) * DR + 64 * h + j];
    float* HX = d ? F_HB : F_HF;
    float hst = 0.f;
    for (int seg = 0; seg < 2; ++seg) {
        const int L = seg == 0 ? CTXL : SEQ; const int rowbase = seg == 0 ? ML + b * CTXL : b * SEQ;
        for (int s0 = 0; s0 < L; s0 += 4) {
            float xv[4];
#pragma unroll
            for (int q = 0; q < 4; ++q) { const int t = d ? L - 1 - (s0 + q) : s0 + q; xv[q] = F_XR[(size_t)(rowbase + t) * DR + 64 * h + j]; }
#pragma unroll
            for (int q = 0; q < 4; ++q) {
                const int t = d ? L - 1 - (s0 + q) : s0 + q; const float x = xv[q];
                xs[j] = x; LDS_WAIT(); __builtin_amdgcn_wave_barrier();
                float za = ba, zi = bi;
#pragma unroll 16
                for (int i = 0; i < 64; ++i) { const float xi = xs[i]; za += xi * WA[i * 64 + j]; zi += xi * WI[i * 64 + j]; }
                __builtin_amdgcn_wave_barrier();
                const float r_ = sigm(za), ig = sigm(zi);
                const float a = __builtin_amdgcn_exp2f(-k2 * r_);
                const float mult = sqrtf(fmaxf(1.0f - a * a, 0.f));
                hst = a * hst + mult * ig * x;
                HX[(size_t)(rowbase + t) * DR + 64 * h + j] = hst;
            }
        }
    }
}
__device__ __forceinline__ void sc_combine(Frame& F) {
    for (size_t idx = (size_t)F.bid * NTHREADS + F.tid; idx < (size_t)M * (DR / 2); idx += (size_t)F.G * NTHREADS) {
        const int row = (int)(idx >> 8), c = (int)(idx & 255) * 2;
        const unsigned gg = *(const unsigned*)(F_P + (size_t)row * PW + 1536 + c);
        const size_t o = (size_t)row * DR + c;
        const float r0 = (F_HF[o] + F_HB[o]) * bflo(gg), r1 = (F_HF[o + 1] + F_HB[o + 1]) * bfhi(gg);
        *(unsigned*)(F_MIX + (size_t)row * D + 512 + c) = pk2(r0, r1);
    }
}

constexpr int NPOS = 66;
constexpr int S_XRB = 0, S_WG = 16384, S_A = 49152, S_B = 81920, S_HS = 114688, S_AGGW = 133120;
struct SUnit { int b, p, L, t0, rowbase; };
__device__ __forceinline__ void s_unit(int u, SUnit& U) { const int idx = u >> 3; U.b = idx / NPOS; U.p = idx - U.b * NPOS; const bool isctx = U.p < 2; U.L = isctx ? CTXL : SEQ; U.t0 = isctx ? 128 * U.p : 128 * (U.p - 2); U.rowbase = isctx ? ML + U.b * CTXL : U.b * SEQ; }
template <bool APPLY>
__device__ __forceinline__ void s_phase(Frame& F, int l) {
    const int tid = F.tid, lane = F.lane, wave = F.wave; LAS unsigned char* lds = F.lds;
    const int h = F.bid & 7;
    const bf16* Pb = F_P; bf16* MIXb = F_MIX; float* AGGb = F_AGG; const float* CARb = F_CAR; unsigned* ABb = F_AB;
    const float* rcw = INP(I_RCW) + (size_t)l * 4 * DR + 64 * h; const float* rcb = INP(I_RCB) + (size_t)l * DR + 64 * h;
    LAS float* Al = (LAS float*)(lds + S_A); LAS float* Bl = (LAS float*)(lds + S_B); LAS unsigned short* HS = (LAS unsigned short*)(lds + S_HS); LAS float* AGGW = (LAS float*)(lds + S_AGGW);
    { const bf16* WGb = F_WGATE;
#pragma unroll
      for (int i = 0; i < 4; ++i) { const int q = tid + 512 * i, d = q >> 10, qq = q & 1023, gate = qq >> 9, n = (qq >> 3) & 63, ch = qq & 7;
          const v4u v = *(const v4u*)(WGb + (size_t)(((l * 2 + d) * 8 + h) * 2) * 4096 + (size_t)qq * 8);
          *(LAS v4u*)(lds + S_WG + d * 16384 + gate * 8192 + n * 128 + ((ch ^ (n & 7)) * 16)) = v; } }
    float k2r[2][4], bar[2][4], bir[2][4];
    { const float* lba = INP(I_LBA) + (size_t)l * 2 * DR + 64 * h; const float* lbi = INP(I_LBI) + (size_t)l * 2 * DR + 64 * h; const float* LRUKb = F_LRUK + (size_t)l * 2 * DR + 64 * h;
#pragma unroll
      for (int d = 0; d < 2; ++d)
#pragma unroll
          for (int ct = 0; ct < 4; ++ct) { const int chl = 16 * ct + (lane & 15); k2r[d][ct] = LRUKb[d * DR + chl]; bar[d][ct] = lba[d * DR + chl]; bir[d][ct] = lbi[d * DR + chl]; } }
    const int t = tid >> 2, cg = tid & 3;
    v4u rA[4], rB[4], g0, g1; float car0 = 0.f, car1 = 0.f; unsigned rmask = 0u;
#define S_PREFETCH(u_) do { SUnit V; s_unit((u_), V); const int tt_ = V.t0 + t; rmask = 0u; \
        _Pragma("unroll") for (int k = 0; k < 4; ++k) { const int ts = tt_ + k - 2; if (ts >= 0 && ts < V.L) { const bf16* rp = Pb + (size_t)(V.rowbase + ts) * PW + 1024 + 64 * h + 16 * cg; rA[k] = *(const v4u*)rp; rB[k] = *(const v4u*)(rp + 8); rmask |= 1u << k; } } \
        if (APPLY) { const bf16* gp = Pb + (size_t)(V.rowbase + tt_) * PW + 1536 + 64 * h + 16 * cg; g0 = *(const v4u*)gp; g1 = *(const v4u*)(gp + 8); \
            const int pb_ = V.p < 2 ? 1 - V.p : 67 - V.p; car0 = CARb[(size_t)((V.b * 2 + 0) * NPOS + V.p) * DR + 64 * h + lane]; car1 = CARb[(size_t)((V.b * 2 + 1) * NPOS + pb_) * DR + 64 * h + lane]; } } while (0)
    int u = F.bid;
    if (u < NB * NPOS * 8) S_PREFETCH(u);
    __syncthreads();
    for (; u < NB * NPOS * 8; u += F.G) {
        SUnit U; s_unit(u, U); const int tt = U.t0 + t;
        { float xr[16];
#pragma unroll
          for (int q = 0; q < 4; ++q) { const f32x4 bv = *(const f32x4*)(rcb + 16 * cg + 4 * q); xr[4 * q] = bv.x; xr[4 * q + 1] = bv.y; xr[4 * q + 2] = bv.z; xr[4 * q + 3] = bv.w; }
#pragma unroll
          for (int k = 0; k < 4; ++k) { if (rmask & (1u << k)) { const v4u r0 = rA[k], r1 = rB[k];
#pragma unroll
                  for (int q = 0; q < 4; ++q) { const f32x4 wv = *(const f32x4*)(rcw + k * DR + 16 * cg + 4 * q); const unsigned wa = q < 2 ? r0[2 * q] : r1[2 * q - 4], wb = q < 2 ? r0[2 * q + 1] : r1[2 * q - 3];
                      xr[4 * q] += wv.x * bflo(wa); xr[4 * q + 1] += wv.y * bfhi(wa); xr[4 * q + 2] += wv.z * bflo(wb); xr[4 * q + 3] += wv.w * bfhi(wb); } } }
          v4u o0, o1; o0.x = pk2(xr[0], xr[1]); o0.y = pk2(xr[2], xr[3]); o0.z = pk2(xr[4], xr[5]); o0.w = pk2(xr[6], xr[7]); o1.x = pk2(xr[8], xr[9]); o1.y = pk2(xr[10], xr[11]); o1.z = pk2(xr[12], xr[13]); o1.w = pk2(xr[14], xr[15]);
          *(LAS v4u*)(lds + S_XRB + t * 128 + (((2 * cg) ^ (t & 7)) * 16)) = o0; *(LAS v4u*)(lds + S_XRB + t * 128 + (((2 * cg + 1) ^ (t & 7)) * 16)) = o1; }
        const v4u cg0 = g0, cg1 = g1; const float ccar0 = car0, ccar1 = car1;
        if (u + F.G < NB * NPOS * 8) S_PREFETCH(u + F.G);
        __syncthreads();
#pragma unroll
        for (int d = 0; d < 2; ++d) {
            const int pos = d == 0 ? U.p : (U.p < 2 ? 1 - U.p : 67 - U.p);
            f32x4 za[4], zi[4];
            { bf16x8 af[2]; const int row = 16 * wave + (lane & 15);
#pragma unroll
              for (int ks = 0; ks < 2; ++ks) { const int chk = (lane >> 4) + 4 * ks; af[ks] = *(const LAS bf16x8*)(lds + S_XRB + row * 128 + ((chk ^ (row & 7)) * 16)); }
#pragma unroll
              for (int ct = 0; ct < 4; ++ct) { const int chl = 16 * ct + (lane & 15); const float ba_ = bar[d][ct], bi_ = bir[d][ct]; za[ct] = (f32x4){ba_, ba_, ba_, ba_}; zi[ct] = (f32x4){bi_, bi_, bi_, bi_};
#pragma unroll
                  for (int ks = 0; ks < 2; ++ks) { const int chk = (lane >> 4) + 4 * ks; const int wo = d * 16384 + chl * 128 + ((chk ^ (chl & 7)) * 16);
                      const bf16x8 fa = *(const LAS bf16x8*)(lds + S_WG + wo), fi = *(const LAS bf16x8*)(lds + S_WG + 8192 + wo);
                      za[ct] = __builtin_amdgcn_mfma_f32_16x16x32_bf16(af[ks], fa, za[ct], 0, 0, 0); zi[ct] = __builtin_amdgcn_mfma_f32_16x16x32_bf16(af[ks], fi, zi[ct], 0, 0, 0); } } }
#pragma unroll
            for (int ct = 0; ct < 4; ++ct) { const int chl = 16 * ct + (lane & 15); const float k2 = k2r[d][ct];
#pragma unroll
                for (int q = 0; q < 4; ++q) { const int tk = 16 * wave + 4 * (lane >> 4) + q;
                    const float x = bf2f(*(const LAS unsigned short*)(lds + S_XRB + tk * 128 + ((((chl >> 3)) ^ (tk & 7)) * 16) + (chl & 7) * 2));
                    const float r_ = sigm(za[ct][q]), ig = sigm(zi[ct][q]); const unsigned laq = f2bf(-k2 * r_); const float a = __builtin_amdgcn_exp2f(bf2f(laq)); const float mult = __builtin_amdgcn_sqrtf(fmaxf(1.0f - a * a, 0.f));
                    const unsigned bq = f2bf(mult * ig * x);
                    Al[tk * 64 + chl] = a; Bl[tk * 64 + chl] = bf2f(bq);
                    if (STORE_AB && !APPLY) ABb[((size_t)d * M + U.rowbase + U.t0 + tk) * DR + 64 * h + chl] = laq | (bq << 16); } }
            __syncthreads();
            { float Pl = 1.f, Hl = 0.f;
#pragma unroll
              for (int s_ = 0; s_ < 16; ++s_) { const int tk = 16 * wave + (d ? 15 - s_ : s_); const float a = Al[tk * 64 + lane], bb = Bl[tk * 64 + lane]; Hl = a * Hl + bb; Pl *= a; }
              AGGW[(wave * 64 + lane) * 2] = Pl; AGGW[(wave * 64 + lane) * 2 + 1] = Hl; }
            __syncthreads();
            if (!APPLY) {
                if (wave == 0) { float Pc = 1.f, Hc = 0.f;
#pragma unroll
                    for (int k = 0; k < 8; ++k) { const int w2 = d ? 7 - k : k; const float pw = AGGW[(w2 * 64 + lane) * 2], hw = AGGW[(w2 * 64 + lane) * 2 + 1]; Hc = pw * Hc + hw; Pc *= pw; }
                    float* ag = AGGb + ((size_t)((U.b * 2 + d) * NPOS + pos) * DR + 64 * h + lane) * 2; ag[0] = Pc; ag[1] = Hc; }
            } else {
                float hst = d ? ccar1 : ccar0;
#pragma unroll
                for (int k = 0; k < 8; ++k) { const int w2 = d ? 7 - k : k; const bool before = d ? (w2 > wave) : (w2 < wave);
                    if (before) { const float pw = AGGW[(w2 * 64 + lane) * 2], hw = AGGW[(w2 * 64 + lane) * 2 + 1]; hst = pw * hst + hw; } }
#pragma unroll
                for (int s_ = 0; s_ < 16; ++s_) { const int tk = 16 * wave + (d ? 15 - s_ : s_); const float a = Al[tk * 64 + lane], bb = Bl[tk * 64 + lane]; hst = a * hst + bb;
                    if (d == 0) HS[tk * 64 + lane] = (unsigned short)f2bf(hst); else HS[tk * 64 + lane] = (unsigned short)f2bf(bf2f(HS[tk * 64 + lane]) + hst); }
            }
            __syncthreads();
        }
        if (APPLY) {
            const LAS v4u* hp = (const LAS v4u*)(HS + t * 64 + 16 * cg); const v4u h0 = hp[0], h1 = hp[1];
            v4u o0, o1;
#pragma unroll
            for (int q = 0; q < 4; ++q) { o0[q] = pk2(bflo(h0[q]) * bflo(cg0[q]), bfhi(h0[q]) * bfhi(cg0[q])); o1[q] = pk2(bflo(h1[q]) * bflo(cg1[q]), bfhi(h1[q]) * bfhi(cg1[q])); }
            bf16* op = MIXb + (size_t)(U.rowbase + tt) * D + 512 + 64 * h + 16 * cg; *(v4u*)op = o0; *(v4u*)(op + 8) = o1;
            __syncthreads();
        }
    }
#undef S_PREFETCH
}
__device__ __forceinline__ void s1_phase(Frame& F, int l) {
    const int tid = F.tid, lane = F.lane, wave = F.wave; LAS unsigned char* lds = F.lds;
    const int h = F.bid & 7;
    const bf16* Pb = F_P; float* AGGb = F_AGG; unsigned* ABb = F_AB;
    const float* rcw = INP(I_RCW) + (size_t)l * 4 * DR + 64 * h; const float* rcb = INP(I_RCB) + (size_t)l * DR + 64 * h;
    LAS float* AGW = (LAS float*)(lds + S_A);
    { const bf16* WGb = F_WGATE;
#pragma unroll
      for (int i = 0; i < 4; ++i) { const int q = tid + 512 * i, d = q >> 10, qq = q & 1023, gate = qq >> 9, n = (qq >> 3) & 63, ch = qq & 7;
          const v4u v = *(const v4u*)(WGb + (size_t)(((l * 2 + d) * 8 + h) * 2) * 4096 + (size_t)qq * 8);
          *(LAS v4u*)(lds + S_WG + d * 16384 + gate * 8192 + n * 128 + ((ch ^ (n & 7)) * 16)) = v; } }
    float k2r[2][4], bar[2][4], bir[2][4];
    { const float* lba = INP(I_LBA) + (size_t)l * 2 * DR + 64 * h; const float* lbi = INP(I_LBI) + (size_t)l * 2 * DR + 64 * h; const float* LRUKb = F_LRUK + (size_t)l * 2 * DR + 64 * h;
#pragma unroll
      for (int d = 0; d < 2; ++d)
#pragma unroll
          for (int ct = 0; ct < 4; ++ct) { const int chl = 16 * ct + (lane & 15); k2r[d][ct] = LRUKb[d * DR + chl]; bar[d][ct] = lba[d * DR + chl]; bir[d][ct] = lbi[d * DR + chl]; } }
    const int t = tid >> 2, cg = tid & 3, grp = lane >> 4;
    v4u rA[4], rB[4]; unsigned rmask = 0u;
#define S1_PREFETCH(u_) do { SUnit V; s_unit((u_), V); const int tt_ = V.t0 + t; rmask = 0u; \
        _Pragma("unroll") for (int k = 0; k < 4; ++k) { const int ts = tt_ + k - 2; if (ts >= 0 && ts < V.L) { const bf16* rp = Pb + (size_t)(V.rowbase + ts) * PW + 1024 + 64 * h + 16 * cg; rA[k] = *(const v4u*)rp; rB[k] = *(const v4u*)(rp + 8); rmask |= 1u << k; } } } while (0)
    int u = F.bid;
    if (u < NB * NPOS * 8) S1_PREFETCH(u);
    __syncthreads();
    for (; u < NB * NPOS * 8; u += F.G) {
        SUnit U; s_unit(u, U);
        { float xr[16];
#pragma unroll
          for (int q = 0; q < 4; ++q) { const f32x4 bv = *(const f32x4*)(rcb + 16 * cg + 4 * q); xr[4 * q] = bv.x; xr[4 * q + 1] = bv.y; xr[4 * q + 2] = bv.z; xr[4 * q + 3] = bv.w; }
#pragma unroll
          for (int k = 0; k < 4; ++k) { if (rmask & (1u << k)) { const v4u r0 = rA[k], r1 = rB[k];
#pragma unroll
                  for (int q = 0; q < 4; ++q) { const f32x4 wv = *(const f32x4*)(rcw + k * DR + 16 * cg + 4 * q); const unsigned wa = q < 2 ? r0[2 * q] : r1[2 * q - 4], wb = q < 2 ? r0[2 * q + 1] : r1[2 * q - 3];
                      xr[4 * q] += wv.x * bflo(wa); xr[4 * q + 1] += wv.y * bfhi(wa); xr[4 * q + 2] += wv.z * bflo(wb); xr[4 * q + 3] += wv.w * bfhi(wb); } } }
          v4u o0, o1; o0.x = pk2(xr[0], xr[1]); o0.y = pk2(xr[2], xr[3]); o0.z = pk2(xr[4], xr[5]); o0.w = pk2(xr[6], xr[7]); o1.x = pk2(xr[8], xr[9]); o1.y = pk2(xr[10], xr[11]); o1.z = pk2(xr[12], xr[13]); o1.w = pk2(xr[14], xr[15]);
          *(LAS v4u*)(lds + S_XRB + t * 128 + (((2 * cg) ^ (t & 7)) * 16)) = o0; *(LAS v4u*)(lds + S_XRB + t * 128 + (((2 * cg + 1) ^ (t & 7)) * 16)) = o1; }
        if (u + F.G < NB * NPOS * 8) S1_PREFETCH(u + F.G);
        __syncthreads();
        bf16x8 af[2]; { const int row = 16 * wave + (lane & 15);
#pragma unroll
          for (int ks = 0; ks < 2; ++ks) { const int chk = grp + 4 * ks; af[ks] = *(const LAS bf16x8*)(lds + S_XRB + row * 128 + ((chk ^ (row & 7)) * 16)); } }
        float xv[4][4];
#pragma unroll
        for (int ct = 0; ct < 4; ++ct) { const int chl = 16 * ct + (lane & 15);
#pragma unroll
            for (int q = 0; q < 4; ++q) { const int tk = 16 * wave + 4 * grp + q; xv[ct][q] = bf2f(*(const LAS unsigned short*)(lds + S_XRB + tk * 128 + ((((chl >> 3)) ^ (tk & 7)) * 16) + (chl & 7) * 2)); } }
#pragma unroll
        for (int d = 0; d < 2; ++d) {
            unsigned* abrow = ABb + ((size_t)d * M + U.rowbase + U.t0 + 16 * wave + 4 * grp) * DR + 64 * h + (lane & 15);
#pragma unroll
            for (int ct = 0; ct < 4; ++ct) { const int chl = 16 * ct + (lane & 15); const float ba_ = bar[d][ct], bi_ = bir[d][ct], k2 = k2r[d][ct];
                f32x4 za = (f32x4){ba_, ba_, ba_, ba_}, zi = (f32x4){bi_, bi_, bi_, bi_};
#pragma unroll
                for (int ks = 0; ks < 2; ++ks) { const int chk = grp + 4 * ks; const int wo = d * 16384 + chl * 128 + ((chk ^ (chl & 7)) * 16);
                    const bf16x8 fa = *(const LAS bf16x8*)(lds + S_WG + wo), fi = *(const LAS bf16x8*)(lds + S_WG + 8192 + wo);
                    za = __builtin_amdgcn_mfma_f32_16x16x32_bf16(af[ks], fa, za, 0, 0, 0); zi = __builtin_amdgcn_mfma_f32_16x16x32_bf16(af[ks], fi, zi, 0, 0, 0); }
                float Pl = 1.f, Hl = 0.f;
#pragma unroll
                for (int qq = 0; qq < 4; ++qq) { const int q = d ? 3 - qq : qq;
                    const float r_ = sigm(za[q]), ig = sigm(zi[q]); const unsigned w = pk2(-k2 * r_, 0.f) & 0xffffu; const float a = __builtin_amdgcn_exp2f(bf2f(w)); const float mult = __builtin_amdgcn_sqrtf(fmaxf(1.0f - a * a, 0.f));
                    const unsigned bq = f2bf(mult * ig * xv[ct][q]); abrow[(size_t)q * DR + 16 * ct] = w | (bq << 16);
                    Hl = a * Hl + bf2f(bq); Pl *= a; }
                { const float Pp = __shfl_xor(Pl, 16), Hp = __shfl_xor(Hl, 16); const bool first = d ? ((grp & 1) != 0) : ((grp & 1) == 0);
                  const float Pn = Pl * Pp, Hn = first ? (Pp * Hl + Hp) : (Pl * Hp + Hl); Pl = Pn; Hl = Hn; }
                { const float Pp = __shfl_xor(Pl, 32), Hp = __shfl_xor(Hl, 32); const bool first = d ? ((grp & 2) != 0) : ((grp & 2) == 0);
                  const float Pn = Pl * Pp, Hn = first ? (Pp * Hl + Hp) : (Pl * Hp + Hl); Pl = Pn; Hl = Hn; }
                if (lane < 16) { AGW[((d * 8 + wave) * 64 + chl) * 2] = Pl; AGW[((d * 8 + wave) * 64 + chl) * 2 + 1] = Hl; }
            }
        }
        __syncthreads();
        if (wave < 2) { const int d = wave; const int pos = d == 0 ? U.p : (U.p < 2 ? 1 - U.p : 67 - U.p); float Pc = 1.f, Hc = 0.f;
#pragma unroll
            for (int k = 0; k < 8; ++k) { const int w2 = d ? 7 - k : k; const float pw = AGW[((d * 8 + w2) * 64 + lane) * 2], hw = AGW[((d * 8 + w2) * 64 + lane) * 2 + 1]; Hc = pw * Hc + hw; Pc *= pw; }
            float* ag = AGGb + ((size_t)((U.b * 2 + d) * NPOS + pos) * DR + 64 * h + lane) * 2; ag[0] = Pc; ag[1] = Hc; }
    }
#undef S1_PREFETCH
}
__device__ __forceinline__ void s3r_phase(Frame& F) {
    const int lane = F.lane, wave = F.wave; LAS unsigned char* lds = F.lds;
    const int h = F.bid & 7;
    const GAS bf16* Pb = (const GAS bf16*)F_P; GAS bf16* MIXb = (GAS bf16*)F_MIX; const GAS float* CARb = (const GAS float*)F_CAR; const GAS unsigned* ABb = (const GAS unsigned*)F_AB;
    LAS float* AGW = (LAS float*)(lds + S_A);
    unsigned wf[16], wb[16]; unsigned short gq[16]; float car0 = 0.f, car1 = 0.f;
#define S3R_PREFETCH(u_) do { SUnit V; s_unit((u_), V); const size_t r0_ = (size_t)(V.rowbase + V.t0 + 16 * wave); const int c_ = 64 * h + lane; \
        _Pragma("unroll") for (int s_ = 0; s_ < 16; ++s_) { wf[s_] = ABb[(r0_ + s_) * DR + c_]; wb[s_] = ABb[((size_t)M + r0_ + s_) * DR + c_]; gq[s_] = Pb[(r0_ + s_) * PW + 1536 + c_]; } \
        const int pb_ = V.p < 2 ? 1 - V.p : 67 - V.p; car0 = CARb[(size_t)((V.b * 2 + 0) * NPOS + V.p) * DR + c_]; car1 = CARb[(size_t)((V.b * 2 + 1) * NPOS + pb_) * DR + c_]; } while (0)
    int u = F.bid, par = 0;
    if (u < NB * NPOS * 8) S3R_PREFETCH(u);
    for (; u < NB * NPOS * 8; u += F.G, par ^= 1) {
        SUnit U; s_unit(u, U);
        float af[16], bfv[16], ab[16], bb[16], gv[16];
#pragma unroll
        for (int s_ = 0; s_ < 16; ++s_) { af[s_] = __builtin_amdgcn_exp2f(bflo(wf[s_])); bfv[s_] = bfhi(wf[s_]); ab[s_] = __builtin_amdgcn_exp2f(bflo(wb[s_])); bb[s_] = bfhi(wb[s_]); gv[s_] = bf2f(gq[s_]); }
        const float c0 = car0, c1 = car1;
        if (u + F.G < NB * NPOS * 8) S3R_PREFETCH(u + F.G);
        { float P0 = 1.f, H0 = 0.f, P1 = 1.f, H1 = 0.f;
#pragma unroll
          for (int s_ = 0; s_ < 16; ++s_) { H0 = af[s_] * H0 + bfv[s_]; P0 *= af[s_]; H1 = ab[15 - s_] * H1 + bb[15 - s_]; P1 *= ab[15 - s_]; }
          LAS float* aw = AGW + (size_t)par * 2048;
          aw[((0 * 8 + wave) * 64 + lane) * 2] = P0; aw[((0 * 8 + wave) * 64 + lane) * 2 + 1] = H0; aw[((1 * 8 + wave) * 64 + lane) * 2] = P1; aw[((1 * 8 + wave) * 64 + lane) * 2 + 1] = H1; }
        __syncthreads();
        float hf[16];
        { const LAS float* aw = AGW + (size_t)par * 2048; float hst = c0;
#pragma unroll
          for (int k = 0; k < 8; ++k) { if (k < wave) { const float pw = aw[((0 * 8 + k) * 64 + lane) * 2], hw = aw[((0 * 8 + k) * 64 + lane) * 2 + 1]; hst = pw * hst + hw; } }
#pragma unroll
          for (int s_ = 0; s_ < 16; ++s_) { hst = af[s_] * hst + bfv[s_]; hf[s_] = hst; }
          hst = c1;
#pragma unroll
          for (int k = 7; k >= 0; --k) { if (k > wave) { const float pw = aw[((1 * 8 + k) * 64 + lane) * 2], hw = aw[((1 * 8 + k) * 64 + lane) * 2 + 1]; hst = pw * hst + hw; } }
          GAS bf16* op = MIXb + (size_t)(U.rowbase + U.t0 + 16 * wave) * D + 512 + 64 * h + lane;
#pragma unroll
          for (int s_ = 15; s_ >= 0; --s_) { hst = ab[s_] * hst + bb[s_]; op[(size_t)s_ * D] = (bf16)f2bf((hf[s_] + hst) * gv[s_]); } }
    }
#undef S3R_PREFETCH
}
__device__ __forceinline__ void s3_phase(Frame& F) {
    const int tid = F.tid, lane = F.lane, wave = F.wave; LAS unsigned char* lds = F.lds;
    const int h = F.bid & 7;
    const bf16* Pb = F_P; bf16* MIXb = F_MIX; const float* CARb = F_CAR; const unsigned* ABb = F_AB;
    LAS float* Al = (LAS float*)(lds + S_A); LAS float* Bl = (LAS float*)(lds + S_B); LAS unsigned short* HS = (LAS unsigned short*)(lds + S_HS); LAS float* AGGW = (LAS float*)(lds + S_AGGW);
    const int t = tid >> 2, cg = tid & 3;
    v4u ab[2][4], g0, g1; float car0 = 0.f, car1 = 0.f;
#define S3_PREFETCH(u_) do { SUnit V; s_unit((u_), V); const int tt_ = V.t0 + t; \
        _Pragma("unroll") for (int d = 0; d < 2; ++d) { const unsigned* ap = ABb + ((size_t)d * M + V.rowbase + tt_) * DR + 64 * h + 16 * cg; \
            _Pragma("unroll") for (int q = 0; q < 4; ++q) ab[d][q] = *(const v4u*)(ap + 4 * q); } \
        { const bf16* gp = Pb + (size_t)(V.rowbase + tt_) * PW + 1536 + 64 * h + 16 * cg; g0 = *(const v4u*)gp; g1 = *(const v4u*)(gp + 8); \
          const int pb_ = V.p < 2 ? 1 - V.p : 67 - V.p; car0 = CARb[(size_t)((V.b * 2 + 0) * NPOS + V.p) * DR + 64 * h + lane]; car1 = CARb[(size_t)((V.b * 2 + 1) * NPOS + pb_) * DR + 64 * h + lane]; } } while (0)
    int u = F.bid;
    if (u < NB * NPOS * 8) S3_PREFETCH(u);
    for (; u < NB * NPOS * 8; u += F.G) {
        SUnit U; s_unit(u, U); const int tt = U.t0 + t;
        v4u cab[2][4];
#pragma unroll
        for (int d = 0; d < 2; ++d)
#pragma unroll
            for (int q = 0; q < 4; ++q) cab[d][q] = ab[d][q];
        const v4u cg0 = g0, cg1 = g1; const float ccar0 = car0, ccar1 = car1;
        if (u + F.G < NB * NPOS * 8) S3_PREFETCH(u + F.G);
#pragma unroll
        for (int d = 0; d < 2; ++d) {
#pragma unroll
            for (int q = 0; q < 4; ++q) { f32x4 av, bv;
#pragma unroll
                for (int e = 0; e < 4; ++e) { const unsigned w = cab[d][q][e]; av[e] = __builtin_amdgcn_exp2f(bflo(w)); bv[e] = bfhi(w); }
                *(LAS f32x4*)(Al + t * 64 + 16 * cg + 4 * q) = av; *(LAS f32x4*)(Bl + t * 64 + 16 * cg + 4 * q) = bv; }
            __syncthreads();
            { float Pl = 1.f, Hl = 0.f;
#pragma unroll
              for (int s_ = 0; s_ < 16; ++s_) { const int tk = 16 * wave + (d ? 15 - s_ : s_); const float a = Al[tk * 64 + lane], bb = Bl[tk * 64 + lane]; Hl = a * Hl + bb; Pl *= a; }
              AGGW[(wave * 64 + lane) * 2] = Pl; AGGW[(wave * 64 + lane) * 2 + 1] = Hl; }
            __syncthreads();
            { float hst = d ? ccar1 : ccar0;
#pragma unroll
              for (int k = 0; k < 8; ++k) { const int w2 = d ? 7 - k : k; const bool before = d ? (w2 > wave) : (w2 < wave);
                  if (before) { const float pw = AGGW[(w2 * 64 + lane) * 2], hw = AGGW[(w2 * 64 + lane) * 2 + 1]; hst = pw * hst + hw; } }
#pragma unroll
              for (int s_ = 0; s_ < 16; ++s_) { const int tk = 16 * wave + (d ? 15 - s_ : s_); const float a = Al[tk * 64 + lane], bb = Bl[tk * 64 + lane]; hst = a * hst + bb;
                  if (d == 0) HS[tk * 64 + lane] = (unsigned short)f2bf(hst); else HS[tk * 64 + lane] = (unsigned short)f2bf(bf2f(HS[tk * 64 + lane]) + hst); } }
            __syncthreads();
        }
        { const LAS v4u* hp = (const LAS v4u*)(HS + t * 64 + 16 * cg); const v4u h0 = hp[0], h1 = hp[1];
          v4u o0, o1;
#pragma unroll
          for (int q = 0; q < 4; ++q) { o0[q] = pk2(bflo(h0[q]) * bflo(cg0[q]), bfhi(h0[q]) * bfhi(cg0[q])); o1[q] = pk2(bflo(h1[q]) * bflo(cg1[q]), bfhi(h1[q]) * bfhi(cg1[q])); }
          bf16* op = MIXb + (size_t)(U.rowbase + tt) * D + 512 + 64 * h + 16 * cg; *(v4u*)op = o0; *(v4u*)(op + 8) = o1; }
        __syncthreads();
    }
#undef S3_PREFETCH
}
__device__ __forceinline__ void s3_stream(Frame& F) {
    const GAS unsigned* ABb = (const GAS unsigned*)F_AB; const GAS float* CARb = (const GAS float*)F_CAR; const GAS bf16* Pb = (const GAS bf16*)F_P; GAS bf16* MIXb = (GAS bf16*)F_MIX; const int lane = F.lane;
    for (int u = F.bid * NWAVES + F.wave; u < NB * NPOS * 8; u += F.G * NWAVES) {
        const int h = u & 7, idx = u >> 3, b = idx / NPOS, p = idx - b * NPOS; const bool isctx = p < 2;
        const int row0 = (isctx ? ML + b * CTXL + 128 * p : b * SEQ + 128 * (p - 2)); const int pb = p < 2 ? 1 - p : 67 - p; const int c = 64 * h + lane;
        const GAS unsigned* abf = ABb + (size_t)row0 * DR + c; const GAS unsigned* abb = ABb + ((size_t)M + row0) * DR + c;
        const GAS bf16* gp = Pb + (size_t)row0 * PW + 1536 + c; GAS bf16* op = MIXb + (size_t)row0 * D + 512 + c;
        float hf[128];
        float hst = CARb[(size_t)((b * 2 + 0) * NPOS + p) * DR + c];
#pragma unroll
        for (int bt = 0; bt < 8; ++bt) { unsigned w[16];
#pragma unroll
            for (int i = 0; i < 16; ++i) w[i] = abf[(size_t)(16 * bt + i) * DR];
#pragma unroll
            for (int i = 0; i < 16; ++i) { hst = __builtin_amdgcn_exp2f(bflo(w[i])) * hst + bfhi(w[i]); hf[16 * bt + i] = hst; } }
        hst = CARb[(size_t)((b * 2 + 1) * NPOS + pb) * DR + c];
#pragma unroll
        for (int bt = 7; bt >= 0; --bt) { unsigned w[16]; unsigned short g[16]; float o[16];
#pragma unroll
            for (int i = 0; i < 16; ++i) { w[i] = abb[(size_t)(16 * bt + i) * DR]; g[i] = gp[(size_t)(16 * bt + i) * PW]; }
#pragma unroll
            for (int i = 15; i >= 0; --i) { hst = __builtin_amdgcn_exp2f(bflo(w[i])) * hst + bfhi(w[i]); o[i] = (hf[16 * bt + i] + hst) * bf2f(g[i]); }
#pragma unroll
            for (int i = 0; i < 16; ++i) op[(size_t)(16 * bt + i) * D] = (bf16)f2bf(o[i]); }
    }
}
__device__ __forceinline__ void s2_carry(Frame& F) {
    const int gw = F.bid * NWAVES + F.wave; if (gw >= NB * 2 * 8) return;
    const int b = gw >> 4, d = (gw >> 3) & 1, h = gw & 7;
    const float* ag = F_AGG + ((size_t)(b * 2 + d) * NPOS * DR + 64 * h + F.lane) * 2; float* car = F_CAR + (size_t)(b * 2 + d) * NPOS * DR + 64 * h + F.lane;
    float hst = 0.f;
#pragma unroll 1
    for (int p0 = 0; p0 < NPOS; p0 += 22) { float pa[22], ha[22];
#pragma unroll
        for (int k = 0; k < 22; ++k) { pa[k] = ag[(size_t)(p0 + k) * DR * 2]; ha[k] = ag[(size_t)(p0 + k) * DR * 2 + 1]; }
#pragma unroll
        for (int k = 0; k < 22; ++k) { car[(size_t)(p0 + k) * DR] = hst; hst = pa[k] * hst + ha[k]; } }
}

__device__ __forceinline__ void moe_dispatch(Frame& F, int moe) {
    LAS int* tab = (LAS int*)(F.lds + 131072 + 1024);
    if (F.tid == 0) { int off = 0; for (int e = 0; e < NE; ++e) { const int c = (int)__hip_atomic_load(F.ctl + CW_CNT + moe * 512 + e * 64, RLX_AGENT); tab[16 + e] = c; tab[32 + e] = off; off += (c + 255) & ~255; } tab[40] = off; }
    __syncthreads();
    const int total = tab[40]; const bf16* HNb = F_HN; bf16* HS = F_Y; const int* list = F_LIST;
    for (int s0 = (F.bid * NWAVES + F.wave) * 4; s0 < total; s0 += F.G * NWAVES * 4) {
        v4u a[4], b[4];
#pragma unroll
        for (int q = 0; q < 4; ++q) { const int s_ = s0 + q; a[q] = (v4u){0u, 0u, 0u, 0u}; b[q] = a[q];
            int e = 0;
#pragma unroll
            for (int k = 1; k < NE; ++k) e += (s_ >= tab[32 + k]) ? 1 : 0;
            const int rank = s_ - tab[32 + e];
            if (s_ < total && rank < tab[16 + e]) { const int tok = list[(size_t)e * M + rank]; const bf16* src = HNb + (size_t)tok * D + 16 * F.lane; a[q] = *(const v4u*)src; b[q] = *(const v4u*)(src + 8); } }
#pragma unroll
        for (int q = 0; q < 4; ++q) { const int s_ = s0 + q; if (s_ < total) { bf16* dst = HS + (size_t)s_ * D + 16 * F.lane; *(v4u*)dst = a[q]; *(v4u*)(dst + 8) = b[q]; } }
    }
}
__device__ __forceinline__ void combine_rows(Frame& F, int moe, int lc, bool latent_only) {
    LAS int* OFFS = (LAS int*)(F.lds + 32768 + 8192 + 128);
    if (F.tid == 0) { int o = 0; for (int e = 0; e < NE; ++e) { OFFS[e] = o; const int c = (int)__hip_atomic_load(F.ctl + CW_CNT + moe * 512 + e * 64, RLX_AGENT); o += (c + 255) & ~255; } }
    __syncthreads();
    const unsigned* INFOb = F_INFO + (size_t)moe * M * 8; const bf16* Yb = F_Y; const float* MODb = F_MOD + (size_t)lc * 5 * (6 * D) + 5 * D;
    bf16* XBb = F_XB;
    for (int i0 = F.wave; i0 < ROWS_PER_WG; i0 += 2 * NWAVES) {
        int rr[2]; bool on[2]; int e1[2], q1[2], e2[2], q2[2]; float g1[2], g2[2];
#pragma unroll
        for (int k = 0; k < 2; ++k) { const int i = i0 + k * NWAVES; rr[k] = F.bid * ROWS_PER_WG + i; on[k] = (i < ROWS_PER_WG) && !(latent_only && rr[k] >= ML);
            if (on[k]) { const unsigned* inf = INFOb + (size_t)rr[k] * 8; e1[k] = (int)inf[0]; q1[k] = (int)inf[1]; e2[k] = (int)inf[2]; q2[k] = (int)inf[3]; g1[k] = __builtin_bit_cast(float, inf[4]); g2[k] = __builtin_bit_cast(float, inf[5]); } }
        v2u xw[2][4], ya[2][4], yb[2][4];
#pragma unroll
        for (int k = 0; k < 2; ++k) if (on[k]) {
            const int s1 = OFFS[__builtin_amdgcn_readfirstlane(e1[k])] + __builtin_amdgcn_readfirstlane(q1[k]), s2 = OFFS[__builtin_amdgcn_readfirstlane(e2[k])] + __builtin_amdgcn_readfirstlane(q2[k]);
            const bf16* y1 = Yb + (size_t)s1 * D, * y2 = Yb + (size_t)s2 * D; const bf16* xs = XBb + (size_t)rr[k] * D;
#pragma unroll
            for (int j = 0; j < 4; ++j) { const int col = 4 * F.lane + 256 * j; xw[k][j] = *(const v2u*)(xs + col); ya[k][j] = *(const v2u*)(y1 + col); yb[k][j] = *(const v2u*)(y2 + col); } }
#pragma unroll
        for (int k = 0; k < 2; ++k) if (on[k]) {
            const int bb = rr[k] < ML ? (rr[k] >> 13) : 4; const float* gf = MODb + (size_t)bb * (6 * D); bf16* xs = XBb + (size_t)rr[k] * D; const float ga = g1[k], gb = g2[k];
#pragma unroll
            for (int j = 0; j < 4; ++j) { const int col = 4 * F.lane + 256 * j; const f32x4 gv = *(const f32x4*)(gf + col); const v2u x = xw[k][j], a = ya[k][j], b = yb[k][j];
                const f32x4 xv = (f32x4){bflo(x.x), bfhi(x.x), bflo(x.y), bfhi(x.y)};
                f32x4 yy; yy.x = ga * bflo(a.x) + gb * bflo(b.x); yy.y = ga * bfhi(a.x) + gb * bfhi(b.x); yy.z = ga * bflo(a.y) + gb * bflo(b.y); yy.w = ga * bfhi(a.y) + gb * bfhi(b.y);
                const f32x4 xn = xv + gv * yy; v2u o; o.x = pk2(xn.x, xn.y); o.y = pk2(xn.z, xn.w); *(v2u*)(xs + col) = o; } }
    }
    asm volatile("s_waitcnt vmcnt(0)" ::: "memory");
    __syncthreads();
    if (F.tid == 0) { __builtin_amdgcn_fence(__ATOMIC_RELEASE, "agent"); __builtin_amdgcn_fence(__ATOMIC_ACQUIRE, "agent"); asm volatile("s_waitcnt vmcnt(0)" ::: "memory"); }
    __syncthreads();
}
#define DIAG 0
__device__ __forceinline__ bool phase_enter(Frame& F) { int ln = (int)__builtin_amdgcn_mbcnt_hi(~0u, __builtin_amdgcn_mbcnt_lo(~0u, 0u)); asm volatile("" : "+v"(ln)); int wv = F.wave0; asm volatile("" : "+s"(wv));
    F.lane = ln; F.wave = wv; F.tid = wv * 64 + ln;     int bi_ = blockIdx.x; asm volatile("" : "+s"(bi_)); F.bid = bi_; GAS unsigned char* w = F.ws_g; asm volatile("" : "+s"(w)); F.ws_g = w; GAS float* o = F.out_g; asm volatile("" : "+s"(o)); F.out_g = o; return true; }
__device__ __forceinline__ bool phase_runs(int lo, int hi, int ph) { asm volatile("" : "+s"(ph)); return lo <= ph && ph < hi; }
constexpr int PH_PER_LAYER = 10, NPH = 1 + DEPTH * PH_PER_LAYER + 1;
__global__ void __launch_bounds__(NTHREADS, 2) fwd_kernel(Args args) {
    extern __shared__ __attribute__((aligned(16))) unsigned char lds_raw[];
    Frame F;
    F.lds = (LAS unsigned char*)0;
    if (args.ph_lo < -1) lds_raw[0] = 0;
    F.MISC = (volatile LAS unsigned*)(F.lds + MISC_OFF);
    F.tid = threadIdx.x; F.lane = F.tid & 63; F.wave = __builtin_amdgcn_readfirstlane(F.tid >> 6); F.wave0 = F.wave; F.bid = blockIdx.x; F.G = gridDim.x;
    F.out_g = (GAS float*)args.out; F.ws_g = (GAS unsigned char*)args.ws; unsigned char* ws = args.ws;
    F.ctl = (gu32*)(ws + WS_CTL);
    for (int u = F.tid; u < 64; u += NTHREADS) F.MISC[u] = 0u;
    if (F.tid == 0) { volatile LAS unsigned long long* tb = (volatile LAS unsigned long long*)(F.lds + INTAB_OFF);
#pragma unroll
        for (int i = 0; i < N_IN; ++i) tb[i] = (unsigned long long)args.in[i]; }
    __syncthreads();
#if MK_ONE_LAUNCH
    XcdBarrier bar = xcd_barrier_post((unsigned*)(F.ctl + CW_BAR), F.MISC + 8);
#define GRID_BAR() xcd_barrier(bar)
#else
#define GRID_BAR() do { if (F.tid == 0) __hip_atomic_store(F.ctl + CW_TMO, 0xBADBA0u, RLX_AGENT); } while (0)
#endif
    const int lo = args.ph_lo, hi = args.ph_hi;
    int ph = 0;
#define RUNS() (phase_runs(lo, hi, ph) && phase_enter(F))
#define SEAM() do { if (ph + 1 < hi) GRID_BAR(); } while (0)

    if (RUNS()) { p0_prologue(F);
#if REPEAT == 1
        GRID_BAR(); p0_prologue(F);
#endif
        SEAM(); } ++ph;
    for (int l = 0; l < DEPTH; ++l) {
        const bool first = (l == 0);
        const float* modl = F_MOD + (size_t)l * 5 * (6 * D);
        if (RUNS()) {
#if DIAG
            if (l == 2) { diag_comb_pre(F, 0, 1); }
            if (l == 0) {  }
#endif
            if (l == 2) combine_rows(F, 0, 1, false);
            n_phase<false>(F, l, 0, 0, first);
#if REPEAT == 2
            if (l != 2) { GRID_BAR(); n_phase<false>(F, l, 0, 0, first); }
#endif
#if REPEAT == 12
            if (l == 2) { GRID_BAR(); convert_moe_range(F, 1, 0, MOE_ITEMS, F.bid, F.G); }
#endif
#if DIAG
            if (l == 2) { __syncthreads(); diag_comb_post(F, false, 7); }
#endif

            SEAM(); } ++ph;
        if (RUNS()) {
#if FAST_GEMM & 1
            { pg8::ProbDense S; S.A = F_HN; S.Bt = F_WIN + (size_t)l * DIN * D; S.K = D; S.ord.init(M / 256, DIN / 256, F.G, F.bid, WGM_G1); pg8::EpiP E{F_P}; pg8::gemm_phase(F.lds, S, E, F.tid);
              if (l == 0) tail_convert(F, S.ord.nwg, 0, 0, TAIL0_A); else if (l == 1) tail_convert(F, S.ord.nwg, 0, TAIL0_B, TAIL0_END); else if (l == 2) tail_convert(F, S.ord.nwg, 1, TAIL1_A, TAIL1_B);
#if REPEAT == 6
              GRID_BAR(); pg8::gemm_phase(F.lds, S, E, F.tid);
#endif
            }
#else
            NG g{}; g.A = F_HN; g.lda = D; g.ridx = nullptr; g.nvalid = 0; g.arow0 = 0; g.Bt = F_WIN + (size_t)l * DIN * D; g.K = D; g.nrows = M; g.O = F_P; g.ldo = PW; g.orow0 = 0;
            g.ncols = 512; g.pcol0 = 0; g.pair = 0; g.mode = 0; g.ocol0 = 0; gemm_naive(F, g);
            g.pcol0 = 512; g.pair = 1; g.mode = 2; g.ocol0 = 512; gemm_naive(F, g);
            g.pcol0 = 1536; g.pair = 0; g.mode = 0; g.ocol0 = 1024; gemm_naive(F, g);
            g.pcol0 = 2048; g.pair = 0; g.mode = 1; g.ocol0 = 1536; gemm_naive(F, g);
#endif
            SEAM(); } ++ph;
        if (RUNS()) {
#if FAST_SCAN
            s1_phase(F, l);
#if REPEAT == 3
            GRID_BAR(); s1_phase(F, l);
#endif
#if REPEAT == 13
            GRID_BAR(); sa_mx(F, l);
#endif
#else
            sa_xr_conv(F, l); sa_mx(F, l);
#endif
            SEAM(); } ++ph;
        if (RUNS()) {
#if FAST_SCAN
            s2_carry(F); sa_mx(F, l);
#if REPEAT == 4
            GRID_BAR(); s2_carry(F);
#endif
#else
            sb_scan_naive(F, l);
#endif
            SEAM(); } ++ph;
        if (RUNS()) {
#if FAST_SCAN
            s3r_phase(F);
#if REPEAT == 5
            GRID_BAR(); s3r_phase(F);
#endif
#else
            sc_combine(F);
#endif
            SEAM(); } ++ph;
        if (RUNS()) {
#if FAST_GEMM & 2
            { pg8::ProbDense S; S.A = F_MIX; S.Bt = F_WOUT + (size_t)l * D * D; S.K = D; S.ord.init(ML / 256, D / 256, F.G, F.bid, WGM_G2);
              if (first) { pg8::EpiRes<true> E{INP(I_X), F_XB, modl + 2 * D}; pg8::gemm_phase(F.lds, S, E, F.tid); } else { pg8::EpiRes<false> E{nullptr, F_XB, modl + 2 * D}; pg8::gemm_phase(F.lds, S, E, F.tid); }
#if REPEAT == 20
              GRID_BAR(); { pg8::EpiRes<false> E{nullptr, F_XB, (const float*)(((unsigned char*)F.ws_g) + 128 * 1024)}; pg8::gemm_phase(F.lds, S, E, F.tid); }
#endif
            }
            if (l != DEPTH - 1) gemm_ctx_res(F, F_MIX, D, F_WOUT + (size_t)l * D * D, D, first, modl + 4 * (6 * D) + 2 * D);
#else
            NG g{}; g.A = F_MIX; g.lda = D; g.Bt = F_WOUT + (size_t)l * D * D; g.K = D; g.nrows = M; g.ncols = D; g.mode = 4; g.xl_src = xl_src; g.xc_src = xc_src; g.gate = modl + 2 * D;
            gemm_naive(F, g);
#endif
            SEAM(); } ++ph;
        if (RUNS()) { if (l & 1) n_phase<true>(F, l, 1, l >> 1, false); else { n_phase<false>(F, l, 1, 0, false); if (l == 2) convert_moe_range(F, 1, TAIL1_C, MOE_ITEMS, F.bid, F.G);
#if REPEAT == 11
            GRID_BAR(); n_phase<false>(F, l, 1, 0, false);
#endif
            } SEAM(); } ++ph;
        if (RUNS()) { if ((l & 1) && !MOE_GATHER) {
            moe_dispatch(F, l >> 1);
#if REPEAT == 7
            GRID_BAR(); moe_dispatch(F, l >> 1);
#endif
            SEAM(); } } ++ph;
        if (RUNS()) {
#if DIAG
#endif
            if (!(l & 1)) {
#if FAST_GEMM & 4
                pg8::ProbDense S; S.A = F_HN; S.Bt = F_WDGU + (size_t)(l >> 1) * 2 * FD * D; S.K = D; S.ord.init(M / 256, 2 * FD / 256, F.G, F.bid, WGM_WIDE); pg8::EpiGLU E{F_HID, FD}; pg8::gemm_phase(F.lds, S, E, F.tid);
                if (l == 0) tail_convert(F, S.ord.nwg, 0, TAIL0_A, TAIL0_B); else tail_convert(F, S.ord.nwg, 1, TAIL1_B, TAIL1_C);
#if REPEAT == 8
                GRID_BAR(); pg8::gemm_phase(F.lds, S, E, F.tid);
#endif
#else
                NG g{}; g.A = F_HN; g.lda = D; g.Bt = F_WDGU + (size_t)(l >> 1) * 2 * FD * D; g.K = D; g.nrows = M; g.ncols = FD; g.pair = 1; g.mode = 3; g.O = F_HID; g.ldo = FD; gemm_naive(F, g);
#endif
            } else {
#if FAST_GEMM & 16
                LAS int* tab = (LAS int*)(F.lds + 131072 + 1024);
                if (F.tid == 0) { int tp = 0, off = 0; for (int e = 0; e < NE; ++e) { const int c = (int)__hip_atomic_load(F.ctl + CW_CNT + (l >> 1) * 512 + e * 64, RLX_AGENT); tab[e] = tp; tab[16 + e] = c; tab[32 + e] = off; tp += (c + 255) >> 8; off += (c + 255) & ~255; } tab[8] = tp; }
                __syncthreads();
                pg8::ProbMoeT<(MOE_GATHER != 0)> S; S.A = MOE_GATHER ? F_HN : F_Y  ; S.Bt = F_WMGU; S.list = F_LIST; S.tab_ = tab; S.K = D; S.bt_rows = 2 * FM; S.up = (MOE_GATHER != 0); S.ord.init(__builtin_amdgcn_readfirstlane(tab[8]), 2 * FM / 256, F.G, F.bid, WGM_WIDE);
                pg8::EpiGLU E{F_HID, FM}; pg8::gemm_phase(F.lds, S, E, F.tid);
#if REPEAT == 9
                GRID_BAR(); pg8::gemm_phase(F.lds, S, E, F.tid);
#endif
#else
                int off = 0;
                for (int e = 0; e < NE; ++e) { const int c = (int)__hip_atomic_load(F.ctl + CW_CNT + (l >> 1) * 512 + e * 64, RLX_AGENT); const int nr = (c + 255) & ~255;
                    NG g{}; g.A = F_HN; g.lda = D; g.ridx = F_LIST + (size_t)e * M; g.nvalid = c; g.Bt = F_WMGU + (size_t)e * 2 * FM * D; g.K = D; g.nrows = nr; g.ncols = FM; g.pair = 1; g.mode = 3; g.O = F_HID; g.ldo = FM; g.orow0 = off;
                    if (c > 0) gemm_naive(F, g); off += nr; }
#endif
            }
            SEAM(); } ++ph;
        if (RUNS()) {
            if (!(l & 1)) {
#if FAST_GEMM & 8
                pg8::ProbDense S; S.A = F_HID; S.Bt = F_WDD + (size_t)(l >> 1) * D * FD; S.K = FD; S.ord.init(ML / 256, D / 256, F.G, F.bid, WGM_G4); pg8::EpiRes<false> E{nullptr, F_XB, modl + 5 * D}; pg8::gemm_phase(F.lds, S, E, F.tid);
#if REPEAT == 21
                GRID_BAR(); { pg8::EpiRes<false> E2{nullptr, F_XB, (const float*)(((unsigned char*)F.ws_g) + 128 * 1024)}; pg8::gemm_phase(F.lds, S, E2, F.tid); }
#endif
                gemm_ctx_res(F, F_HID, FD, F_WDD + (size_t)(l >> 1) * D * FD, FD, false, modl + 4 * (6 * D) + 5 * D);
#else
                NG g{}; g.A = F_HID; g.lda = FD; g.Bt = F_WDD + (size_t)(l >> 1) * D * FD; g.K = FD; g.nrows = M; g.ncols = D; g.mode = 4; g.xl_src = ((float*)F.out_g); g.xc_src = F_XC; g.gate = modl + 5 * D; gemm_naive(F, g);
#endif
            } else {
#if FAST_GEMM & 32
                LAS int* tab = (LAS int*)(F.lds + 131072 + 1024);
                if (F.tid == 0) { int tp = 0, off = 0; for (int e = 0; e < NE; ++e) { const int c = (int)__hip_atomic_load(F.ctl + CW_CNT + (l >> 1) * 512 + e * 64, RLX_AGENT); tab[e] = tp; tab[16 + e] = c; tab[32 + e] = off; tp += (c + 255) >> 8; off += (c + 255) & ~255; } tab[8] = tp; }
                __syncthreads();
                pg8::ProbMoeT<false> S; S.A = F_HID; S.Bt = F_WMD; S.list = F_LIST; S.tab_ = tab; S.K = FM; S.bt_rows = D; S.up = false; S.ord.init(__builtin_amdgcn_readfirstlane(tab[8]), D / 256, F.G, F.bid, WGM_DEEPK);
                pg8::EpiBf E{F_Y, D}; pg8::gemm_phase(F.lds, S, E, F.tid);
                if (l == 1) tail_convert(F, S.ord.nwg, 1, 0, TAIL1_A);
#if REPEAT == 10
                GRID_BAR(); pg8::gemm_phase(F.lds, S, E, F.tid);
#endif
#else
                int off = 0;
                for (int e = 0; e < NE; ++e) { const int c = (int)__hip_atomic_load(F.ctl + CW_CNT + (l >> 1) * 512 + e * 64, RLX_AGENT); const int nr = (c + 255) & ~255;
                    NG g{}; g.A = F_HID; g.lda = FM; g.arow0 = off; g.Bt = F_WMD + (size_t)e * D * FM; g.K = FM; g.nrows = nr; g.ncols = D; g.mode = 0; g.O = F_Y; g.ldo = D; g.orow0 = off;
                    if (c > 0) gemm_naive(F, g); off += nr; }
#endif
            }
            SEAM(); } ++ph;
    }
    if (RUNS()) {
#if DIAG
        diag_comb_pre(F, 1, DEPTH - 1);
#endif
        combine_rows(F, 1, DEPTH - 1, true);
        n_phase<false>(F, 0, 2, 0, false);
#if DIAG
        __syncthreads();
        { const unsigned fs = __hip_atomic_load(F.ctl + CW_FLAG + 64, RLX_AGENT), fc = __hip_atomic_load(F.ctl + CW_FLAG + 128, RLX_AGENT); const unsigned fo = __hip_atomic_load(F.ctl + CW_FLAG + 192, RLX_AGENT); const unsigned tot = fs + fc + fo + 1u; const unsigned fl = (fs * 100u / tot) + 1000u * (fc * 100u / tot) + 1000000u * (fo * 100u / tot);     if (fl) { __syncthreads(); const float sc = 1.0f + (float)fl;
            for (int i = F.wave; i < ROWS_PER_WG; i += NWAVES) { const int r = F.bid * ROWS_PER_WG + i; if (r < ML) { for (int c = F.lane; c < D; c += 64) ((float*)F.out_g)[(size_t)r * D + c] *= sc; } } } }
#endif
    } ++ph;
}

extern "C" void kernel_launch(void* const* d_in, const int* in_sizes, int n_in, void* d_out, int out_size, void* d_ws, size_t ws_size, hipStream_t stream) {
    static int grid = 0;
    if (grid == 0) {
        if (n_in != N_IN || in_sizes[0] != ML * D || out_size != ML * D || ws_size < WS_END) { fprintf(stderr, "kernel_launch: unexpected shapes (n_in %d, in0 %d, out %d, ws %zu)\n", n_in, n_in > 0 ? in_sizes[0] : -1, out_size, ws_size); grid = -1; return; }
        int dev = 0, cus = 0, per_cu = 0;
        if (hipGetDevice(&dev) != hipSuccess || hipDeviceGetAttribute(&cus, hipDeviceAttributeMultiprocessorCount, dev) != hipSuccess) { grid = -1; return; }
        if (hipFuncSetAttribute((const void*)fwd_kernel, hipFuncAttributeMaxDynamicSharedMemorySize, LDS_BYTES) != hipSuccess) { fprintf(stderr, "kernel_launch: hipFuncSetAttribute failed\n"); grid = -1; return; }
        if (hipOccupancyMaxActiveBlocksPerMultiprocessor(&per_cu, (const void*)fwd_kernel, NTHREADS, LDS_BYTES) != hipSuccess || per_cu < 1) fprintf(stderr, "kernel_launch: occupancy query reports %d\n", per_cu);
        (void)hipGetLastError();
        grid = cus;
        if (grid != 256) { fprintf(stderr, "kernel_launch: built for 256 CUs, device has %d\n", cus); grid = -1; return; }
    }
    if (grid < 0) return;
    (void)hipMemsetAsync((char*)d_ws + WS_CTL, 0, CTL_ZERO_BYTES, stream);
    Args a{};
    for (int i = 0; i < N_IN; ++i) a.in[i] = (const float*)d_in[i];
    a.out = (float*)d_out; a.ws = (unsigned char*)d_ws;
#if MK_ONE_LAUNCH
    a.ph_lo = 0; a.ph_hi = NPH;
    hipLaunchKernelGGL(fwd_kernel, dim3(grid), dim3(NTHREADS), LDS_BYTES, stream, a);
#else
    for (int p = 0; p < NPH; ++p) { a.ph_lo = p; a.ph_hi = p + 1; hipLaunchKernelGGL(fwd_kernel, dim3(grid), dim3(NTHREADS), LDS_BYTES, stream, a); }
#endif
}
```

```cpp
#include <hip/hip_runtime.h>
#include <cstdio>
#include <cstdint>

#ifndef FAST_GEMM
#define FAST_GEMM 63
#endif
#ifndef FAST_SCAN
#define FAST_SCAN 1
#endif
#ifndef ALT_MOD
#define ALT_MOD 0
#endif
#ifndef REPEAT
#define REPEAT 0
#endif
#ifndef EPI2
#define EPI2 0
#endif
#ifndef STORE_AB
#define STORE_AB 1
#endif
#ifndef MOE_GATHER
#define MOE_GATHER 1
#endif
#ifndef WGM_DEEPK
#define WGM_DEEPK 2
#endif
#ifndef WGM_WIDE
#define WGM_WIDE 4
#endif
#ifndef PG8_SP2
#define PG8_SP2 1
#endif
#ifndef WGM_G1
#define WGM_G1 2
#endif
#ifndef WGM_G2
#define WGM_G2 4
#endif
#ifndef WGM_G4
#define WGM_G4 8
#endif
#ifndef MK_ONE_LAUNCH
#define MK_ONE_LAUNCH 1
#endif

constexpr int D = 1024, NB = 4, SEQ = 8192, CTXL = 256, ML = NB * SEQ, MC = NB * CTXL, M = ML + MC;
constexpr int DIN = 2560, PW = 2048, FD = 2816, FM = 3584, NE = 8, DEPTH = 4;
constexpr int DR = 512;
constexpr int NSLOT = 69632;
constexpr float EPS = 1e-6f;
constexpr int NWAVES = 8, NTHREADS = 512;
constexpr int ROWS_PER_WG = 132;

constexpr size_t MiB = 1u << 20;
constexpr size_t WS_CTL = 0, CTL_ZERO_BYTES = (REPEAT == 20 || REPEAT == 21) ? 256 * 1024 : 64 * 1024;
constexpr size_t WS_MOD = 1 * MiB;
constexpr size_t WS_LRUK = 1 * MiB + 512 * 1024;
constexpr size_t WS_INFO = 2 * MiB;
constexpr size_t WS_LIST = 5 * MiB;
constexpr size_t WS_AGG = 7 * MiB;
constexpr size_t WS_XC = 10 * MiB;
constexpr size_t WS_WGATE = 14 * MiB;
constexpr size_t WS_WIN = 15 * MiB;
constexpr size_t WS_WOUT = 35 * MiB;
constexpr size_t WS_WDGU = 43 * MiB;
constexpr size_t WS_WDD = 65 * MiB;
constexpr size_t WS_WMGU = 76 * MiB;
constexpr size_t WS_WMD = 188 * MiB;
constexpr size_t WS_HN = 244 * MiB;
constexpr size_t WS_Y = 310 * MiB;
constexpr size_t WS_BIG = 446 * MiB;
constexpr size_t WS_P = WS_BIG;
constexpr size_t WS_MIX = WS_BIG + 132 * MiB;
constexpr size_t WS_AB = WS_BIG + 198 * MiB;
constexpr size_t WS_XR = WS_BIG + 198 * MiB;
constexpr size_t WS_HF = WS_BIG + 264 * MiB;
constexpr size_t WS_HB = WS_BIG + 330 * MiB;
constexpr size_t WS_CAR = 922 * MiB;
constexpr size_t WS_XB = 924 * MiB;
constexpr size_t WS_END = 990 * MiB;
constexpr int CW_TMO = 0;
constexpr int CW_CNT = 1024;
constexpr int CW_SPLIT = 3200;
constexpr int CW_BAR = 4096;

constexpr int LDS_BYTES = 155648;
constexpr int GIDX_OFF = 147456;
constexpr int MISC_OFF = 131072 + 8192;

#define GAS __attribute__((address_space(1)))
#define LAS __attribute__((address_space(3)))
typedef unsigned short bf16;
typedef unsigned v4u __attribute__((ext_vector_type(4)));
typedef unsigned v2u __attribute__((ext_vector_type(2)));
typedef float f32x4 __attribute__((ext_vector_type(4)));
typedef short bf16x8 __attribute__((ext_vector_type(8)));
typedef GAS unsigned gu32;
#define RLX_AGENT __ATOMIC_RELAXED, __HIP_MEMORY_SCOPE_AGENT
#define LDS_WAIT() asm volatile("s_waitcnt lgkmcnt(0)" ::: "memory")
#define VM_WAIT() asm volatile("s_waitcnt vmcnt(0)" ::: "memory")
typedef float f32x2_t __attribute__((ext_vector_type(2)));
typedef double f64x2_t __attribute__((ext_vector_type(2)));
typedef __bf16 bf16x2_t __attribute__((ext_vector_type(2)));
__device__ __forceinline__ unsigned f2bf(float f) { return (unsigned)__builtin_bit_cast(unsigned short, (__bf16)f); }
__device__ __forceinline__ unsigned pk2(float lo, float hi) { const f32x2_t v = {lo, hi}; return __builtin_bit_cast(unsigned, __builtin_convertvector(v, bf16x2_t)); }
__device__ __forceinline__ float bf2f(unsigned b) { return __builtin_bit_cast(float, b << 16); }
__device__ __forceinline__ float bflo(unsigned w) { return __builtin_bit_cast(float, w << 16); }
__device__ __forceinline__ float bfhi(unsigned w) { return __builtin_bit_cast(float, w & 0xffff0000u); }
__device__ __forceinline__ float sigm(float x) { return __builtin_amdgcn_rcpf(1.f + __builtin_amdgcn_exp2f(-1.44269504089f * x)); }
__device__ __forceinline__ float sigm_p(float x) { return 1.0f / (1.0f + expf(-x)); }
__device__ __forceinline__ float silu_f(float x) { return x * sigm(x); }
__device__ __forceinline__ float gelu_tanh_f(float x) { return x * sigm(1.5957691216057308f * (x + 0.044715f * x * x * x)); }
__device__ __forceinline__ float wave_sum(float v) {
#pragma unroll
    for (int o = 1; o < 64; o <<= 1) v += __shfl_xor(v, o);
    return v;
}

#define XB_TMO      128
#define XB_XCNT(j)  (256  + 64 * (j))
#define XB_XSUB(j)  (1280 + 64 * (j))
#define XB_XGEN(j)  (2304 + 64 * (j))
#define XB_TOP      3328
#define XB_TOPGEN   3392
#define XCD_BAR_WORDS 3456
#define XB_SPIN_CAP (1u << 21)
__device__ __forceinline__ unsigned xb_ld(unsigned* p)              { return __hip_atomic_load(p, __ATOMIC_RELAXED, __HIP_MEMORY_SCOPE_AGENT); }
__device__ __forceinline__ unsigned xb_add(unsigned* p, unsigned v) { return __hip_atomic_fetch_add(p, v, __ATOMIC_RELAXED, __HIP_MEMORY_SCOPE_AGENT); }
__device__ __forceinline__ unsigned xb_xcc_id() { return (unsigned)__builtin_amdgcn_s_getreg((3 << 11) | 20) & 0xFu; }
#define XB_SPIN(cond, bar) do { unsigned _sp = 0; while (cond) { __builtin_amdgcn_s_sleep(1); \
    if ((++_sp & 255u) == 0u) { if (xb_ld(&(bar)[XB_TMO])) break; if (_sp > XB_SPIN_CAP) { atomicAdd(&(bar)[XB_TMO], 1u); break; } } } } while (0)
struct XcdBarrier { unsigned* bar; unsigned x; volatile LAS unsigned* st; };
__device__ __forceinline__ XcdBarrier xcd_barrier_post(unsigned* bar, volatile LAS unsigned* st) {
    XcdBarrier b; b.bar = bar; b.x = xb_xcc_id(); b.st = st;
    if (threadIdx.x == 0) (void)xb_add(&bar[XB_XCNT(b.x)], 1u);
    return b;
}
__device__ __forceinline__ void xcd_barrier_complete(unsigned* bar, unsigned x, unsigned& nloc, unsigned& nx) {
    const unsigned G = gridDim.x * gridDim.y * gridDim.z;
    unsigned sum, cnt, mine, sp = 0u;
    for (;;) {
        sum = 0u; cnt = 0u; mine = 0u;
#pragma unroll
        for (unsigned j = 0; j < 16; ++j) { const unsigned c = xb_ld(&bar[XB_XCNT(j)]); sum += c; cnt += (c > 0u) ? 1u : 0u; mine = (j == x) ? c : mine; }
        if (sum == G) break;
        __builtin_amdgcn_s_sleep(1);
        if ((++sp & 255u) == 0u) { if (xb_ld(&bar[XB_TMO])) break; if (sp > XB_SPIN_CAP) { atomicAdd(&bar[XB_TMO], 1u); break; } }
    }
    nloc = mine > 0u ? mine : 1u; nx = cnt > 0u ? cnt : 1u;
}
__device__ __forceinline__ void xcd_barrier(const XcdBarrier& b) {
    asm volatile("s_waitcnt vmcnt(0)" ::: "memory");
    __syncthreads();
    if (threadIdx.x == 0) {
        unsigned* bar = b.bar;
        __builtin_amdgcn_s_waitcnt(0);
        unsigned nloc = b.st[0], nx = b.st[1];
        if (nloc == 0u) { xcd_barrier_complete(bar, b.x, nloc, nx); b.st[0] = nloc; b.st[1] = nx; }
        const unsigned old = xb_add(&bar[XB_XSUB(b.x)], 1u);
        const unsigned gen = old / nloc;
        if (old + 1u == (gen + 1u) * nloc) {
            __builtin_amdgcn_fence(__ATOMIC_RELEASE, "agent");
            asm volatile("s_waitcnt vmcnt(0)" ::: "memory");
            const unsigned og = xb_add(&bar[XB_TOP], 1u);
            const unsigned tg = og / nx;
            if (og + 1u == (tg + 1u) * nx) xb_add(&bar[XB_TOPGEN], 1u);
            else XB_SPIN(xb_ld(&bar[XB_TOPGEN]) == tg, bar);
            __builtin_amdgcn_fence(__ATOMIC_ACQUIRE, "agent");
            xb_add(&bar[XB_XGEN(b.x)], 1u);
            asm volatile("s_waitcnt vmcnt(0)" ::: "memory");
        } else {
            XB_SPIN(xb_ld(&bar[XB_XGEN(b.x)]) == gen, bar);
            __builtin_amdgcn_fence(__ATOMIC_ACQUIRE, "agent");
            asm volatile("s_waitcnt vmcnt(0)" ::: "memory");
        }
    }
    __syncthreads();
}

enum { I_X = 0, I_C, I_CTX, I_CCTX, I_ADAW, I_ADAB, I_GMIX, I_GFFN, I_WIN, I_WOUT, I_CONVW, I_RCW, I_RCB, I_LWA, I_LBA, I_LWI, I_LBI, I_LAM,
       I_DWG, I_DWU, I_DWD, I_RW, I_RB, I_MWG, I_MWU, I_MWD, I_FG, N_IN };
struct Args { const float* in[N_IN]; float* out; unsigned char* ws; int ph_lo, ph_hi; };
struct Frame {
    LAS unsigned char* lds; volatile LAS unsigned* MISC; gu32* ctl;
    int tid, lane, wave, wave0, bid, G;
    GAS float* out_g; GAS unsigned char* ws_g;
};
constexpr int INTAB_OFF = MISC_OFF + 512;
__device__ __forceinline__ const float* in_ptr(const Frame& F, int i) { unsigned ad_ = (unsigned)(INTAB_OFF + 8 * i); asm volatile("" : "+v"(ad_));     const volatile LAS unsigned* t = (const volatile LAS unsigned*)(unsigned long)ad_; const unsigned lo = __builtin_amdgcn_readfirstlane(t[0]), hi = __builtin_amdgcn_readfirstlane(t[1]); return (const float*)(const GAS float*)(((unsigned long long)hi << 32) | lo); }
#define INP(i) in_ptr(F, (i))
#define WSP(T, off) ((T*)(F.ws_g + (off)))
#define F_MOD WSP(float, WS_MOD)
#define F_LRUK WSP(float, WS_LRUK)
#define F_INFO WSP(unsigned, WS_INFO)
#define F_LIST WSP(int, WS_LIST)
#define F_AGG WSP(float, WS_AGG)
#define F_XC WSP(float, WS_XC)
#define F_WGATE WSP(bf16, WS_WGATE)
#define F_WIN WSP(bf16, WS_WIN)
#define F_WOUT WSP(bf16, WS_WOUT)
#define F_WDGU WSP(bf16, WS_WDGU)
#define F_WDD WSP(bf16, WS_WDD)
#define F_WMGU WSP(bf16, WS_WMGU)
#define F_WMD WSP(bf16, WS_WMD)
#define F_HN WSP(bf16, WS_HN)
#define F_Y WSP(bf16, WS_Y)
#define F_HID WSP(bf16, WS_BIG)
#define F_P WSP(bf16, WS_P)
#define F_MIX WSP(bf16, WS_MIX)
#define F_XR WSP(float, WS_XR)
#define F_HF WSP(float, WS_HF)
#define F_HB WSP(float, WS_HB)
#define F_CAR WSP(float, WS_CAR)
#define F_AB WSP(unsigned, WS_AB)
#define F_XB WSP(bf16, WS_XB)

__device__ __forceinline__ void transpose_item(const float* W, int K, int N, bf16* WT, int k0, int n0, int dst_row0, LAS float* scr, int lane) {
    const int n4 = lane & 15, kr = lane >> 4;
    f32x4 v[16];
#pragma unroll
    for (int i = 0; i < 16; ++i) v[i] = __builtin_nontemporal_load((const f32x4*)(W + (size_t)(k0 + 4 * i + kr) * N + n0 + 4 * n4));
#pragma unroll
    for (int i = 0; i < 16; ++i) { LAS float* p = scr + (4 * i + kr) * 65 + 4 * n4; p[0] = v[i].x; p[1] = v[i].y; p[2] = v[i].z; p[3] = v[i].w; }
    LDS_WAIT(); asm volatile("" ::: "memory");
    const int c = lane & 7, nn = lane >> 3;
#pragma unroll
    for (int j = 0; j < 8; ++j) { const int n = nn + 8 * j; const LAS float* s = scr + (8 * c) * 65 + n;
        v4u o; o.x = pk2(s[0 * 65], s[1 * 65]); o.y = pk2(s[2 * 65], s[3 * 65]); o.z = pk2(s[4 * 65], s[5 * 65]); o.w = pk2(s[6 * 65], s[7 * 65]);
        *(GAS v4u*)(WT + (size_t)(dst_row0 + n) * K + k0 + 8 * c) = o; }
    LDS_WAIT(); asm volatile("" ::: "memory");
}
__device__ __forceinline__ int map_win(int n) { if (n < 512) return n; if (n < 1024) { const int j = n - 512; return 512 + 256 * (j >> 7) + (j & 127); } if (n < 1536) { const int j = n - 1024; return 512 + 256 * (j >> 7) + 128 + (j & 127); } return n; }
__device__ __forceinline__ int map_g(int n) { return 256 * (n >> 7) + (n & 127); }
__device__ __forceinline__ int map_u(int n) { return 256 * (n >> 7) + 128 + (n & 127); }

__device__ __forceinline__ bool transpose_group(int& it, const float* src, int nmat, int K, int N, bf16* dst, size_t dst_mat_stride, int mapkind, LAS float* scr, int lane) {
    const int nkb = K / 64, nnb = N / 64, per = nkb * nnb, tot = nmat * per;
    if (it >= tot) { it -= tot; return false; }
    const int mi = it / per, r = it % per, kb = r / nnb, nb = r % nnb, n0 = 64 * nb;
    const int d0 = mapkind == 0 ? n0 : (mapkind == 1 ? map_win(n0) : (mapkind == 2 ? map_g(n0) : map_u(n0)));
    transpose_item(src + (size_t)mi * K * N, K, N, dst + (size_t)mi * dst_mat_stride, 64 * kb, n0, d0, scr, lane);
    return true;
}
constexpr int TAIL0_A = 4200, TAIL0_B = 7600, TAIL0_END = 11800, TAIL1_A = 12000, TAIL1_B = 16200, TAIL1_C = 19600;
constexpr int TAIL0_UP = 18500, TAIL1_UP = 19600;
constexpr int MOE_ITEMS = 3 * NE * (D / 64) * (FM / 64);
__device__ __forceinline__ void convert_moe_range(Frame& F, int j, int lo, int hi, int kblk, int nblk) {
    LAS float* scr = (LAS float*)(F.lds + F.wave * 16640);
    constexpr int I_GU = NE * (D / 64) * (FM / 64);
    for (int it0 = lo + kblk * NWAVES + F.wave; it0 < hi; it0 += nblk * NWAVES) {
        int it = it0;
        if (transpose_group(it, INP(I_MWG) + (size_t)j * NE * D * FM, NE, D, FM, F_WMGU, (size_t)2 * FM * D, 2, scr, F.lane)) continue;
        if (transpose_group(it, INP(I_MWU) + (size_t)j * NE * D * FM, NE, D, FM, F_WMGU, (size_t)2 * FM * D, 3, scr, F.lane)) continue;
        transpose_group(it, INP(I_MWD) + (size_t)j * NE * FM * D, NE, FM, D, F_WMD, (size_t)D * FM, 0, scr, F.lane);
    }
}
__device__ __forceinline__ void tail_convert(Frame& F, int nwg, int j, int lo, int hi) {
    const int rem = nwg % F.G;
    if (rem == 0) convert_moe_range(F, j, lo, hi, F.bid, F.G);
    else if (F.bid >= rem) convert_moe_range(F, j, lo, hi, F.bid - rem, F.G - rem);
}
__device__ __forceinline__ void p0_prologue(Frame& F) {
    LAS float* S5 = (LAS float*)(F.lds + 0);
    LAS float* RED = (LAS float*)(F.lds + 20480);
    for (int i = F.tid; i < 5 * D; i += NTHREADS) { const float v = i < 4 * D ? INP(I_C)[i] : INP(I_CCTX)[i - 4 * D]; S5[i] = silu_f(v); }
    __syncthreads();
    for (int item = F.bid; item < DEPTH * 24; item += F.G) {
        const int l = item / 24, strip = item % 24;
        const float* wp = INP(I_ADAW) + ((size_t)l * D + 128 * F.wave) * (6 * D) + strip * 256 + 4 * F.lane;
        f32x4 a0 = (f32x4){0.f, 0.f, 0.f, 0.f}, a1 = a0, a2 = a0, a3 = a0, a4 = a0;
        const LAS float* s = S5 + 128 * F.wave;
#pragma unroll 16
        for (int kk = 0; kk < 128; ++kk) { const f32x4 wv = *(const f32x4*)(wp + (size_t)kk * (6 * D));
            a0 = a0 + wv * s[kk]; a1 = a1 + wv * s[D + kk]; a2 = a2 + wv * s[2 * D + kk]; a3 = a3 + wv * s[3 * D + kk]; a4 = a4 + wv * s[4 * D + kk]; }
        LAS f32x4* rw = (LAS f32x4*)RED + F.wave * 320 + F.lane;
        rw[0] = a0; rw[64] = a1; rw[128] = a2; rw[192] = a3; rw[256] = a4;
        __syncthreads();
        if (F.tid < 320) { f32x4 t = (f32x4){0.f, 0.f, 0.f, 0.f};
#pragma unroll
            for (int w = 0; w < 8; ++w) t = t + ((const LAS f32x4*)RED)[w * 320 + F.tid];
            const int r = F.tid >> 6, col = strip * 256 + 4 * (F.tid & 63);
            *(f32x4*)(F_MOD + ((size_t)l * 5 + r) * (6 * D) + col) = t + *(const f32x4*)(INP(I_ADAB) + l * 6 * D + col); }
        __syncthreads();
    }
#if ALT_MOD
    for (int idx = F.bid * NTHREADS + F.tid; idx < DEPTH * 5 * 6 * D; idx += F.G * NTHREADS) {
        const int l = idx / (5 * 6 * D), r = (idx / (6 * D)) % 5, col = idx % (6 * D);
        const float* cv = r < 4 ? INP(I_C) + r * D : INP(I_CCTX); const float* aw = INP(I_ADAW) + (size_t)l * D * (6 * D) + col;
        float acc = INP(I_ADAB)[l * 6 * D + col];
        for (int k = 0; k < D; ++k) { const float x = cv[k]; acc += (x / (1.0f + expf(-x))) * aw[(size_t)k * (6 * D)]; }
        F_MOD[idx] = acc; }
#endif
    { const int g = F.bid * NTHREADS + F.tid; if (g < DEPTH * 2 * DR) { const float lam = INP(I_LAM)[g]; F_LRUK[g] = 8.0f * log1pf(expf(-lam)) * 1.44269504089f; } }
    __syncthreads();
    LAS float* scr = (LAS float*)(F.lds + F.wave * 16640);
    constexpr int NMODWG = DEPTH * 24;
    const int gw = (F.bid >= NMODWG ? F.bid - NMODWG : F.G) * NWAVES + F.wave, NGW = (F.G - NMODWG) * NWAVES;
    constexpr int I_IN = DEPTH * (D / 64) * (DIN / 64), I_OUT = DEPTH * (D / 64) * (D / 64), I_DG = 2 * (D / 64) * (FD / 64), I_DD = 2 * (FD / 64) * (D / 64), I_LR = DEPTH * 2 * 8;
    constexpr int NIT = I_IN + I_OUT + 2 * I_DG + I_DD + 2 * I_LR;
    for (int it0 = gw; it0 < NIT && F.bid >= NMODWG; it0 += NGW) {
        int it = it0;
        if (transpose_group(it, INP(I_WIN), DEPTH, D, DIN, F_WIN, (size_t)DIN * D, 1, scr, F.lane)) continue;
        if (transpose_group(it, INP(I_WOUT), DEPTH, D, D, F_WOUT, (size_t)D * D, 0, scr, F.lane)) continue;
        if (transpose_group(it, INP(I_DWG), 2, D, FD, F_WDGU, (size_t)2 * FD * D, 2, scr, F.lane)) continue;
        if (transpose_group(it, INP(I_DWU), 2, D, FD, F_WDGU, (size_t)2 * FD * D, 3, scr, F.lane)) continue;
        if (transpose_group(it, INP(I_DWD), 2, FD, D, F_WDD, (size_t)D * FD, 0, scr, F.lane)) continue;
        if (transpose_group(it, INP(I_LWA), DEPTH * 2 * 8, 64, 64, F_WGATE, (size_t)2 * 64 * 64, 0, scr, F.lane)) continue;
        transpose_group(it, INP(I_LWI), DEPTH * 2 * 8, 64, 64, F_WGATE + 64 * 64, (size_t)2 * 64 * 64, 0, scr, F.lane);
    }
    convert_moe_range(F, 0, TAIL0_END, TAIL0_UP, F.bid, F.G);
}

template <bool ROUTE>
__device__ __forceinline__ void n_phase(Frame& F, int l, int kind, int moe, bool first) {
    LAS float* RWl = (LAS float*)(F.lds + 0);
    LAS float* RT = (LAS float*)(F.lds + 32768);
    LAS int* RK = (LAS int*)(F.lds + 32768 + 4096);
    LAS int* BASE = (LAS int*)(F.lds + 32768 + 8192);
    if (ROUTE) { const float* rw = INP(I_RW) + (size_t)moe * D * NE; for (int i = F.tid; i < D * NE; i += NTHREADS) RWl[i] = rw[i]; }
    __syncthreads();
    const float* gvec = kind == 2 ? INP(I_FG) : (kind == 0 ? INP(I_GMIX) + l * D : INP(I_GFFN) + l * D);
    const float* xin = INP(I_X); const float* cin = INP(I_CTX); const bf16* XBb = F_XB; float* outp = (float*)F.out_g;
    f32x4 mul[4], add[4], vn[4]; v2u vb[4];
    int cur_bb = -1; bool have_vn = false;
    const int row_base = F.bid * ROWS_PER_WG;
    for (int i = F.wave; i < ROWS_PER_WG; i += NWAVES) {
        const int r = row_base + i; const bool lat = r < ML;
        if (kind == 2 && !lat) { have_vn = false; continue; }
        if (ROUTE && l == DEPTH - 1 && !lat) {
            if (F.lane == 0) { int m1 = -1; asm volatile("" : "+v"(m1)); RT[i * 4 + 0] = __builtin_bit_cast(float, m1); RT[i * 4 + 1] = __builtin_bit_cast(float, m1); } have_vn = false; continue; }
        const int bb = lat ? (r >> 13) : 4;
        if (bb != cur_bb) { cur_bb = bb;
#pragma unroll
            for (int j = 0; j < 4; ++j) { const int col = 4 * F.lane + 256 * j; const f32x4 g = *(const f32x4*)(gvec + col);
                if (kind == 2) { mul[j] = g; add[j] = (f32x4){0.f, 0.f, 0.f, 0.f}; }
                else { const float* mp = F_MOD + ((size_t)l * 5 + bb) * (6 * D) + (kind == 0 ? 0 : 3) * D; const f32x4 sh = *(const f32x4*)(mp + col), sc = *(const f32x4*)(mp + D + col);
                    mul[j] = g * (sc + 1.0f); add[j] = sh; } } }
        f32x4 v[4];
        if (!have_vn) {
            if (first) { const float* xs = lat ? xin + (size_t)r * D : cin + (size_t)(r - ML) * D;
#pragma unroll
                for (int j = 0; j < 4; ++j) v[j] = *(const f32x4*)(xs + 4 * F.lane + 256 * j); }
            else {
#pragma unroll
                for (int j = 0; j < 4; ++j) { const v2u w = *(const v2u*)(XBb + (size_t)r * D + 4 * F.lane + 256 * j); v[j] = (f32x4){bflo(w.x), bfhi(w.x), bflo(w.y), bfhi(w.y)}; } } }
        else if (first) {
#pragma unroll
            for (int j = 0; j < 4; ++j) v[j] = vn[j]; }
        else {
#pragma unroll
            for (int j = 0; j < 4; ++j) v[j] = (f32x4){bflo(vb[j].x), bfhi(vb[j].x), bflo(vb[j].y), bfhi(vb[j].y)}; }
        { const int i2 = i + NWAVES, r2 = row_base + i2; have_vn = (i2 < ROWS_PER_WG) && !((kind == 2 || (ROUTE && l == DEPTH - 1)) && r2 >= ML);
          if (have_vn) {
              if (first) { const float* xs2 = r2 < ML ? xin + (size_t)r2 * D : cin + (size_t)(r2 - ML) * D;
#pragma unroll
                  for (int j = 0; j < 4; ++j) vn[j] = *(const f32x4*)(xs2 + 4 * F.lane + 256 * j); }
              else {
#pragma unroll
                  for (int j = 0; j < 4; ++j) vb[j] = *(const v2u*)(XBb + (size_t)r2 * D + 4 * F.lane + 256 * j); } } }
        float ss = 0.f;
#pragma unroll
        for (int j = 0; j < 4; ++j) ss += (v[j].x * v[j].x + v[j].y * v[j].y) + (v[j].z * v[j].z + v[j].w * v[j].w);
        const float rstd = 1.0f / sqrtf(wave_sum(ss) * (1.0f / D) + EPS);
        f32x4 hv[4];
#pragma unroll
        for (int j = 0; j < 4; ++j) hv[j] = v[j] * rstd * mul[j] + add[j];
        if (kind == 2) {
#pragma unroll
            for (int j = 0; j < 4; ++j) *(f32x4*)(outp + (size_t)r * D + 4 * F.lane + 256 * j) = hv[j];
        } else {
            bf16* hr = F_HN + (size_t)r * D;
#pragma unroll
            for (int j = 0; j < 4; ++j) { v2u o; o.x = pk2(hv[j].x, hv[j].y); o.y = pk2(hv[j].z, hv[j].w); *(v2u*)(hr + 4 * F.lane + 256 * j) = o; }
        }
        if (ROUTE) {
            float lg[8];
#pragma unroll
            for (int e = 0; e < 8; ++e) lg[e] = 0.f;
#pragma unroll
            for (int j = 0; j < 4; ++j)
#pragma unroll
                for (int q = 0; q < 4; ++q) { const float hx = hv[j][q]; const LAS f32x4* rp = (const LAS f32x4*)(RWl + (4 * F.lane + 256 * j + q) * 8); const f32x4 w0 = rp[0], w1 = rp[1];
                    lg[0] += hx * w0.x; lg[1] += hx * w0.y; lg[2] += hx * w0.z; lg[3] += hx * w0.w; lg[4] += hx * w1.x; lg[5] += hx * w1.y; lg[6] += hx * w1.z; lg[7] += hx * w1.w; }
#pragma unroll
            for (int e = 0; e < 8; ++e) lg[e] = wave_sum(lg[e]) + INP(I_RB)[moe * NE + e];
            int e1 = 0; float v1 = lg[0];
#pragma unroll
            for (int e = 1; e < 8; ++e) if (lg[e] > v1) { v1 = lg[e]; e1 = e; }
            int e2 = -1; float v2 = -3.0e38f;
#pragma unroll
            for (int e = 0; e < 8; ++e) if (e != e1 && lg[e] > v2) { v2 = lg[e]; e2 = e; }
            const float g1 = sigm(v1 - v2), g2 = 1.0f - g1;
            if (F.lane == 0) { RT[i * 4 + 0] = __builtin_bit_cast(float, e1); RT[i * 4 + 1] = __builtin_bit_cast(float, e2); RT[i * 4 + 2] = g1; RT[i * 4 + 3] = g2; }
        }
    }
    if (ROUTE) {
        __syncthreads();
        if (F.tid < NE) { const int e = F.tid; int c = 0;
            for (int i = 0; i < ROWS_PER_WG; ++i) { const int a = __builtin_bit_cast(int, RT[i * 4 + 0]), b = __builtin_bit_cast(int, RT[i * 4 + 1]);
                if (a == e) { RK[i * 2 + 0] = c; ++c; } if (b == e) { RK[i * 2 + 1] = c; ++c; } }
            BASE[e] = (int)__hip_atomic_fetch_add(F.ctl + CW_CNT + moe * 512 + e * 64, (unsigned)c, RLX_AGENT); }
        __syncthreads();
        if (F.tid < ROWS_PER_WG) { const int i = F.tid, r = row_base + i;
            const int e1 = __builtin_bit_cast(int, RT[i * 4 + 0]), e2 = __builtin_bit_cast(int, RT[i * 4 + 1]);
            if (e1 >= 0) {
            const int r1 = BASE[e1] + RK[i * 2 + 0], r2 = BASE[e2] + RK[i * 2 + 1];
            unsigned* inf = F_INFO + ((size_t)moe * M + r) * 8;
            v4u o0; o0.x = (unsigned)e1; o0.y = (unsigned)r1; o0.z = (unsigned)e2; o0.w = (unsigned)r2; *(v4u*)inf = o0;
            v4u o1; o1.x = __builtin_bit_cast(unsigned, RT[i * 4 + 2]); o1.y = __builtin_bit_cast(unsigned, RT[i * 4 + 3]); o1.z = 0u; o1.w = 0u; *(v4u*)(inf + 4) = o1;
            F_LIST[(size_t)e1 * M + r1] = r; F_LIST[(size_t)e2 * M + r2] = r; } }
    }
    __syncthreads();
}

struct NG { const bf16* A; int lda; const int* ridx; int nvalid; int arow0; const bf16* Bt; int K; int nrows, ncols, pcol0; int pair, mode;
            bf16* O; int ldo, orow0, ocol0; const float* xl_src; const float* xc_src; const float* gate; };
__device__ __forceinline__ void gemm_naive(Frame& F, const NG& g) {
    const int ntm = g.nrows / 32, ntn = g.ncols / 32, nt = ntm * ntn;
    const int lr = F.lane & 15, lq = F.lane >> 4;
    for (int t = F.bid * NWAVES + F.wave; t < nt; t += F.G * NWAVES) {
        const int tm = t / ntn, tn = t % ntn;
        const bf16* ap[2]; const bf16* bp[2]; const bf16* bp2[2];
#pragma unroll
        for (int mi = 0; mi < 2; ++mi) { const int i = 32 * tm + 16 * mi + lr; const size_t ar = g.ridx ? (size_t)g.ridx[i < g.nvalid ? i : 0] : (size_t)(g.arow0 + i); ap[mi] = g.A + ar * g.lda + 8 * lq; }
#pragma unroll
        for (int ni = 0; ni < 2; ++ni) { const int j = 32 * tn + 16 * ni + lr; const int pc = g.pair ? g.pcol0 + 256 * (j >> 7) + (j & 127) : g.pcol0 + j;
            bp[ni] = g.Bt + (size_t)pc * g.K + 8 * lq; bp2[ni] = bp[ni] + (size_t)128 * g.K; }
        f32x4 acc[2][2], acc2[2][2];
#pragma unroll
        for (int mi = 0; mi < 2; ++mi)
#pragma unroll
            for (int ni = 0; ni < 2; ++ni) { acc[mi][ni] = (f32x4){0.f, 0.f, 0.f, 0.f}; acc2[mi][ni] = (f32x4){0.f, 0.f, 0.f, 0.f}; }
        for (int k0 = 0; k0 < g.K; k0 += 32) {
            bf16x8 a[2], b[2], b2[2];
#pragma unroll
            for (int mi = 0; mi < 2; ++mi) a[mi] = *(const bf16x8*)(ap[mi] + k0);
#pragma unroll
            for (int ni = 0; ni < 2; ++ni) { b[ni] = *(const bf16x8*)(bp[ni] + k0); if (g.pair) b2[ni] = *(const bf16x8*)(bp2[ni] + k0); else b2[ni] = b[ni]; }
#pragma unroll
            for (int mi = 0; mi < 2; ++mi)
#pragma unroll
                for (int ni = 0; ni < 2; ++ni) { acc[mi][ni] = __builtin_amdgcn_mfma_f32_16x16x32_bf16(a[mi], b[ni], acc[mi][ni], 0, 0, 0);
                    if (g.pair) acc2[mi][ni] = __builtin_amdgcn_mfma_f32_16x16x32_bf16(a[mi], b2[ni], acc2[mi][ni], 0, 0, 0); }
        }
#pragma unroll
        for (int mi = 0; mi < 2; ++mi)
#pragma unroll
            for (int ni = 0; ni < 2; ++ni)
#pragma unroll
                for (int q = 0; q < 4; ++q) {
                    const int i = 32 * tm + 16 * mi + 4 * lq + q, j = 32 * tn + 16 * ni + lr; const float v = acc[mi][ni][q], u = acc2[mi][ni][q];
                    const int row = g.orow0 + i;
                    if (g.mode == 4) { const bool lat = row < ML; const int bb = lat ? (row >> 13) : 4;
                        const float* xs = lat ? g.xl_src + (size_t)row * D : g.xc_src + (size_t)(row - ML) * D; float* xd = lat ? ((float*)F.out_g) + (size_t)row * D : F_XC + (size_t)(row - ML) * D;
                        xd[j] = xs[j] + g.gate[(size_t)bb * (6 * D) + j] * v; }
                    else { float o = v; if (g.mode == 1) o = gelu_tanh_f(v); else if (g.mode == 2) o = v * u; else if (g.mode == 3) o = silu_f(v) * u;
                        g.O[(size_t)row * g.ldo + g.ocol0 + j] = (bf16)f2bf(o); }
                }
    }
}

namespace pg8 {
constexpr int BM = 256, BK = 64, HALF = 128, HTB = HALF * BK * 2, NXCD = 8, WGM = 4;
__device__ __forceinline__ int lds_byte(int r, int c) { const int st = (r >> 4) * 2 + (c >> 5), rr = r & 15, cc = c & 31, ob = rr * 64 + cc * 2; return st * 1024 + (ob ^ (((ob >> 9) & 1) << 5)); }
__device__ __forceinline__ void stage_rc(int b, int& R, int& C) { const int st = b / 1024, sb = b % 1024, swz = sb ^ (((sb >> 9) & 1) << 5); R = (st >> 1) * 16 + swz / 64; C = (st & 1) * 32 + (swz % 64) / 2; }
__device__ __forceinline__ int perm32(int rho) { const int n = rho >> 4, i = rho & 15; return 8 * (i >> 2) + 4 * n + (i & 3); }
struct Unit { int pm, pn, orow0, e, kq, spl, ovj; };
struct TileOrder {
    int nM, nN, nwg, G, c, wgm;
    __device__ void init(int nM_, int nN_, int G_, int c_, int wgm_ = WGM) { nM = nM_; nN = nN_; nwg = nM * nN; G = G_; c = c_; wgm = wgm_; }
    __device__ __forceinline__ void map(int L, int& pm, int& pn) const {
        int wgid = L; { const int q = nwg / NXCD, r = nwg % NXCD, xcd = wgid % NXCD, off = wgid / NXCD; wgid = (xcd < r ? xcd * (q + 1) : r * (q + 1) + (xcd - r) * q) + off; }
        const int nig = wgm * nN, gid = wgid / nig, fm = gid * wgm, gsz = (nM - fm) < wgm ? (nM - fm) : wgm;
        pm = fm + ((wgid % nig) % gsz); pn = (wgid % nig) / gsz;
    }
    __device__ __forceinline__ bool next(int i, int& pm, int& pn) const { const long L = (long)i * G + c; if (L >= nwg) return false; map((int)L, pm, pn); return true; }
};
__device__ __forceinline__ unsigned cvt_pk_bf16(float lo, float hi) { unsigned r; asm volatile("v_cvt_pk_bf16_f32 %0, %1, %2" : "=v"(r) : "v"(lo), "v"(hi)); return r; }

struct ProbDense {
    static constexpr bool GATHER = false; static constexpr bool SPLITK = false;
    const bf16* A; const bf16* Bt; int K; TileOrder ord;
    __device__ __forceinline__ bool next(int i, Unit& u) const { if (!ord.next(i, u.pm, u.pn)) return false; u.orow0 = u.pm * BM; u.e = 0; return true; }
    __device__ __forceinline__ const char* a_base(const Unit& u) const { return (const char*)A + (size_t)u.pm * BM * K * 2; }
    __device__ __forceinline__ const char* b_base(const Unit& u) const { return (const char*)Bt + (size_t)u.pn * BM * K * 2; }
    __device__ __forceinline__ unsigned row_index(const Unit&, int) const { return 0u; }
};
struct ProbMoe {
    const bf16* A; const bf16* Bt; const int* list; const LAS int* tab_; int K; int bt_rows; bool up; TileOrder ord;
    __device__ __forceinline__ bool next(int i, Unit& u) const {
        if (!ord.next(i, u.pm, u.pn)) return false;
        unsigned ta_ = (unsigned)(unsigned long)tab_; asm volatile("" : "+v"(ta_)); const LAS int* tab = (const LAS int*)(unsigned long)ta_;
        int e = 0;
#pragma unroll
        for (int q = 1; q < NE; ++q) e += (u.pm >= __builtin_amdgcn_readfirstlane(tab[q])) ? 1 : 0;
        u.e = e; u.orow0 = __builtin_amdgcn_readfirstlane(tab[32 + e]) + (u.pm - __builtin_amdgcn_readfirstlane(tab[e])) * BM; return true; }
    __device__ __forceinline__ const char* a_base(const Unit& u) const { return up ? (const char*)A : (const char*)A + (size_t)u.orow0 * K * 2; }
    __device__ __forceinline__ const char* b_base(const Unit& u) const { return (const char*)Bt + ((size_t)u.e * bt_rows + (size_t)u.pn * BM) * K * 2; }
    __device__ __forceinline__ const unsigned* row_ptr(const Unit& u, int lr) const {
        unsigned ta_ = (unsigned)(unsigned long)tab_; asm volatile("" : "+v"(ta_)); const LAS int* tab = (const LAS int*)(unsigned long)ta_;
        const int loc = (u.pm - __builtin_amdgcn_readfirstlane(tab[u.e])) * BM + lr; const int c = __builtin_amdgcn_readfirstlane(tab[16 + u.e]); return (const unsigned*)(list + (size_t)u.e * M + (loc < c ? loc : 0)); }
    __device__ __forceinline__ unsigned row_index(const Unit& u, int lr) const {
        unsigned ta_ = (unsigned)(unsigned long)tab_; asm volatile("" : "+v"(ta_)); const LAS int* tab = (const LAS int*)(unsigned long)ta_;
        const int loc = (u.pm - __builtin_amdgcn_readfirstlane(tab[u.e])) * BM + lr; const int c = __builtin_amdgcn_readfirstlane(tab[16 + u.e]); return (unsigned)list[(size_t)u.e * M + (loc < c ? loc : 0)]; }
};
template <bool G> struct ProbMoeT : ProbMoe { static constexpr bool GATHER = G; static constexpr bool SPLITK = false; };
struct ProbMoeSplit : ProbMoe {
    static constexpr bool GATHER = false; static constexpr bool SPLITK = true;
    int nfull, nmain, novf, spl;
    __device__ __forceinline__ void init_split() { nfull = ord.nwg / ord.G; nmain = nfull * ord.G; novf = ord.nwg - nmain; spl = (novf == 0) ? 1 : (novf * 4 <= ord.G) ? 4 : (novf * 2 <= ord.G) ? 2 : 1; }
    __device__ __forceinline__ bool next(int i, Unit& u) const {
        int L, kq = 0, sp = 1, j = 0;
        if (i < nfull) L = i * ord.G + ord.c;
        else if (i == nfull) { if (ord.c >= novf * spl) return false; j = ord.c % novf; kq = ord.c / novf; sp = spl; L = nmain + j; }
        else return false;
        ord.map(L, u.pm, u.pn); u.kq = kq; u.spl = sp; u.ovj = j;
        unsigned ta_ = (unsigned)(unsigned long)tab_; asm volatile("" : "+v"(ta_)); const LAS int* tab = (const LAS int*)(unsigned long)ta_;
        int e = 0;
#pragma unroll
        for (int q = 1; q < NE; ++q) e += (u.pm >= __builtin_amdgcn_readfirstlane(tab[q])) ? 1 : 0;
        u.e = e; u.orow0 = __builtin_amdgcn_readfirstlane(tab[32 + e]) + (u.pm - __builtin_amdgcn_readfirstlane(tab[e])) * BM; return true; }
    __device__ __forceinline__ int ntiles(const Unit& u) const { return K / BK / u.spl; }
    __device__ __forceinline__ const char* a_base(const Unit& u) const { return (const char*)A + ((size_t)u.orow0 * K + (size_t)u.kq * (K / u.spl)) * 2; }
    __device__ __forceinline__ const char* b_base(const Unit& u) const { return (const char*)Bt + (((size_t)u.e * bt_rows + (size_t)u.pn * BM) * K + (size_t)u.kq * (K / u.spl)) * 2; }
};

struct EpiP {
    static constexpr bool PERM = true;
    bf16* P;
    __device__ __forceinline__ void operator()(const f32x4 (&acc)[2][2][4][2], const Unit& u, int wr, int wc, int fr, int fq) const {
        int ld = PW; asm volatile("" : "+s"(ld));
        const int pn = u.pn; const unsigned loff = (unsigned)(fr * ld + 8 * fq) * 2u;
        char* base = (char*)(P + (size_t)(u.orow0 + wr * 64) * ld + wc * 32);
#pragma unroll
        for (int ai = 0; ai < 2; ++ai)
#pragma unroll
            for (int m = 0; m < 4; ++m) { char* rowb = base + (size_t)((ai * HALF + m * 16) * ld) * 2;
                if (pn >= 2 && pn < 6) { const f32x4 a0 = acc[ai][0][m][0] * acc[ai][1][m][0], a1 = acc[ai][0][m][1] * acc[ai][1][m][1];
                    v4u w; w.x = cvt_pk_bf16(a0[0], a0[1]); w.y = cvt_pk_bf16(a0[2], a0[3]); w.z = cvt_pk_bf16(a1[0], a1[1]); w.w = cvt_pk_bf16(a1[2], a1[3]);
                    *(v4u*)(rowb + (size_t)(512 + 128 * (pn - 2)) * 2 + loff) = w; }
                else { const int cbase = (pn < 2) ? 256 * pn : 256 * pn - 512;
#pragma unroll
                    for (int bj = 0; bj < 2; ++bj) { f32x4 v0 = acc[ai][bj][m][0], v1 = acc[ai][bj][m][1];
                        if (pn >= 8) {
#pragma unroll
                            for (int q = 0; q < 4; ++q) { v0[q] = gelu_tanh_f(v0[q]); v1[q] = gelu_tanh_f(v1[q]); } }
                        v4u w; w.x = cvt_pk_bf16(v0[0], v0[1]); w.y = cvt_pk_bf16(v0[2], v0[3]); w.z = cvt_pk_bf16(v1[0], v1[1]); w.w = cvt_pk_bf16(v1[2], v1[3]);
                        *(v4u*)(rowb + (size_t)(cbase + bj * HALF) * 2 + loff) = w; } }
            }
    }
};
struct EpiGLU {
    static constexpr bool PERM = true;
    bf16* O; int ldo;
    __device__ __forceinline__ void operator()(const f32x4 (&acc)[2][2][4][2], const Unit& u, int wr, int wc, int fr, int fq) const {
        int ld = ldo; asm volatile("" : "+s"(ld));
        const unsigned loff = (unsigned)(fr * ld + 8 * fq) * 2u;
        char* base = (char*)(O + (size_t)(u.orow0 + wr * 64) * ld + 128 * u.pn + wc * 32);
#pragma unroll
        for (int ai = 0; ai < 2; ++ai)
#pragma unroll
            for (int m = 0; m < 4; ++m) { char* rowb = base + (size_t)((ai * HALF + m * 16) * ld) * 2;
                const f32x4 g0 = acc[ai][0][m][0], g1 = acc[ai][0][m][1], u0 = acc[ai][1][m][0], u1 = acc[ai][1][m][1];
                const f32x4 t0 = g0 * -1.44269504089f, t1 = g1 * -1.44269504089f; f32x4 e0, e1;
#pragma unroll
                for (int q = 0; q < 4; ++q) { e0[q] = __builtin_amdgcn_exp2f(t0[q]); e1[q] = __builtin_amdgcn_exp2f(t1[q]); }
                const f32x4 d0 = e0 + 1.0f, d1 = e1 + 1.0f, p0 = g0 * u0, p1 = g1 * u1; f32x4 r0, r1;
#pragma unroll
                for (int q = 0; q < 4; ++q) { r0[q] = __builtin_amdgcn_rcpf(d0[q]); r1[q] = __builtin_amdgcn_rcpf(d1[q]); }
                const f32x4 a0 = p0 * r0, a1 = p1 * r1;
                v4u w; w.x = cvt_pk_bf16(a0[0], a0[1]); w.y = cvt_pk_bf16(a0[2], a0[3]); w.z = cvt_pk_bf16(a1[0], a1[1]); w.w = cvt_pk_bf16(a1[2], a1[3]);
                *(v4u*)(rowb + loff) = w; }
    }
};
struct EpiBf {
    static constexpr bool PERM = true;
    bf16* O; int ldo;
    __device__ __forceinline__ void operator()(const f32x4 (&acc)[2][2][4][2], const Unit& u, int wr, int wc, int fr, int fq) const {
        int ld = ldo; asm volatile("" : "+s"(ld));
        const unsigned loff = (unsigned)(fr * ld + 8 * fq) * 2u;
        char* base = (char*)(O + (size_t)(u.orow0 + wr * 64) * ld + 256 * u.pn + wc * 32);
#pragma unroll
        for (int ai = 0; ai < 2; ++ai)
#pragma unroll
            for (int m = 0; m < 4; ++m) { char* rowb = base + (size_t)((ai * HALF + m * 16) * ld) * 2;
#pragma unroll
                for (int bj = 0; bj < 2; ++bj) { const f32x4 v0 = acc[ai][bj][m][0], v1 = acc[ai][bj][m][1];
                    v4u w; w.x = cvt_pk_bf16(v0[0], v0[1]); w.y = cvt_pk_bf16(v0[2], v0[3]); w.z = cvt_pk_bf16(v1[0], v1[1]); w.w = cvt_pk_bf16(v1[2], v1[3]);
                    *(v4u*)(rowb + (size_t)(bj * HALF) * 2 + loff) = w; } }
    }
};
struct EpiBfSplit {
    static constexpr bool PERM = true;
    bf16* O; int ldo; float* part; unsigned* cnt;
    __device__ __forceinline__ void operator()(const f32x4 (&acc)[2][2][4][2], const Unit& u, int wr, int wc, int fr, int fq) const {
        int ld = ldo; asm volatile("" : "+s"(ld));
        const unsigned loff = (unsigned)(fr * ld + 8 * fq) * 2u;
        char* base = (char*)(O + (size_t)(u.orow0 + wr * 64) * ld + 256 * u.pn + wc * 32);
        if (u.spl == 1) {
#pragma unroll
            for (int ai = 0; ai < 2; ++ai)
#pragma unroll
                for (int m = 0; m < 4; ++m) { char* rowb = base + (size_t)((ai * HALF + m * 16) * ld) * 2;
#pragma unroll
                    for (int bj = 0; bj < 2; ++bj) { const f32x4 v0 = acc[ai][bj][m][0], v1 = acc[ai][bj][m][1];
                        v4u w; w.x = cvt_pk_bf16(v0[0], v0[1]); w.y = cvt_pk_bf16(v0[2], v0[3]); w.z = cvt_pk_bf16(v1[0], v1[1]); w.w = cvt_pk_bf16(v1[2], v1[3]);
                        *(v4u*)(rowb + (size_t)(bj * HALF) * 2 + loff) = w; } }
            return;
        }
        const int tid = (wr * 4 + wc) * 64 + fq * 16 + fr;
        f32x4* mine = (f32x4*)part + (size_t)(u.ovj * u.spl + u.kq) * 16384 + tid;
#pragma unroll
        for (int ai = 0; ai < 2; ++ai)
#pragma unroll
            for (int bj = 0; bj < 2; ++bj)
#pragma unroll
                for (int m = 0; m < 4; ++m)
#pragma unroll
                    for (int n = 0; n < 2; ++n) mine[(((ai * 2 + bj) * 4 + m) * 2 + n) * 512] = acc[ai][bj][m][n];
        asm volatile("s_waitcnt vmcnt(0)" ::: "memory");
        __syncthreads();
        if (tid == 0) { __builtin_amdgcn_fence(__ATOMIC_RELEASE, "agent"); (void)__hip_atomic_fetch_add(cnt + u.ovj, 1u, RLX_AGENT);
            unsigned sp = 0; while (__hip_atomic_load(cnt + u.ovj, RLX_AGENT) < (unsigned)u.spl) { __builtin_amdgcn_s_sleep(2); if (++sp > (1u << 22)) break; } }
        __syncthreads();
        __builtin_amdgcn_fence(__ATOMIC_ACQUIRE, "agent");
#pragma unroll
        for (int qd = 0; qd < 4; ++qd) { const int ai = qd >> 1, bj = qd & 1;
            if ((qd % u.spl) != u.kq) continue;
            f32x4 sm[4][2];
#pragma unroll
            for (int m = 0; m < 4; ++m)
#pragma unroll
                for (int n = 0; n < 2; ++n) sm[m][n] = acc[ai][bj][m][n];
            for (int q = 1; q < u.spl; ++q) { int oq = u.kq + q; if (oq >= u.spl) oq -= u.spl;
                const f32x4* pp = (const f32x4*)part + (size_t)(u.ovj * u.spl + oq) * 16384 + tid + qd * 4096; f32x4 tv[4][2];
#pragma unroll
                for (int m = 0; m < 4; ++m)
#pragma unroll
                    for (int n = 0; n < 2; ++n) tv[m][n] = pp[(m * 2 + n) * 512];
#pragma unroll
                for (int m = 0; m < 4; ++m)
#pragma unroll
                    for (int n = 0; n < 2; ++n) sm[m][n] += tv[m][n]; }
#pragma unroll
            for (int m = 0; m < 4; ++m) { char* rowb = base + (size_t)((ai * HALF + m * 16) * ld) * 2; const f32x4 v0 = sm[m][0], v1 = sm[m][1];
                v4u w; w.x = cvt_pk_bf16(v0[0], v0[1]); w.y = cvt_pk_bf16(v0[2], v0[3]); w.z = cvt_pk_bf16(v1[0], v1[1]); w.w = cvt_pk_bf16(v1[2], v1[3]);
                *(v4u*)(rowb + (size_t)(bj * HALF) * 2 + loff) = w; } }
    }
};
template <bool SRCF32> struct EpiRes {
    static constexpr bool PERM = true;
    const float* xf; bf16* XB; const float* gate;
    __device__ __forceinline__ void operator()(const f32x4 (&acc)[2][2][4][2], const Unit& u, int wr, int wc, int fr, int fq) const {
        int ld = D; asm volatile("" : "+s"(ld));
        const int bb = u.orow0 >> 13; const size_t e0u = (size_t)(u.orow0 + wr * 64) * ld + u.pn * BM + wc * 32; const unsigned lofe = (unsigned)(fr * ld + 8 * fq);
        const float* gp = gate + (size_t)bb * (6 * D) + u.pn * BM + wc * 32 + 8 * fq;
        f32x4 gv[2][2];
#pragma unroll
        for (int bj = 0; bj < 2; ++bj)
#pragma unroll
            for (int n = 0; n < 2; ++n) gv[bj][n] = *(const f32x4*)(gp + bj * HALF + 4 * n);
#pragma unroll
        for (int ai = 0; ai < 2; ++ai) {
            f32x4 xs[4][2][2];
#pragma unroll
            for (int m = 0; m < 4; ++m) { const size_t rou = e0u + (size_t)((ai * HALF + m * 16) * ld);
#pragma unroll
                for (int bj = 0; bj < 2; ++bj) {
                    if (SRCF32) { const float* xfp = (const float*)((const char*)(xf + rou + bj * HALF) + (size_t)(lofe * 4u)); xs[m][bj][0] = *(const f32x4*)xfp; xs[m][bj][1] = *(const f32x4*)(xfp + 4); }
                    else { const bf16* xbp = (const bf16*)((const char*)(XB + rou + bj * HALF) + (size_t)(lofe * 2u)); const v4u w = *(const v4u*)xbp; xs[m][bj][0] = __builtin_bit_cast(f32x4, w); } } }
#pragma unroll
            for (int m = 0; m < 4; ++m) { const size_t rou = e0u + (size_t)((ai * HALF + m * 16) * ld);
#pragma unroll
                for (int bj = 0; bj < 2; ++bj) { f32x4 x0, x1; bf16* xbp = (bf16*)((char*)(XB + rou + bj * HALF) + (size_t)(lofe * 2u));
                    if (SRCF32) { x0 = xs[m][bj][0]; x1 = xs[m][bj][1]; }
                    else { const v4u w = __builtin_bit_cast(v4u, xs[m][bj][0]); x0 = (f32x4){bflo(w.x), bfhi(w.x), bflo(w.y), bfhi(w.y)}; x1 = (f32x4){bflo(w.z), bfhi(w.z), bflo(w.w), bfhi(w.w)}; }
                    const f32x4 v0 = x0 + gv[bj][0] * acc[ai][bj][m][0], v1 = x1 + gv[bj][1] * acc[ai][bj][m][1];
                    v4u o; o.x = cvt_pk_bf16(v0[0], v0[1]); o.y = cvt_pk_bf16(v0[2], v0[3]); o.z = cvt_pk_bf16(v1[0], v1[1]); o.w = cvt_pk_bf16(v1[2], v1[3]);
                    *(v4u*)xbp = o; } }
        }
    }
};

template <class Prob, class Epi>
__device__ __forceinline__ void gemm_phase(LAS unsigned char* lds, const Prob& S, const Epi& E, int tid_in) {
    int tid_ = tid_in; asm volatile("" : "+v"(tid_));
    const int tid = tid_, wid = __builtin_amdgcn_readfirstlane(tid >> 6), lane = tid & 63, wr = wid >> 2, wc = wid & 3, fr = lane & 15, fq = lane >> 4;
    const int K = S.K; int nt = K / BK;
    unsigned voffB[2], vA0[2], vA1[2];
#pragma unroll
    for (int i = 0; i < 2; ++i) { int R, C; stage_rc(tid * 16 + i * 8192, R, C); const int Rb = Epi::PERM ? ((R & ~31) + perm32(R & 31)) : R; voffB[i] = (unsigned)(Rb * K + C) * 2u; vA0[i] = (unsigned)(R * K + C) * 2u; vA1[i] = vA0[i]; }
    const size_t kstep = (size_t)(BK * 2);
    const size_t hstep = (size_t)HALF * K * 2;
    const unsigned ldsw = (unsigned)wid * 1024u;
    const int aoff = lds_byte(wr * 64 + fr, fq * 8), boff = lds_byte(wc * 32 + fr, fq * 8);
#define PG8_SA(b, h) (((b) * 2 + (h)) * HTB)
#define PG8_SB(b, h) ((4 + (b) * 2 + (h)) * HTB)
#define PG8_STAGE(bufoff, gbase, voff) do { _Pragma("unroll") for (int _i = 0; _i < 2; ++_i) \
        __builtin_amdgcn_global_load_lds((const unsigned*)((const char*)(gbase) + (voff)[_i]), (LAS unsigned*)(lds + (bufoff) + ldsw + _i * 8192), 16, 0, 0); } while (0)
#define PG8_STAGE_A(bufoff, gbase, h) do { if constexpr (Prob::GATHER) { if (h) PG8_STAGE(bufoff, gbase, vA1); else PG8_STAGE(bufoff, gbase, vA0); } else PG8_STAGE(bufoff, (gbase) + (h) * hstep, vA0); } while (0)
#define PG8_LDA(dst, b, h) do { _Pragma("unroll") for (int m = 0; m < 4; ++m) _Pragma("unroll") for (int k = 0; k < 2; ++k) dst[m][k] = *(const LAS bf16x8*)(lds + PG8_SA(b, h) + aoff + m * 2048 + k * 1024); } while (0)
#define PG8_LDB(dst, b, h) do { _Pragma("unroll") for (int n = 0; n < 2; ++n) _Pragma("unroll") for (int k = 0; k < 2; ++k) dst[n][k] = *(const LAS bf16x8*)(lds + PG8_SB(b, h) + boff + n * 2048 + k * 1024); } while (0)
#define PG8_MMA(ai, bj, At, Bt) do { __builtin_amdgcn_s_setprio(1); _Pragma("unroll") for (int m = 0; m < 4; ++m) _Pragma("unroll") for (int n = 0; n < 2; ++n) _Pragma("unroll") for (int k = 0; k < 2; ++k) \
        acc[ai][bj][m][n] = __builtin_amdgcn_mfma_f32_16x16x32_bf16(Bt[n][k], At[m][k], acc[ai][bj][m][n], 0, 0, 0); __builtin_amdgcn_s_setprio(0); } while (0)
#define PG8_WAIT_V(n) asm volatile("s_waitcnt vmcnt(" #n ")" ::: "memory")
#define PG8_WAIT_L(n) asm volatile("s_waitcnt lgkmcnt(" #n ")" ::: "memory")
#define PG8_BAR __builtin_amdgcn_s_barrier()
#define PG8_SCHED __builtin_amdgcn_sched_barrier(0)
#define PG8_GATHER_VOFF(u) do { _Pragma("unroll") for (int _i = 0; _i < 2; ++_i) { int R_, C_; stage_rc(tid * 16 + _i * 8192, R_, C_); \
        vA0[_i] = (S.row_index(u, R_) * (unsigned)K + (unsigned)C_) * 2u; asm volatile("" : "+v"(vA0[_i]) :: "memory"); } \
        _Pragma("unroll") for (int _i = 0; _i < 2; ++_i) { int R_, C_; stage_rc(tid * 16 + _i * 8192, R_, C_); \
        vA1[_i] = (S.row_index(u, HALF + R_) * (unsigned)K + (unsigned)C_) * 2u; asm volatile("" : "+v"(vA1[_i]) :: "memory"); } } while (0)
#define PG8_GATHER_DMA(u) do { _Pragma("unroll") for (int _h = 0; _h < 2; ++_h) _Pragma("unroll") for (int _i = 0; _i < 2; ++_i) { int R_, C_; stage_rc(tid * 16 + _i * 8192, R_, C_); \
        __builtin_amdgcn_global_load_lds(S.row_ptr(u, _h * HALF + R_), (LAS unsigned*)(lds + GIDX_OFF + (_h * 2 + _i) * 2048 + wid * 256), 4, 0, 0); } } while (0)
#define PG8_GATHER_FROM_LDS() do { _Pragma("unroll") for (int _i = 0; _i < 2; ++_i) { int R_, C_; stage_rc(tid * 16 + _i * 8192, R_, C_); \
        vA0[_i] = (*(const LAS unsigned*)(lds + GIDX_OFF + _i * 2048 + tid * 4) * (unsigned)K + (unsigned)C_) * 2u; vA1[_i] = (*(const LAS unsigned*)(lds + GIDX_OFF + (2 + _i) * 2048 + tid * 4) * (unsigned)K + (unsigned)C_) * 2u; } } while (0)
    Unit cur, nxt; int ui = 0;
    if (!S.next(0, cur)) return;
    f32x4 acc[2][2][4][2];
#pragma unroll
    for (int a = 0; a < 2; ++a)
#pragma unroll
        for (int b = 0; b < 2; ++b)
#pragma unroll
            for (int m = 0; m < 4; ++m)
#pragma unroll
                for (int n = 0; n < 2; ++n) acc[a][b][m][n] = (f32x4){0.f, 0.f, 0.f, 0.f};
    bf16x8 At[4][2], B0[2][2], B1[2][2];
    const char* cA = S.a_base(cur); const char* cB = S.b_base(cur);
    if constexpr (Prob::SPLITK) nt = S.ntiles(cur);
    if constexpr (Prob::GATHER) PG8_GATHER_VOFF(cur);
#if PG8_SP2
    PG8_STAGE(PG8_SB(0, 0), cB, voffB); PG8_STAGE(PG8_SB(0, 1), cB + hstep, voffB); PG8_STAGE_A(PG8_SA(0, 0), cA, 0); PG8_STAGE_A(PG8_SA(0, 1), cA, 1);
    if (wr == 1) PG8_BAR;
    PG8_WAIT_V(2); PG8_BAR;
#else
    PG8_STAGE(PG8_SB(0, 0), cB, voffB); PG8_STAGE_A(PG8_SA(0, 0), cA, 0); PG8_STAGE(PG8_SB(0, 1), cB + hstep, voffB); PG8_STAGE_A(PG8_SA(0, 1), cA, 1);
    if (wr == 1) PG8_BAR;
    PG8_WAIT_V(4); PG8_BAR;
#endif
    PG8_STAGE(PG8_SB(1, 0), cB + kstep, voffB); PG8_STAGE_A(PG8_SA(1, 0), cA + kstep, 0); PG8_STAGE(PG8_SB(1, 1), cB + hstep + kstep, voffB);
    PG8_WAIT_V(6); PG8_BAR;
    for (;;) {
        const bool has_next = S.next(ui + 1, nxt);
        if constexpr (Prob::GATHER) { if (has_next) PG8_GATHER_DMA(nxt); }
        const char* nA = has_next ? S.a_base(nxt) : cA; const char* nB = has_next ? S.b_base(nxt) : cB;
        for (int t = 0; t < nt; t += 2) {
            const bool last = (t == nt - 2);
            const char* a1 = cA + (size_t)(t + 1) * kstep;
            const char* a2 = last ? nA : cA + (size_t)(t + 2) * kstep; const char* b2 = last ? nB : cB + (size_t)(t + 2) * kstep;
            const char* a3 = a2 + kstep; const char* b3 = b2 + kstep;
#if !PG8_SP2
            PG8_LDB(B0, 0, 0); PG8_SCHED; PG8_LDA(At, 0, 0); PG8_STAGE_A(PG8_SA(1, 1), a1, 1);
            PG8_WAIT_L(8); PG8_BAR; PG8_WAIT_L(0); PG8_MMA(0, 0, At, B0); PG8_BAR; PG8_SCHED;
            if constexpr (Prob::GATHER) { if (last && has_next) PG8_GATHER_FROM_LDS(); }
            PG8_LDB(B1, 0, 1); PG8_STAGE(PG8_SB(0, 0), b2, voffB);
            PG8_BAR; PG8_WAIT_L(0); PG8_MMA(0, 1, At, B1); PG8_BAR;
            PG8_LDA(At, 0, 1); PG8_STAGE_A(PG8_SA(0, 0), a2, 0);
            PG8_BAR; PG8_WAIT_L(0); PG8_MMA(1, 0, At, B0); PG8_BAR; PG8_SCHED;
            PG8_STAGE(PG8_SB(0, 1), b2 + hstep, voffB);
            PG8_WAIT_V(6); PG8_BAR; PG8_MMA(1, 1, At, B1); PG8_BAR;
            PG8_LDB(B0, 1, 0); PG8_SCHED; PG8_LDA(At, 1, 0); PG8_STAGE_A(PG8_SA(0, 1), a2, 1);
            PG8_WAIT_L(8); PG8_BAR; PG8_WAIT_L(0); PG8_MMA(0, 0, At, B0); PG8_BAR; PG8_SCHED;
            PG8_LDB(B1, 1, 1); PG8_STAGE(PG8_SB(1, 0), b3, voffB);
            PG8_BAR; PG8_WAIT_L(0); PG8_MMA(0, 1, At, B1); PG8_BAR;
            PG8_LDA(At, 1, 1); PG8_STAGE_A(PG8_SA(1, 0), a3, 0);
            PG8_BAR; PG8_WAIT_L(0); PG8_MMA(1, 0, At, B0); PG8_BAR; PG8_SCHED;
            PG8_STAGE(PG8_SB(1, 1), b3 + hstep, voffB);
            PG8_WAIT_V(6); PG8_BAR; PG8_MMA(1, 1, At, B1); PG8_BAR;
#else
            PG8_LDB(B0, 0, 0); PG8_LDB(B1, 0, 1); PG8_SCHED; PG8_LDA(At, 0, 0); PG8_STAGE_A(PG8_SA(1, 1), a1, 1);
            PG8_WAIT_V(8); PG8_WAIT_L(0); PG8_BAR; PG8_MMA(0, 0, At, B0); PG8_MMA(0, 1, At, B1); PG8_BAR; PG8_SCHED;
            if constexpr (Prob::GATHER) { if (last && has_next) PG8_GATHER_FROM_LDS(); }
            PG8_LDA(At, 0, 1); PG8_STAGE(PG8_SB(0, 0), b2, voffB); PG8_STAGE(PG8_SB(0, 1), b2 + hstep, voffB); PG8_STAGE_A(PG8_SA(0, 0), a2, 0);
            PG8_WAIT_V(8); PG8_WAIT_L(0); PG8_BAR; PG8_MMA(1, 0, At, B0); PG8_MMA(1, 1, At, B1); PG8_BAR; PG8_SCHED;
            PG8_LDB(B0, 1, 0); PG8_LDB(B1, 1, 1); PG8_SCHED; PG8_LDA(At, 1, 0); PG8_STAGE_A(PG8_SA(0, 1), a2, 1);
            PG8_WAIT_V(8); PG8_WAIT_L(0); PG8_BAR; PG8_MMA(0, 0, At, B0); PG8_MMA(0, 1, At, B1); PG8_BAR; PG8_SCHED;
            PG8_LDA(At, 1, 1); PG8_STAGE(PG8_SB(1, 0), b3, voffB); PG8_STAGE(PG8_SB(1, 1), b3 + hstep, voffB); PG8_STAGE_A(PG8_SA(1, 0), a3, 0);
            PG8_WAIT_V(8); PG8_WAIT_L(0); PG8_BAR; PG8_MMA(1, 0, At, B0); PG8_MMA(1, 1, At, B1); PG8_BAR; PG8_SCHED;
#endif
        }
        if (wr == 0) PG8_BAR;
        E(acc, cur, wr, wc, fr, fq);
#if EPI2
        if constexpr (Epi::PERM) E(acc, cur, wr, wc, fr, fq);
#endif
        if (!has_next) break;
#pragma unroll
        for (int a = 0; a < 2; ++a)
#pragma unroll
            for (int b = 0; b < 2; ++b)
#pragma unroll
                for (int m = 0; m < 4; ++m)
#pragma unroll
                    for (int n = 0; n < 2; ++n) { double z0_, z1_; asm volatile("v_mov_b64 %0, 0" : "=v"(z0_)); asm volatile("v_mov_b64 %0, 0" : "=v"(z1_)); const f64x2_t z_ = {z0_, z1_}; acc[a][b][m][n] = __builtin_bit_cast(f32x4, z_); }
        cur = nxt; cA = nA; cB = nB; ++ui;
        if constexpr (Prob::SPLITK) nt = S.ntiles(cur);
        if (wr == 1) PG8_BAR;
    }
    PG8_WAIT_V(0);
    PG8_BAR;
#undef PG8_SA
#undef PG8_SB
#undef PG8_STAGE
#undef PG8_STAGE_A
#undef PG8_LDA
#undef PG8_LDB
#undef PG8_MMA
#undef PG8_WAIT_V
#undef PG8_WAIT_L
#undef PG8_BAR
#undef PG8_SCHED
#undef PG8_GATHER_VOFF
#undef PG8_GATHER_DMA
#undef PG8_GATHER_FROM_LDS
}
}

__device__ __forceinline__ void gemm_ctx_res(Frame& F, const bf16* A, int lda, const bf16* Bt, int K, bool first, const float* gate4) {
    if (F.bid >= 256) return;
    const int tm = F.bid >> 4, tn = F.bid & 15, lr = F.lane & 15, lq = F.lane >> 4;
    const int ks = K / 8, nst = ks / 32;
    const bf16* ap = A + (size_t)(ML + 64 * tm + lr) * lda + F.wave * ks + 8 * lq; const bf16* bp = Bt + (size_t)(64 * tn + lr) * K + F.wave * ks + 8 * lq;
    f32x4 acc[4][4];
#pragma unroll
    for (int mi = 0; mi < 4; ++mi)
#pragma unroll
        for (int ni = 0; ni < 4; ++ni) acc[mi][ni] = (f32x4){0.f, 0.f, 0.f, 0.f};
    for (int st0 = 0; st0 < nst; st0 += 4) {
        bf16x8 af[4][4], bfr[4][4];
#pragma unroll
        for (int s_ = 0; s_ < 4; ++s_) if (st0 + s_ < nst) {
#pragma unroll
            for (int q = 0; q < 4; ++q) { af[s_][q] = *(const bf16x8*)(ap + (size_t)(16 * q) * lda + 32 * (st0 + s_)); bfr[s_][q] = *(const bf16x8*)(bp + (size_t)(16 * q) * K + 32 * (st0 + s_)); } }
        __builtin_amdgcn_sched_barrier(0);
#pragma unroll
        for (int s_ = 0; s_ < 4; ++s_) if (st0 + s_ < nst) {
#pragma unroll
            for (int mi = 0; mi < 4; ++mi)
#pragma unroll
                for (int ni = 0; ni < 4; ++ni) acc[mi][ni] = __builtin_amdgcn_mfma_f32_16x16x32_bf16(af[s_][mi], bfr[s_][ni], acc[mi][ni], 0, 0, 0); }
        __builtin_amdgcn_sched_barrier(0);
    }
    LAS float* Pl = (LAS float*)(F.lds) + F.wave * 4096;
#pragma unroll
    for (int mi = 0; mi < 4; ++mi)
#pragma unroll
        for (int ni = 0; ni < 4; ++ni)
#pragma unroll
            for (int q = 0; q < 4; ++q) Pl[(16 * mi + 4 * lq + q) * 64 + 16 * ni + lr] = acc[mi][ni][q];
    __syncthreads();
    { const int i = F.tid >> 3, j0 = (F.tid & 7) * 8; const LAS float* Ps = (const LAS float*)(F.lds) + i * 64 + j0;
      f32x4 s0 = (f32x4){0.f, 0.f, 0.f, 0.f}, s1 = s0;
#pragma unroll
      for (int w = 0; w < 8; ++w) { s0 = s0 + *(const LAS f32x4*)(Ps + w * 4096); s1 = s1 + *(const LAS f32x4*)(Ps + w * 4096 + 4); }
      const size_t ro = (size_t)(64 * tm + i) * D + 64 * tn + j0; const float* gp = gate4 + 64 * tn + j0;
      const f32x4 g0 = *(const f32x4*)gp, g1 = *(const f32x4*)(gp + 4); bf16* xd = F_XB + (size_t)ML * D + ro; f32x4 x0, x1;
      if (first) { const float* cin = INP(I_CTX); x0 = *(const f32x4*)(cin + ro); x1 = *(const f32x4*)(cin + ro + 4); }
      else { const v4u w = *(const v4u*)xd; x0 = (f32x4){bflo(w.x), bfhi(w.x), bflo(w.y), bfhi(w.y)}; x1 = (f32x4){bflo(w.z), bfhi(w.z), bflo(w.w), bfhi(w.w)}; }
      const f32x4 v0 = x0 + g0 * s0, v1 = x1 + g1 * s1; v4u o; o.x = pk2(v0.x, v0.y); o.y = pk2(v0.z, v0.w); o.z = pk2(v1.x, v1.y); o.w = pk2(v1.z, v1.w); *(v4u*)xd = o; }
    __syncthreads();
}

__device__ __forceinline__ void sa_xr_conv(Frame& F, int l) {
    const float* cw = INP(I_RCW) + (size_t)l * 4 * DR; const float* cb = INP(I_RCB) + (size_t)l * DR;
    for (size_t idx = (size_t)F.bid * NTHREADS + F.tid; idx < (size_t)M * DR; idx += (size_t)F.G * NTHREADS) {
        const int row = (int)(idx >> 9), c = (int)(idx & 511);
        int t, L; if (row < ML) { t = row & (SEQ - 1); L = SEQ; } else { t = (row - ML) & (CTXL - 1); L = CTXL; }
        float a = cb[c];
#pragma unroll
        for (int k = 0; k < 4; ++k) { const int tt = t + k - 2; if (tt >= 0 && tt < L) a += cw[k * DR + c] * bf2f(F_P[(size_t)(row + k - 2) * PW + 1024 + c]); }
        F_XR[idx] = a;
    }
}
__device__ __forceinline__ void sa_mx(Frame& F, int l) {
    const float* cw = INP(I_CONVW) + (size_t)l * 3 * DR; const bf16* Pb = F_P; bf16* MIXb = F_MIX;
    const int gt = F.bid * NTHREADS + F.tid, c0 = (gt & 63) * 8; const int rstep = (F.G * NTHREADS) >> 6;
    float w0[8], w1[8], w2[8];
#pragma unroll
    for (int q = 0; q < 8; ++q) { w0[q] = cw[c0 + q]; w1[q] = cw[DR + c0 + q]; w2[q] = cw[2 * DR + c0 + q]; }
    for (int row0 = gt >> 6; row0 < M; row0 += 4 * rstep) {
        v4u um[4], u0[4], up[4], cbv[4];
#pragma unroll
        for (int k = 0; k < 4; ++k) { const int row = row0 + k * rstep; const v4u z = (v4u){0u, 0u, 0u, 0u}; um[k] = z; u0[k] = z; up[k] = z; cbv[k] = z;
            if (row < M) { int dlt; bool okm, okp;
                if (row < ML) { const int t = row & (SEQ - 1); if (c0 < 256) { dlt = 1; okm = (t & 63) > 0; okp = (t & 63) < 63; } else { dlt = 64; okm = (t >> 6) > 0; okp = (t >> 6) < 127; } }
                else { const int t = (row - ML) & (CTXL - 1); dlt = 1; okm = t > 0; okp = t < CTXL - 1; }
                if (okm) um[k] = *(const v4u*)(Pb + (size_t)(row - dlt) * PW + 512 + c0);
                u0[k] = *(const v4u*)(Pb + (size_t)row * PW + 512 + c0);
                if (okp) up[k] = *(const v4u*)(Pb + (size_t)(row + dlt) * PW + 512 + c0);
                cbv[k] = *(const v4u*)(Pb + (size_t)row * PW + c0); } }
#pragma unroll
        for (int k = 0; k < 4; ++k) { const int row = row0 + k * rstep;
            if (row < M) { v4u o;
#pragma unroll
                for (int q = 0; q < 4; ++q) {
                    const float r0 = bflo(cbv[k][q]) * (w0[2 * q] * bflo(um[k][q]) + w1[2 * q] * bflo(u0[k][q]) + w2[2 * q] * bflo(up[k][q]));
                    const float r1 = bfhi(cbv[k][q]) * (w0[2 * q + 1] * bfhi(um[k][q]) + w1[2 * q + 1] * bfhi(u0[k][q]) + w2[2 * q + 1] * bfhi(up[k][q]));
                    o[q] = pk2(r0, r1); }
                *(v4u*)(MIXb + (size_t)row * D + c0) = o; } }
    }
}
__device__ __forceinline__ void sa_mx_alt(Frame& F, int l) {
    const float* cw = INP(I_CONVW) + (size_t)l * 3 * DR; const bf16* P = F_P; bf16* MIXb = F_MIX;
    for (size_t idx = (size_t)F.bid * NTHREADS + F.tid; idx < (size_t)M * DR; idx += (size_t)F.G * NTHREADS) {
        const int row = (int)(idx / DR), c = (int)(idx % DR);
        float acc = 0.f;
        if (row < ML) { const int b = row / SEQ, t = row % SEQ, gr = t / 64, gc = t % 64;
            for (int k = 0; k < 3; ++k) {
                if (c < 256) { const int g2 = gc + k - 1; if (g2 >= 0 && g2 < 64) acc += cw[k * DR + c] * bf2f(P[(size_t)(b * SEQ + gr * 64 + g2) * PW + 512 + c]); }
                else { const int r2 = gr + k - 1; if (r2 >= 0 && r2 < SEQ / 64) acc += cw[k * DR + c] * bf2f(P[(size_t)(b * SEQ + r2 * 64 + gc) * PW + 512 + c]); } } }
        else { const int b = (row - ML) / CTXL, t = (row - ML) % CTXL;
            for (int k = 0; k < 3; ++k) { const int t2 = t + k - 1; if (t2 >= 0 && t2 < CTXL) acc += cw[k * DR + c] * bf2f(P[(size_t)(ML + b * CTXL + t2) * PW + 512 + c]); } }
        MIXb[(size_t)row * D + c] = (bf16)f2bf(bf2f(P[(size_t)row * PW + c]) * acc);
    }
}
__device__ __forceinline__ void sb_scan_naive(Frame& F, int l) {
    if (F.bid >= 64 || F.wave != 0) return;
    const int b = F.bid >> 4, h = (F.bid >> 1) & 7, d = F.bid & 1, j = F.lane;
    volatile LAS float* xs = (volatile LAS float*)(F.lds + 0);
    LAS float* WA = (LAS float*)(F.lds + 1024);
    LAS float* WI = (LAS float*)(F.lds + 1024 + 16384);
    { const float* pa = INP(I_LWA) + ((size_t)((l * 2 + d) * 8 + h) * 64) * 64 + j; const float* pi = INP(I_LWI) + ((size_t)((l * 2 + d) * 8 + h) * 64) * 64 + j;
      for (int i = 0; i < 64; ++i) { WA[i * 64 + j] = pa[i * 64]; WI[i * 64 + j] = pi[i * 64]; } }
    LDS_WAIT(); __builtin_amdgcn_wave_barrier();
    const float ba = INP(I_LBA)[(l * 2 + d) * DR + 64 * h + j], bi = INP(I_LBI)[(l * 2 + d) * DR + 64 * h + j], k2 = F_LRUK[(l * 2 + d) * DR + 64 * h + j];
    float* HX = d ? F_HB : F_HF;
    float hst = 0.f;
    for (int seg = 0; seg < 2; ++seg) {
        const int L = seg == 0 ? CTXL : SEQ; const int rowbase = seg == 0 ? ML + b * CTXL : b * SEQ;
        for (int s0 = 0; s0 < L; s0 += 4) {
            float xv[4];
#pragma unroll
            for (int q = 0; q < 4; ++q) { const int t = d ? L - 1 - (s0 + q) : s0 + q; xv[q] = F_XR[(size_t)(rowbase + t) * DR + 64 * h + j]; }
#pragma unroll
            for (int q = 0; q < 4; ++q) {
                const int t = d ? L - 1 - (s0 + q) : s0 + q; const float x = xv[q];
                xs[j] = x; LDS_WAIT(); __builtin_amdgcn_wave_barrier();
                float za = ba, zi = bi;
#pragma unroll 16
                for (int i = 0; i < 64; ++i) { const float xi = xs[i]; za += xi * WA[i * 64 + j]; zi += xi * WI[i * 64 + j]; }
                __builtin_amdgcn_wave_barrier();
                const float r_ = sigm(za), ig = sigm(zi);
                const float a = __builtin_amdgcn_exp2f(-k2 * r_);
                const float mult = sqrtf(fmaxf(1.0f - a * a, 0.f));
                hst = a * hst + mult * ig * x;
                HX[(size_t)(rowbase + t) * DR + 64 * h + j] = hst;
            }
        }
    }
}
__device__ __forceinline__ void sc_combine(Frame& F) {
    for (size_t idx = (size_t)F.bid * NTHREADS + F.tid; idx < (size_t)M * (DR / 2); idx += (size_t)F.G * NTHREADS) {
        const int row = (int)(idx >> 8), c = (int)(idx & 255) * 2;
        const unsigned gg = *(const unsigned*)(F_P + (size_t)row * PW + 1536 + c);
        const size_t o = (size_t)row * DR + c;
        const float r0 = (F_HF[o] + F_HB[o]) * bflo(gg), r1 = (F_HF[o + 1] + F_HB[o + 1]) * bfhi(gg);
        *(unsigned*)(F_MIX + (size_t)row * D + 512 + c) = pk2(r0, r1);
    }
}

constexpr int NPOS = 66;
constexpr int S_XRB = 0, S_WG = 16384, S_A = 49152, S_B = 81920, S_HS = 114688, S_AGGW = 133120;
struct SUnit { int b, p, L, t0, rowbase; };
__device__ __forceinline__ void s_unit(int u, SUnit& U) { const int idx = u >> 3; U.b = idx / NPOS; U.p = idx - U.b * NPOS; const bool isctx = U.p < 2; U.L = isctx ? CTXL : SEQ; U.t0 = isctx ? 128 * U.p : 128 * (U.p - 2); U.rowbase = isctx ? ML + U.b * CTXL : U.b * SEQ; }
template <bool APPLY>
__device__ __forceinline__ void s_phase(Frame& F, int l) {
    const int tid = F.tid, lane = F.lane, wave = F.wave; LAS unsigned char* lds = F.lds;
    const int h = F.bid & 7;
    const bf16* Pb = F_P; bf16* MIXb = F_MIX; float* AGGb = F_AGG; const float* CARb = F_CAR; unsigned* ABb = F_AB;
    const float* rcw = INP(I_RCW) + (size_t)l * 4 * DR + 64 * h; const float* rcb = INP(I_RCB) + (size_t)l * DR + 64 * h;
    LAS float* Al = (LAS float*)(lds + S_A); LAS float* Bl = (LAS float*)(lds + S_B); LAS unsigned short* HS = (LAS unsigned short*)(lds + S_HS); LAS float* AGGW = (LAS float*)(lds + S_AGGW);
    { const bf16* WGb = F_WGATE;
#pragma unroll
      for (int i = 0; i < 4; ++i) { const int q = tid + 512 * i, d = q >> 10, qq = q & 1023, gate = qq >> 9, n = (qq >> 3) & 63, ch = qq & 7;
          const v4u v = *(const v4u*)(WGb + (size_t)(((l * 2 + d) * 8 + h) * 2) * 4096 + (size_t)qq * 8);
          *(LAS v4u*)(lds + S_WG + d * 16384 + gate * 8192 + n * 128 + ((ch ^ (n & 7)) * 16)) = v; } }
    float k2r[2][4], bar[2][4], bir[2][4];
    { const float* lba = INP(I_LBA) + (size_t)l * 2 * DR + 64 * h; const float* lbi = INP(I_LBI) + (size_t)l * 2 * DR + 64 * h; const float* LRUKb = F_LRUK + (size_t)l * 2 * DR + 64 * h;
#pragma unroll
      for (int d = 0; d < 2; ++d)
#pragma unroll
          for (int ct = 0; ct < 4; ++ct) { const int chl = 16 * ct + (lane & 15); k2r[d][ct] = LRUKb[d * DR + chl]; bar[d][ct] = lba[d * DR + chl]; bir[d][ct] = lbi[d * DR + chl]; } }
    const int t = tid >> 2, cg = tid & 3;
    v4u rA[4], rB[4], g0, g1; float car0 = 0.f, car1 = 0.f; unsigned rmask = 0u;
#define S_PREFETCH(u_) do { SUnit V; s_unit((u_), V); const int tt_ = V.t0 + t; rmask = 0u; \
        _Pragma("unroll") for (int k = 0; k < 4; ++k) { const int ts = tt_ + k - 2; if (ts >= 0 && ts < V.L) { const bf16* rp = Pb + (size_t)(V.rowbase + ts) * PW + 1024 + 64 * h + 16 * cg; rA[k] = *(const v4u*)rp; rB[k] = *(const v4u*)(rp + 8); rmask |= 1u << k; } } \
        if (APPLY) { const bf16* gp = Pb + (size_t)(V.rowbase + tt_) * PW + 1536 + 64 * h + 16 * cg; g0 = *(const v4u*)gp; g1 = *(const v4u*)(gp + 8); \
            const int pb_ = V.p < 2 ? 1 - V.p : 67 - V.p; car0 = CARb[(size_t)((V.b * 2 + 0) * NPOS + V.p) * DR + 64 * h + lane]; car1 = CARb[(size_t)((V.b * 2 + 1) * NPOS + pb_) * DR + 64 * h + lane]; } } while (0)
    int u = F.bid;
    if (u < NB * NPOS * 8) S_PREFETCH(u);
    __syncthreads();
    for (; u < NB * NPOS * 8; u += F.G) {
        SUnit U; s_unit(u, U); const int tt = U.t0 + t;
        { float xr[16];
#pragma unroll
          for (int q = 0; q < 4; ++q) { const f32x4 bv = *(const f32x4*)(rcb + 16 * cg + 4 * q); xr[4 * q] = bv.x; xr[4 * q + 1] = bv.y; xr[4 * q + 2] = bv.z; xr[4 * q + 3] = bv.w; }
#pragma unroll
          for (int k = 0; k < 4; ++k) { if (rmask & (1u << k)) { const v4u r0 = rA[k], r1 = rB[k];
#pragma unroll
                  for (int q = 0; q < 4; ++q) { const f32x4 wv = *(const f32x4*)(rcw + k * DR + 16 * cg + 4 * q); const unsigned wa = q < 2 ? r0[2 * q] : r1[2 * q - 4], wb = q < 2 ? r0[2 * q + 1] : r1[2 * q - 3];
                      xr[4 * q] += wv.x * bflo(wa); xr[4 * q + 1] += wv.y * bfhi(wa); xr[4 * q + 2] += wv.z * bflo(wb); xr[4 * q + 3] += wv.w * bfhi(wb); } } }
          v4u o0, o1; o0.x = pk2(xr[0], xr[1]); o0.y = pk2(xr[2], xr[3]); o0.z = pk2(xr[4], xr[5]); o0.w = pk2(xr[6], xr[7]); o1.x = pk2(xr[8], xr[9]); o1.y = pk2(xr[10], xr[11]); o1.z = pk2(xr[12], xr[13]); o1.w = pk2(xr[14], xr[15]);
          *(LAS v4u*)(lds + S_XRB + t * 128 + (((2 * cg) ^ (t & 7)) * 16)) = o0; *(LAS v4u*)(lds + S_XRB + t * 128 + (((2 * cg + 1) ^ (t & 7)) * 16)) = o1; }
        const v4u cg0 = g0, cg1 = g1; const float ccar0 = car0, ccar1 = car1;
        if (u + F.G < NB * NPOS * 8) S_PREFETCH(u + F.G);
        __syncthreads();
#pragma unroll
        for (int d = 0; d < 2; ++d) {
            const int pos = d == 0 ? U.p : (U.p < 2 ? 1 - U.p : 67 - U.p);
            f32x4 za[4], zi[4];
            { bf16x8 af[2]; const int row = 16 * wave + (lane & 15);
#pragma unroll
              for (int ks = 0; ks < 2; ++ks) { const int chk = (lane >> 4) + 4 * ks; af[ks] = *(const LAS bf16x8*)(lds + S_XRB + row * 128 + ((chk ^ (row & 7)) * 16)); }
#pragma unroll
              for (int ct = 0; ct < 4; ++ct) { const int chl = 16 * ct + (lane & 15); const float ba_ = bar[d][ct], bi_ = bir[d][ct]; za[ct] = (f32x4){ba_, ba_, ba_, ba_}; zi[ct] = (f32x4){bi_, bi_, bi_, bi_};
#pragma unroll
                  for (int ks = 0; ks < 2; ++ks) { const int chk = (lane >> 4) + 4 * ks; const int wo = d * 16384 + chl * 128 + ((chk ^ (chl & 7)) * 16);
                      const bf16x8 fa = *(const LAS bf16x8*)(lds + S_WG + wo), fi = *(const LAS bf16x8*)(lds + S_WG + 8192 + wo);
                      za[ct] = __builtin_amdgcn_mfma_f32_16x16x32_bf16(af[ks], fa, za[ct], 0, 0, 0); zi[ct] = __builtin_amdgcn_mfma_f32_16x16x32_bf16(af[ks], fi, zi[ct], 0, 0, 0); } } }
#pragma unroll
            for (int ct = 0; ct < 4; ++ct) { const int chl = 16 * ct + (lane & 15); const float k2 = k2r[d][ct];
#pragma unroll
                for (int q = 0; q < 4; ++q) { const int tk = 16 * wave + 4 * (lane >> 4) + q;
                    const float x = bf2f(*(const LAS unsigned short*)(lds + S_XRB + tk * 128 + ((((chl >> 3)) ^ (tk & 7)) * 16) + (chl & 7) * 2));
                    const float r_ = sigm(za[ct][q]), ig = sigm(zi[ct][q]); const unsigned laq = f2bf(-k2 * r_); const float a = __builtin_amdgcn_exp2f(bf2f(laq)); const float mult = __builtin_amdgcn_sqrtf(fmaxf(1.0f - a * a, 0.f));
                    const unsigned bq = f2bf(mult * ig * x);
                    Al[tk * 64 + chl] = a; Bl[tk * 64 + chl] = bf2f(bq);
                    if (STORE_AB && !APPLY) ABb[((size_t)d * M + U.rowbase + U.t0 + tk) * DR + 64 * h + chl] = laq | (bq << 16); } }
            __syncthreads();
            { float Pl = 1.f, Hl = 0.f;
#pragma unroll
              for (int s_ = 0; s_ < 16; ++s_) { const int tk = 16 * wave + (d ? 15 - s_ : s_); const float a = Al[tk * 64 + lane], bb = Bl[tk * 64 + lane]; Hl = a * Hl + bb; Pl *= a; }
              AGGW[(wave * 64 + lane) * 2] = Pl; AGGW[(wave * 64 + lane) * 2 + 1] = Hl; }
            __syncthreads();
            if (!APPLY) {
                if (wave == 0) { float Pc = 1.f, Hc = 0.f;
#pragma unroll
                    for (int k = 0; k < 8; ++k) { const int w2 = d ? 7 - k : k; const float pw = AGGW[(w2 * 64 + lane) * 2], hw = AGGW[(w2 * 64 + lane) * 2 + 1]; Hc = pw * Hc + hw; Pc *= pw; }
                    float* ag = AGGb + ((size_t)((U.b * 2 + d) * NPOS + pos) * DR + 64 * h + lane) * 2; ag[0] = Pc; ag[1] = Hc; }
            } else {
                float hst = d ? ccar1 : ccar0;
#pragma unroll
                for (int k = 0; k < 8; ++k) { const int w2 = d ? 7 - k : k; const bool before = d ? (w2 > wave) : (w2 < wave);
                    if (before) { const float pw = AGGW[(w2 * 64 + lane) * 2], hw = AGGW[(w2 * 64 + lane) * 2 + 1]; hst = pw * hst + hw; } }
#pragma unroll
                for (int s_ = 0; s_ < 16; ++s_) { const int tk = 16 * wave + (d ? 15 - s_ : s_); const float a = Al[tk * 64 + lane], bb = Bl[tk * 64 + lane]; hst = a * hst + bb;
                    if (d == 0) HS[tk * 64 + lane] = (unsigned short)f2bf(hst); else HS[tk * 64 + lane] = (unsigned short)f2bf(bf2f(HS[tk * 64 + lane]) + hst); }
            }
            __syncthreads();
        }
        if (APPLY) {
            const LAS v4u* hp = (const LAS v4u*)(HS + t * 64 + 16 * cg); const v4u h0 = hp[0], h1 = hp[1];
            v4u o0, o1;
#pragma unroll
            for (int q = 0; q < 4; ++q) { o0[q] = pk2(bflo(h0[q]) * bflo(cg0[q]), bfhi(h0[q]) * bfhi(cg0[q])); o1[q] = pk2(bflo(h1[q]) * bflo(cg1[q]), bfhi(h1[q]) * bfhi(cg1[q])); }
            bf16* op = MIXb + (size_t)(U.rowbase + tt) * D + 512 + 64 * h + 16 * cg; *(v4u*)op = o0; *(v4u*)(op + 8) = o1;
            __syncthreads();
        }
    }
#undef S_PREFETCH
}
__device__ __forceinline__ void s1_phase(Frame& F, int l) {
    const int tid = F.tid, lane = F.lane, wave = F.wave; LAS unsigned char* lds = F.lds;
    const int h = F.bid & 7;
    const bf16* Pb = F_P; float* AGGb = F_AGG; unsigned* ABb = F_AB;
    const float* rcw = INP(I_RCW) + (size_t)l * 4 * DR + 64 * h; const float* rcb = INP(I_RCB) + (size_t)l * DR + 64 * h;
    LAS float* AGW = (LAS float*)(lds + S_A);
    { const bf16* WGb = F_WGATE;
#pragma unroll
      for (int i = 0; i < 4; ++i) { const int q = tid + 512 * i, d = q >> 10, qq = q & 1023, gate = qq >> 9, n = (qq >> 3) & 63, ch = qq & 7;
          const v4u v = *(const v4u*)(WGb + (size_t)(((l * 2 + d) * 8 + h) * 2) * 4096 + (size_t)qq * 8);
          *(LAS v4u*)(lds + S_WG + d * 16384 + gate * 8192 + n * 128 + ((ch ^ (n & 7)) * 16)) = v; } }
    float k2r[2][4], bar[2][4], bir[2][4];
    { const float* lba = INP(I_LBA) + (size_t)l * 2 * DR + 64 * h; const float* lbi = INP(I_LBI) + (size_t)l * 2 * DR + 64 * h; const float* LRUKb = F_LRUK + (size_t)l * 2 * DR + 64 * h;
#pragma unroll
      for (int d = 0; d < 2; ++d)
#pragma unroll
          for (int ct = 0; ct < 4; ++ct) { const int chl = 16 * ct + (lane & 15); k2r[d][ct] = LRUKb[d * DR + chl]; bar[d][ct] = lba[d * DR + chl]; bir[d][ct] = lbi[d * DR + chl]; } }
    const int t = tid >> 2, cg = tid & 3, grp = lane >> 4;
    v4u rA[4], rB[4]; unsigned rmask = 0u;
#define S1_PREFETCH(u_) do { SUnit V; s_unit((u_), V); const int tt_ = V.t0 + t; rmask = 0u; \
        _Pragma("unroll") for (int k = 0; k < 4; ++k) { const int ts = tt_ + k - 2; if (ts >= 0 && ts < V.L) { const bf16* rp = Pb + (size_t)(V.rowbase + ts) * PW + 1024 + 64 * h + 16 * cg; rA[k] = *(const v4u*)rp; rB[k] = *(const v4u*)(rp + 8); rmask |= 1u << k; } } } while (0)
    int u = F.bid;
    if (u < NB * NPOS * 8) S1_PREFETCH(u);
    __syncthreads();
    for (; u < NB * NPOS * 8; u += F.G) {
        SUnit U; s_unit(u, U);
        { float xr[16];
#pragma unroll
          for (int q = 0; q < 4; ++q) { const f32x4 bv = *(const f32x4*)(rcb + 16 * cg + 4 * q); xr[4 * q] = bv.x; xr[4 * q + 1] = bv.y; xr[4 * q + 2] = bv.z; xr[4 * q + 3] = bv.w; }
#pragma unroll
          for (int k = 0; k < 4; ++k) { if (rmask & (1u << k)) { const v4u r0 = rA[k], r1 = rB[k];
#pragma unroll
                  for (int q = 0; q < 4; ++q) { const f32x4 wv = *(const f32x4*)(rcw + k * DR + 16 * cg + 4 * q); const unsigned wa = q < 2 ? r0[2 * q] : r1[2 * q - 4], wb = q < 2 ? r0[2 * q + 1] : r1[2 * q - 3];
                      xr[4 * q] += wv.x * bflo(wa); xr[4 * q + 1] += wv.y * bfhi(wa); xr[4 * q + 2] += wv.z * bflo(wb); xr[4 * q + 3] += wv.w * bfhi(wb); } } }
          v4u o0, o1; o0.x = pk2(xr[0], xr[1]); o0.y = pk2(xr[2], xr[3]); o0.z = pk2(xr[4], xr[5]); o0.w = pk2(xr[6], xr[7]); o1.x = pk2(xr[8], xr[9]); o1.y = pk2(xr[10], xr[11]); o1.z = pk2(xr[12], xr[13]); o1.w = pk2(xr[14], xr[15]);
          *(LAS v4u*)(lds + S_XRB + t * 128 + (((2 * cg) ^ (t & 7)) * 16)) = o0; *(LAS v4u*)(lds + S_XRB + t * 128 + (((2 * cg + 1) ^ (t & 7)) * 16)) = o1; }
        if (u + F.G < NB * NPOS * 8) S1_PREFETCH(u + F.G);
        __syncthreads();
        bf16x8 af[2]; { const int row = 16 * wave + (lane & 15);
#pragma unroll
          for (int ks = 0; ks < 2; ++ks) { const int chk = grp + 4 * ks; af[ks] = *(const LAS bf16x8*)(lds + S_XRB + row * 128 + ((chk ^ (row & 7)) * 16)); } }
        float xv[4][4];
#pragma unroll
        for (int ct = 0; ct < 4; ++ct) { const int chl = 16 * ct + (lane & 15);
#pragma unroll
            for (int q = 0; q < 4; ++q) { const int tk = 16 * wave + 4 * grp + q; xv[ct][q] = bf2f(*(const LAS unsigned short*)(lds + S_XRB + tk * 128 + ((((chl >> 3)) ^ (tk & 7)) * 16) + (chl & 7) * 2)); } }
#pragma unroll
        for (int d = 0; d < 2; ++d) {
            unsigned* abrow = ABb + ((size_t)d * M + U.rowbase + U.t0 + 16 * wave + 4 * grp) * DR + 64 * h + (lane & 15);
#pragma unroll
            for (int ct = 0; ct < 4; ++ct) { const int chl = 16 * ct + (lane & 15); const float ba_ = bar[d][ct], bi_ = bir[d][ct], k2 = k2r[d][ct];
                f32x4 za = (f32x4){ba_, ba_, ba_, ba_}, zi = (f32x4){bi_, bi_, bi_, bi_};
#pragma unroll
                for (int ks = 0; ks < 2; ++ks) { const int chk = grp + 4 * ks; const int wo = d * 16384 + chl * 128 + ((chk ^ (chl & 7)) * 16);
                    const bf16x8 fa = *(const LAS bf16x8*)(lds + S_WG + wo), fi = *(const LAS bf16x8*)(lds + S_WG + 8192 + wo);
                    za = __builtin_amdgcn_mfma_f32_16x16x32_bf16(af[ks], fa, za, 0, 0, 0); zi = __builtin_amdgcn_mfma_f32_16x16x32_bf16(af[ks], fi, zi, 0, 0, 0); }
                float Pl = 1.f, Hl = 0.f;
#pragma unroll
                for (int qq = 0; qq < 4; ++qq) { const int q = d ? 3 - qq : qq;
                    const float r_ = sigm(za[q]), ig = sigm(zi[q]); const unsigned w = pk2(-k2 * r_, 0.f) & 0xffffu; const float a = __builtin_amdgcn_exp2f(bf2f(w)); const float mult = __builtin_amdgcn_sqrtf(fmaxf(1.0f - a * a, 0.f));
                    const unsigned bq = f2bf(mult * ig * xv[ct][q]); abrow[(size_t)q * DR + 16 * ct] = w | (bq << 16);
                    Hl = a * Hl + bf2f(bq); Pl *= a; }
                { const float Pp = __shfl_xor(Pl, 16), Hp = __shfl_xor(Hl, 16); const bool first = d ? ((grp & 1) != 0) : ((grp & 1) == 0);
                  const float Pn = Pl * Pp, Hn = first ? (Pp * Hl + Hp) : (Pl * Hp + Hl); Pl = Pn; Hl = Hn; }
                { const float Pp = __shfl_xor(Pl, 32), Hp = __shfl_xor(Hl, 32); const bool first = d ? ((grp & 2) != 0) : ((grp & 2) == 0);
                  const float Pn = Pl * Pp, Hn = first ? (Pp * Hl + Hp) : (Pl * Hp + Hl); Pl = Pn; Hl = Hn; }
                if (lane < 16) { AGW[((d * 8 + wave) * 64 + chl) * 2] = Pl; AGW[((d * 8 + wave) * 64 + chl) * 2 + 1] = Hl; }
            }
        }
        __syncthreads();
        if (wave < 2) { const int d = wave; const int pos = d == 0 ? U.p : (U.p < 2 ? 1 - U.p : 67 - U.p); float Pc = 1.f, Hc = 0.f;
#pragma unroll
            for (int k = 0; k < 8; ++k) { const int w2 = d ? 7 - k : k; const float pw = AGW[((d * 8 + w2) * 64 + lane) * 2], hw = AGW[((d * 8 + w2) * 64 + lane) * 2 + 1]; Hc = pw * Hc + hw; Pc *= pw; }
            float* ag = AGGb + ((size_t)((U.b * 2 + d) * NPOS + pos) * DR + 64 * h + lane) * 2; ag[0] = Pc; ag[1] = Hc; }
    }
#undef S1_PREFETCH
}
__device__ __forceinline__ void s3r_phase(Frame& F) {
    const int lane = F.lane, wave = F.wave; LAS unsigned char* lds = F.lds;
    const int h = F.bid & 7;
    const GAS bf16* Pb = (const GAS bf16*)F_P; GAS bf16* MIXb = (GAS bf16*)F_MIX; const GAS float* CARb = (const GAS float*)F_CAR; const GAS unsigned* ABb = (const GAS unsigned*)F_AB;
    LAS float* AGW = (LAS float*)(lds + S_A);
    unsigned wf[16], wb[16]; unsigned short gq[16]; float car0 = 0.f, car1 = 0.f;
#define S3R_PREFETCH(u_) do { SUnit V; s_unit((u_), V); const size_t r0_ = (size_t)(V.rowbase + V.t0 + 16 * wave); const int c_ = 64 * h + lane; \
        _Pragma("unroll") for (int s_ = 0; s_ < 16; ++s_) { wf[s_] = ABb[(r0_ + s_) * DR + c_]; wb[s_] = ABb[((size_t)M + r0_ + s_) * DR + c_]; gq[s_] = Pb[(r0_ + s_) * PW + 1536 + c_]; } \
        const int pb_ = V.p < 2 ? 1 - V.p : 67 - V.p; car0 = CARb[(size_t)((V.b * 2 + 0) * NPOS + V.p) * DR + c_]; car1 = CARb[(size_t)((V.b * 2 + 1) * NPOS + pb_) * DR + c_]; } while (0)
    int u = F.bid, par = 0;
    if (u < NB * NPOS * 8) S3R_PREFETCH(u);
    for (; u < NB * NPOS * 8; u += F.G, par ^= 1) {
        SUnit U; s_unit(u, U);
        float af[16], bfv[16], ab[16], bb[16], gv[16];
#pragma unroll
        for (int s_ = 0; s_ < 16; ++s_) { af[s_] = __builtin_amdgcn_exp2f(bflo(wf[s_])); bfv[s_] = bfhi(wf[s_]); ab[s_] = __builtin_amdgcn_exp2f(bflo(wb[s_])); bb[s_] = bfhi(wb[s_]); gv[s_] = bf2f(gq[s_]); }
        const float c0 = car0, c1 = car1;
        if (u + F.G < NB * NPOS * 8) S3R_PREFETCH(u + F.G);
        { float P0 = 1.f, H0 = 0.f, P1 = 1.f, H1 = 0.f;
#pragma unroll
          for (int s_ = 0; s_ < 16; ++s_) { H0 = af[s_] * H0 + bfv[s_]; P0 *= af[s_]; H1 = ab[15 - s_] * H1 + bb[15 - s_]; P1 *= ab[15 - s_]; }
          LAS float* aw = AGW + (size_t)par * 2048;
          aw[((0 * 8 + wave) * 64 + lane) * 2] = P0; aw[((0 * 8 + wave) * 64 + lane) * 2 + 1] = H0; aw[((1 * 8 + wave) * 64 + lane) * 2] = P1; aw[((1 * 8 + wave) * 64 + lane) * 2 + 1] = H1; }
        __syncthreads();
        float hf[16];
        { const LAS float* aw = AGW + (size_t)par * 2048; float hst = c0;
#pragma unroll
          for (int k = 0; k < 8; ++k) { if (k < wave) { const float pw = aw[((0 * 8 + k) * 64 + lane) * 2], hw = aw[((0 * 8 + k) * 64 + lane) * 2 + 1]; hst = pw * hst + hw; } }
#pragma unroll
          for (int s_ = 0; s_ < 16; ++s_) { hst = af[s_] * hst + bfv[s_]; hf[s_] = hst; }
          hst = c1;
#pragma unroll
          for (int k = 7; k >= 0; --k) { if (k > wave) { const float pw = aw[((1 * 8 + k) * 64 + lane) * 2], hw = aw[((1 * 8 + k) * 64 + lane) * 2 + 1]; hst = pw * hst + hw; } }
          GAS bf16* op = MIXb + (size_t)(U.rowbase + U.t0 + 16 * wave) * D + 512 + 64 * h + lane;
#pragma unroll
          for (int s_ = 15; s_ >= 0; --s_) { hst = ab[s_] * hst + bb[s_]; op[(size_t)s_ * D] = (bf16)f2bf((hf[s_] + hst) * gv[s_]); } }
    }
#undef S3R_PREFETCH
}
__device__ __forceinline__ void s3_phase(Frame& F) {
    const int tid = F.tid, lane = F.lane, wave = F.wave; LAS unsigned char* lds = F.lds;
    const int h = F.bid & 7;
    const bf16* Pb = F_P; bf16* MIXb = F_MIX; const float* CARb = F_CAR; const unsigned* ABb = F_AB;
    LAS float* Al = (LAS float*)(lds + S_A); LAS float* Bl = (LAS float*)(lds + S_B); LAS unsigned short* HS = (LAS unsigned short*)(lds + S_HS); LAS float* AGGW = (LAS float*)(lds + S_AGGW);
    const int t = tid >> 2, cg = tid & 3;
    v4u ab[2][4], g0, g1; float car0 = 0.f, car1 = 0.f;
#define S3_PREFETCH(u_) do { SUnit V; s_unit((u_), V); const int tt_ = V.t0 + t; \
        _Pragma("unroll") for (int d = 0; d < 2; ++d) { const unsigned* ap = ABb + ((size_t)d * M + V.rowbase + tt_) * DR + 64 * h + 16 * cg; \
            _Pragma("unroll") for (int q = 0; q < 4; ++q) ab[d][q] = *(const v4u*)(ap + 4 * q); } \
        { const bf16* gp = Pb + (size_t)(V.rowbase + tt_) * PW + 1536 + 64 * h + 16 * cg; g0 = *(const v4u*)gp; g1 = *(const v4u*)(gp + 8); \
          const int pb_ = V.p < 2 ? 1 - V.p : 67 - V.p; car0 = CARb[(size_t)((V.b * 2 + 0) * NPOS + V.p) * DR + 64 * h + lane]; car1 = CARb[(size_t)((V.b * 2 + 1) * NPOS + pb_) * DR + 64 * h + lane]; } } while (0)
    int u = F.bid;
    if (u < NB * NPOS * 8) S3_PREFETCH(u);
    for (; u < NB * NPOS * 8; u += F.G) {
        SUnit U; s_unit(u, U); const int tt = U.t0 + t;
        v4u cab[2][4];
#pragma unroll
        for (int d = 0; d < 2; ++d)
#pragma unroll
            for (int q = 0; q < 4; ++q) cab[d][q] = ab[d][q];
        const v4u cg0 = g0, cg1 = g1; const float ccar0 = car0, ccar1 = car1;
        if (u + F.G < NB * NPOS * 8) S3_PREFETCH(u + F.G);
#pragma unroll
        for (int d = 0; d < 2; ++d) {
#pragma unroll
            for (int q = 0; q < 4; ++q) { f32x4 av, bv;
#pragma unroll
                for (int e = 0; e < 4; ++e) { const unsigned w = cab[d][q][e]; av[e] = __builtin_amdgcn_exp2f(bflo(w)); bv[e] = bfhi(w); }
                *(LAS f32x4*)(Al + t * 64 + 16 * cg + 4 * q) = av; *(LAS f32x4*)(Bl + t * 64 + 16 * cg + 4 * q) = bv; }
            __syncthreads();
            { float Pl = 1.f, Hl = 0.f;
#pragma unroll
              for (int s_ = 0; s_ < 16; ++s_) { const int tk = 16 * wave + (d ? 15 - s_ : s_); const float a = Al[tk * 64 + lane], bb = Bl[tk * 64 + lane]; Hl = a * Hl + bb; Pl *= a; }
              AGGW[(wave * 64 + lane) * 2] = Pl; AGGW[(wave * 64 + lane) * 2 + 1] = Hl; }
            __syncthreads();
            { float hst = d ? ccar1 : ccar0;
#pragma unroll
              for (int k = 0; k < 8; ++k) { const int w2 = d ? 7 - k : k; const bool before = d ? (w2 > wave) : (w2 < wave);
                  if (before) { const float pw = AGGW[(w2 * 64 + lane) * 2], hw = AGGW[(w2 * 64 + lane) * 2 + 1]; hst = pw * hst + hw; } }
#pragma unroll
              for (int s_ = 0; s_ < 16; ++s_) { const int tk = 16 * wave + (d ? 15 - s_ : s_); const float a = Al[tk * 64 + lane], bb = Bl[tk * 64 + lane]; hst = a * hst + bb;
                  if (d == 0) HS[tk * 64 + lane] = (unsigned short)f2bf(hst); else HS[tk * 64 + lane] = (unsigned short)f2bf(bf2f(HS[tk * 64 + lane]) + hst); } }
            __syncthreads();
        }
        { const LAS v4u* hp = (const LAS v4u*)(HS + t * 64 + 16 * cg); const v4u h0 = hp[0], h1 = hp[1];
          v4u o0, o1;
#pragma unroll
          for (int q = 0; q < 4; ++q) { o0[q] = pk2(bflo(h0[q]) * bflo(cg0[q]), bfhi(h0[q]) * bfhi(cg0[q])); o1[q] = pk2(bflo(h1[q]) * bflo(cg1[q]), bfhi(h1[q]) * bfhi(cg1[q])); }
          bf16* op = MIXb + (size_t)(U.rowbase + tt) * D + 512 + 64 * h + 16 * cg; *(v4u*)op = o0; *(v4u*)(op + 8) = o1; }
        __syncthreads();
    }
#undef S3_PREFETCH
}
__device__ __forceinline__ void s3_stream(Frame& F) {
    const GAS unsigned* ABb = (const GAS unsigned*)F_AB; const GAS float* CARb = (const GAS float*)F_CAR; const GAS bf16* Pb = (const GAS bf16*)F_P; GAS bf16* MIXb = (GAS bf16*)F_MIX; const int lane = F.lane;
    for (int u = F.bid * NWAVES + F.wave; u < NB * NPOS * 8; u += F.G * NWAVES) {
        const int h = u & 7, idx = u >> 3, b = idx / NPOS, p = idx - b * NPOS; const bool isctx = p < 2;
        const int row0 = (isctx ? ML + b * CTXL + 128 * p : b * SEQ + 128 * (p - 2)); const int pb = p < 2 ? 1 - p : 67 - p; const int c = 64 * h + lane;
        const GAS unsigned* abf = ABb + (size_t)row0 * DR + c; const GAS unsigned* abb = ABb + ((size_t)M + row0) * DR + c;
        const GAS bf16* gp = Pb + (size_t)row0 * PW + 1536 + c; GAS bf16* op = MIXb + (size_t)row0 * D + 512 + c;
        float hf[128];
        float hst = CARb[(size_t)((b * 2 + 0) * NPOS + p) * DR + c];
#pragma unroll
        for (int bt = 0; bt < 8; ++bt) { unsigned w[16];
#pragma unroll
            for (int i = 0; i < 16; ++i) w[i] = abf[(size_t)(16 * bt + i) * DR];
#pragma unroll
            for (int i = 0; i < 16; ++i) { hst = __builtin_amdgcn_exp2f(bflo(w[i])) * hst + bfhi(w[i]); hf[16 * bt + i] = hst; } }
        hst = CARb[(size_t)((b * 2 + 1) * NPOS + pb) * DR + c];
#pragma unroll
        for (int bt = 7; bt >= 0; --bt) { unsigned w[16]; unsigned short g[16]; float o[16];
#pragma unroll
            for (int i = 0; i < 16; ++i) { w[i] = abb[(size_t)(16 * bt + i) * DR]; g[i] = gp[(size_t)(16 * bt + i) * PW]; }
#pragma unroll
            for (int i = 15; i >= 0; --i) { hst = __builtin_amdgcn_exp2f(bflo(w[i])) * hst + bfhi(w[i]); o[i] = (hf[16 * bt + i] + hst) * bf2f(g[i]); }
#pragma unroll
            for (int i = 0; i < 16; ++i) op[(size_t)(16 * bt + i) * D] = (bf16)f2bf(o[i]); }
    }
}
__device__ __forceinline__ void s2_carry(Frame& F) {
    const int gw = F.bid * NWAVES + F.wave; if (gw >= NB * 2 * 8) return;
    const int b = gw >> 4, d = (gw >> 3) & 1, h = gw & 7;
    const float* ag = F_AGG + ((size_t)(b * 2 + d) * NPOS * DR + 64 * h + F.lane) * 2; float* car = F_CAR + (size_t)(b * 2 + d) * NPOS * DR + 64 * h + F.lane;
    float hst = 0.f;
#pragma unroll 1
    for (int p0 = 0; p0 < NPOS; p0 += 22) { float pa[22], ha[22];
#pragma unroll
        for (int k = 0; k < 22; ++k) { pa[k] = ag[(size_t)(p0 + k) * DR * 2]; ha[k] = ag[(size_t)(p0 + k) * DR * 2 + 1]; }
#pragma unroll
        for (int k = 0; k < 22; ++k) { car[(size_t)(p0 + k) * DR] = hst; hst = pa[k] * hst + ha[k]; } }
}

__device__ __forceinline__ void moe_dispatch(Frame& F, int moe) {
    LAS int* tab = (LAS int*)(F.lds + 131072 + 1024);
    if (F.tid == 0) { int off = 0; for (int e = 0; e < NE; ++e) { const int c = (int)__hip_atomic_load(F.ctl + CW_CNT + moe * 512 + e * 64, RLX_AGENT); tab[16 + e] = c; tab[32 + e] = off; off += (c + 255) & ~255; } tab[40] = off; }
    __syncthreads();
    const int total = tab[40]; const bf16* HNb = F_HN; bf16* HS = F_Y; const int* list = F_LIST;
    for (int s0 = (F.bid * NWAVES + F.wave) * 4; s0 < total; s0 += F.G * NWAVES * 4) {
        v4u a[4], b[4];
#pragma unroll
        for (int q = 0; q < 4; ++q) { const int s_ = s0 + q; a[q] = (v4u){0u, 0u, 0u, 0u}; b[q] = a[q];
            int e = 0;
#pragma unroll
            for (int k = 1; k < NE; ++k) e += (s_ >= tab[32 + k]) ? 1 : 0;
            const int rank = s_ - tab[32 + e];
            if (s_ < total && rank < tab[16 + e]) { const int tok = list[(size_t)e * M + rank]; const bf16* src = HNb + (size_t)tok * D + 16 * F.lane; a[q] = *(const v4u*)src; b[q] = *(const v4u*)(src + 8); } }
#pragma unroll
        for (int q = 0; q < 4; ++q) { const int s_ = s0 + q; if (s_ < total) { bf16* dst = HS + (size_t)s_ * D + 16 * F.lane; *(v4u*)dst = a[q]; *(v4u*)(dst + 8) = b[q]; } }
    }
}
__device__ __forceinline__ void combine_rows(Frame& F, int moe, int lc, bool latent_only) {
    LAS int* OFFS = (LAS int*)(F.lds + 32768 + 8192 + 128);
    if (F.tid == 0) { int o = 0; for (int e = 0; e < NE; ++e) { OFFS[e] = o; const int c = (int)__hip_atomic_load(F.ctl + CW_CNT + moe * 512 + e * 64, RLX_AGENT); o += (c + 255) & ~255; } }
    __syncthreads();
    const unsigned* INFOb = F_INFO + (size_t)moe * M * 8; const bf16* Yb = F_Y; const float* MODb = F_MOD + (size_t)lc * 5 * (6 * D) + 5 * D;
    bf16* XBb = F_XB;
    for (int i0 = F.wave; i0 < ROWS_PER_WG; i0 += 2 * NWAVES) {
        int rr[2]; bool on[2]; int e1[2], q1[2], e2[2], q2[2]; float g1[2], g2[2];
#pragma unroll
        for (int k = 0; k < 2; ++k) { const int i = i0 + k * NWAVES; rr[k] = F.bid * ROWS_PER_WG + i; on[k] = (i < ROWS_PER_WG) && !(latent_only && rr[k] >= ML);
            if (on[k]) { const unsigned* inf = INFOb + (size_t)rr[k] * 8; e1[k] = (int)inf[0]; q1[k] = (int)inf[1]; e2[k] = (int)inf[2]; q2[k] = (int)inf[3]; g1[k] = __builtin_bit_cast(float, inf[4]); g2[k] = __builtin_bit_cast(float, inf[5]); } }
        v2u xw[2][4], ya[2][4], yb[2][4]; f32x4 gvv[2][4];
#pragma unroll
        for (int k = 0; k < 2; ++k) if (on[k]) {
            const int s1 = OFFS[__builtin_amdgcn_readfirstlane(e1[k])] + __builtin_amdgcn_readfirstlane(q1[k]), s2 = OFFS[__builtin_amdgcn_readfirstlane(e2[k])] + __builtin_amdgcn_readfirstlane(q2[k]);
            const bf16* y1 = Yb + (size_t)s1 * D, * y2 = Yb + (size_t)s2 * D; const bf16* xs = XBb + (size_t)rr[k] * D;
            const int bb = rr[k] < ML ? (rr[k] >> 13) : 4; const float* gf = MODb + (size_t)bb * (6 * D);
#pragma unroll
            for (int j = 0; j < 4; ++j) { const int col = 4 * F.lane + 256 * j; xw[k][j] = *(const v2u*)(xs + col); ya[k][j] = *(const v2u*)(y1 + col); yb[k][j] = *(const v2u*)(y2 + col); gvv[k][j] = *(const f32x4*)(gf + col); } }
#pragma unroll
        for (int k = 0; k < 2; ++k) if (on[k]) {
            bf16* xs = XBb + (size_t)rr[k] * D; const float ga = g1[k], gb = g2[k];
#pragma unroll
            for (int j = 0; j < 4; ++j) { const int col = 4 * F.lane + 256 * j; const f32x4 gv = gvv[k][j]; const v2u x = xw[k][j], a = ya[k][j], b = yb[k][j];
                const f32x4 xv = (f32x4){bflo(x.x), bfhi(x.x), bflo(x.y), bfhi(x.y)};
                f32x4 yy; yy.x = ga * bflo(a.x) + gb * bflo(b.x); yy.y = ga * bfhi(a.x) + gb * bfhi(b.x); yy.z = ga * bflo(a.y) + gb * bflo(b.y); yy.w = ga * bfhi(a.y) + gb * bfhi(b.y);
                const f32x4 xn = xv + gv * yy; v2u o; o.x = pk2(xn.x, xn.y); o.y = pk2(xn.z, xn.w); *(v2u*)(xs + col) = o; } }
    }
    asm volatile("s_waitcnt vmcnt(0)" ::: "memory");
    __syncthreads();
    if (F.tid == 0) { __builtin_amdgcn_fence(__ATOMIC_RELEASE, "agent"); __builtin_amdgcn_fence(__ATOMIC_ACQUIRE, "agent"); asm volatile("s_waitcnt vmcnt(0)" ::: "memory"); }
    __syncthreads();
}
#define DIAG 0
#ifndef TPROBE
#define TPROBE 0
#endif
#ifndef TP_MASK
#define TP_MASK 0x1FFF
#endif
#ifndef TP_SEL
#define TP_SEL 1
#endif
#ifndef TP_MUL
#define TP_MUL 4
#endif
constexpr int CW_TP = 3072;
__device__ __forceinline__ unsigned tp_now() { return (unsigned)__builtin_amdgcn_s_memrealtime(); }
__device__ __forceinline__ int tp_class(int ph) { if (ph == 0) return 0; const int q = ph - 1, l = q / 10, s_ = q - l * 10; if (l >= DEPTH) return 12; if (s_ <= 6) return 1 + s_; return (s_ == 8 ? 8 : 9) + 2 * (l & 1); }
__device__ __forceinline__ bool phase_enter(Frame& F) { int ln = (int)__builtin_amdgcn_mbcnt_hi(~0u, __builtin_amdgcn_mbcnt_lo(~0u, 0u)); asm volatile("" : "+v"(ln)); int wv = F.wave0; asm volatile("" : "+s"(wv));
    F.lane = ln; F.wave = wv; F.tid = wv * 64 + ln;     int bi_ = blockIdx.x; asm volatile("" : "+s"(bi_)); F.bid = bi_; GAS unsigned char* w = F.ws_g; asm volatile("" : "+s"(w)); F.ws_g = w; GAS float* o = F.out_g; asm volatile("" : "+s"(o)); F.out_g = o; return true; }
__device__ __forceinline__ bool phase_runs(int lo, int hi, int ph) { asm volatile("" : "+s"(ph)); return lo <= ph && ph < hi; }
constexpr int PH_PER_LAYER = 10, NPH = 1 + DEPTH * PH_PER_LAYER + 1;
__global__ void __launch_bounds__(NTHREADS, 2) fwd_kernel(Args args) {
    extern __shared__ __attribute__((aligned(16))) unsigned char lds_raw[];
    Frame F;
    F.lds = (LAS unsigned char*)0;
    if (args.ph_lo < -1) lds_raw[0] = 0;
    F.MISC = (volatile LAS unsigned*)(F.lds + MISC_OFF);
    F.tid = threadIdx.x; F.lane = F.tid & 63; F.wave = __builtin_amdgcn_readfirstlane(F.tid >> 6); F.wave0 = F.wave; F.bid = blockIdx.x; F.G = gridDim.x;
    F.out_g = (GAS float*)args.out; F.ws_g = (GAS unsigned char*)args.ws; unsigned char* ws = args.ws;
    F.ctl = (gu32*)(ws + WS_CTL);
    for (int u = F.tid; u < 64; u += NTHREADS) F.MISC[u] = 0u;
    if (F.tid == 0) { volatile LAS unsigned long long* tb = (volatile LAS unsigned long long*)(F.lds + INTAB_OFF);
#pragma unroll
        for (int i = 0; i < N_IN; ++i) tb[i] = (unsigned long long)args.in[i]; }
    __syncthreads();
#if MK_ONE_LAUNCH
    XcdBarrier bar = xcd_barrier_post((unsigned*)(F.ctl + CW_BAR), F.MISC + 8);
#define GRID_BAR() xcd_barrier(bar)
#else
#define GRID_BAR() do { if (F.tid == 0) __hip_atomic_store(F.ctl + CW_TMO, 0xBADBA0u, RLX_AGENT); } while (0)
#endif
    const int lo = args.ph_lo, hi = args.ph_hi;
    int ph = 0;
#if TPROBE
    if (F.tid == 0) F.MISC[15] = tp_now();
#endif
#define RUNS() (phase_runs(lo, hi, ph) && phase_enter(F))
#if TPROBE
#define SEAM() do { if (ph + 1 < hi) { const int c_ = tp_class(ph); __syncthreads(); if (F.tid == 0) { const unsigned n_ = tp_now(); F.MISC[16 + 2 * c_] += n_ - F.MISC[15]; F.MISC[14] = n_; } GRID_BAR(); \
    if (F.tid == 0) { const unsigned n_ = tp_now(); F.MISC[17 + 2 * c_] += n_ - F.MISC[14]; F.MISC[15] = n_; } } } while (0)
#else
#define SEAM() do { if (ph + 1 < hi) GRID_BAR(); } while (0)
#endif

    if (RUNS()) { p0_prologue(F);
#if REPEAT == 1
        GRID_BAR(); p0_prologue(F);
#endif
        SEAM(); } ++ph;
    for (int l = 0; l < DEPTH; ++l) {
        const bool first = (l == 0);
        const float* modl = F_MOD + (size_t)l * 5 * (6 * D);
        if (RUNS()) {
#if DIAG
            if (l == 2) { diag_comb_pre(F, 0, 1); }
            if (l == 0) {  }
#endif
            if (l == 2) combine_rows(F, 0, 1, false);
            n_phase<false>(F, l, 0, 0, first);
#if REPEAT == 2
            if (l != 2) { GRID_BAR(); n_phase<false>(F, l, 0, 0, first); }
#endif
#if REPEAT == 12
            if (l == 2) { GRID_BAR(); convert_moe_range(F, 1, 0, MOE_ITEMS, F.bid, F.G); }
#endif
#if DIAG
            if (l == 2) { __syncthreads(); diag_comb_post(F, false, 7); }
#endif

            SEAM(); } ++ph;
        if (RUNS()) {
#if FAST_GEMM & 1
            { pg8::ProbDense S; S.A = F_HN; S.Bt = F_WIN + (size_t)l * DIN * D; S.K = D; S.ord.init(M / 256, DIN / 256, F.G, F.bid, WGM_G1); pg8::EpiP E{F_P}; pg8::gemm_phase(F.lds, S, E, F.tid);
              if (l == 0) tail_convert(F, S.ord.nwg, 0, 0, TAIL0_A); else if (l == 1) tail_convert(F, S.ord.nwg, 0, TAIL0_B, TAIL0_END); else if (l == 2) tail_convert(F, S.ord.nwg, 1, TAIL1_A, TAIL1_B);
#if REPEAT == 6
              GRID_BAR(); pg8::gemm_phase(F.lds, S, E, F.tid);
#endif
            }
#else
            NG g{}; g.A = F_HN; g.lda = D; g.ridx = nullptr; g.nvalid = 0; g.arow0 = 0; g.Bt = F_WIN + (size_t)l * DIN * D; g.K = D; g.nrows = M; g.O = F_P; g.ldo = PW; g.orow0 = 0;
            g.ncols = 512; g.pcol0 = 0; g.pair = 0; g.mode = 0; g.ocol0 = 0; gemm_naive(F, g);
            g.pcol0 = 512; g.pair = 1; g.mode = 2; g.ocol0 = 512; gemm_naive(F, g);
            g.pcol0 = 1536; g.pair = 0; g.mode = 0; g.ocol0 = 1024; gemm_naive(F, g);
            g.pcol0 = 2048; g.pair = 0; g.mode = 1; g.ocol0 = 1536; gemm_naive(F, g);
#endif
            SEAM(); } ++ph;
        if (RUNS()) {
#if FAST_SCAN
            s1_phase(F, l);
#if REPEAT == 3
            GRID_BAR(); s1_phase(F, l);
#endif
#if REPEAT == 13
            GRID_BAR(); sa_mx(F, l);
#endif
#else
            sa_xr_conv(F, l); sa_mx(F, l);
#endif
            SEAM(); } ++ph;
        if (RUNS()) {
#if FAST_SCAN
            s2_carry(F); sa_mx(F, l);
#if REPEAT == 4
            GRID_BAR(); s2_carry(F);
#endif
#else
            sb_scan_naive(F, l);
#endif
            SEAM(); } ++ph;
        if (RUNS()) {
#if FAST_SCAN
            s3r_phase(F);
#if REPEAT == 5
            GRID_BAR(); s3r_phase(F);
#endif
#else
            sc_combine(F);
#endif
            SEAM(); } ++ph;
        if (RUNS()) {
#if FAST_GEMM & 2
            { pg8::ProbDense S; S.A = F_MIX; S.Bt = F_WOUT + (size_t)l * D * D; S.K = D; S.ord.init(ML / 256, D / 256, F.G, F.bid, WGM_G2);
              if (first) { pg8::EpiRes<true> E{INP(I_X), F_XB, modl + 2 * D}; pg8::gemm_phase(F.lds, S, E, F.tid); } else { pg8::EpiRes<false> E{nullptr, F_XB, modl + 2 * D}; pg8::gemm_phase(F.lds, S, E, F.tid); }
#if REPEAT == 20
              GRID_BAR(); { pg8::EpiRes<false> E{nullptr, F_XB, (const float*)(((unsigned char*)F.ws_g) + 128 * 1024)}; pg8::gemm_phase(F.lds, S, E, F.tid); }
#endif
            }
            if (l != DEPTH - 1) gemm_ctx_res(F, F_MIX, D, F_WOUT + (size_t)l * D * D, D, first, modl + 4 * (6 * D) + 2 * D);
#else
            NG g{}; g.A = F_MIX; g.lda = D; g.Bt = F_WOUT + (size_t)l * D * D; g.K = D; g.nrows = M; g.ncols = D; g.mode = 4; g.xl_src = xl_src; g.xc_src = xc_src; g.gate = modl + 2 * D;
            gemm_naive(F, g);
#endif
            SEAM(); } ++ph;
        if (RUNS()) { if (l & 1) n_phase<true>(F, l, 1, l >> 1, false); else { n_phase<false>(F, l, 1, 0, false); if (l == 2) convert_moe_range(F, 1, TAIL1_C, TAIL1_UP, F.bid, F.G);
#if REPEAT == 11
            GRID_BAR(); n_phase<false>(F, l, 1, 0, false);
#endif
            } SEAM(); } ++ph;
        if (RUNS()) { if ((l & 1) && !MOE_GATHER) {
            moe_dispatch(F, l >> 1);
#if REPEAT == 7
            GRID_BAR(); moe_dispatch(F, l >> 1);
#endif
            SEAM(); } } ++ph;
        if (RUNS()) {
#if DIAG
#endif
            if (!(l & 1)) {
#if FAST_GEMM & 4
                pg8::ProbDense S; S.A = F_HN; S.Bt = F_WDGU + (size_t)(l >> 1) * 2 * FD * D; S.K = D; S.ord.init(M / 256, 2 * FD / 256, F.G, F.bid, WGM_WIDE); pg8::EpiGLU E{F_HID, FD}; pg8::gemm_phase(F.lds, S, E, F.tid);
                if (l == 0) tail_convert(F, S.ord.nwg, 0, TAIL0_A, TAIL0_B); else tail_convert(F, S.ord.nwg, 1, TAIL1_B, TAIL1_C);
#if REPEAT == 8
                GRID_BAR(); pg8::gemm_phase(F.lds, S, E, F.tid);
#endif
#else
                NG g{}; g.A = F_HN; g.lda = D; g.Bt = F_WDGU + (size_t)(l >> 1) * 2 * FD * D; g.K = D; g.nrows = M; g.ncols = FD; g.pair = 1; g.mode = 3; g.O = F_HID; g.ldo = FD; gemm_naive(F, g);
#endif
            } else {
#if FAST_GEMM & 16
                LAS int* tab = (LAS int*)(F.lds + 131072 + 1024);
                if (F.tid == 0) { int tp = 0, off = 0; for (int e = 0; e < NE; ++e) { const int c = (int)__hip_atomic_load(F.ctl + CW_CNT + (l >> 1) * 512 + e * 64, RLX_AGENT); tab[e] = tp; tab[16 + e] = c; tab[32 + e] = off; tp += (c + 255) >> 8; off += (c + 255) & ~255; } tab[8] = tp; }
                __syncthreads();
                pg8::ProbMoeT<(MOE_GATHER != 0)> S; S.A = MOE_GATHER ? F_HN : F_Y  ; S.Bt = F_WMGU; S.list = F_LIST; S.tab_ = tab; S.K = D; S.bt_rows = 2 * FM; S.up = (MOE_GATHER != 0); S.ord.init(__builtin_amdgcn_readfirstlane(tab[8]), 2 * FM / 256, F.G, F.bid, WGM_WIDE);
                pg8::EpiGLU E{F_HID, FM}; pg8::gemm_phase(F.lds, S, E, F.tid);
#if !(REPEAT == 9)
                tail_convert(F, S.ord.nwg, l >> 1, (l == 1) ? TAIL0_UP : TAIL1_UP, MOE_ITEMS);
#endif
#if REPEAT == 9
                GRID_BAR(); pg8::gemm_phase(F.lds, S, E, F.tid);
#endif
#else
                int off = 0;
                for (int e = 0; e < NE; ++e) { const int c = (int)__hip_atomic_load(F.ctl + CW_CNT + (l >> 1) * 512 + e * 64, RLX_AGENT); const int nr = (c + 255) & ~255;
                    NG g{}; g.A = F_HN; g.lda = D; g.ridx = F_LIST + (size_t)e * M; g.nvalid = c; g.Bt = F_WMGU + (size_t)e * 2 * FM * D; g.K = D; g.nrows = nr; g.ncols = FM; g.pair = 1; g.mode = 3; g.O = F_HID; g.ldo = FM; g.orow0 = off;
                    if (c > 0) gemm_naive(F, g); off += nr; }
#endif
            }
            SEAM(); } ++ph;
        if (RUNS()) {
            if (!(l & 1)) {
#if FAST_GEMM & 8
                pg8::ProbDense S; S.A = F_HID; S.Bt = F_WDD + (size_t)(l >> 1) * D * FD; S.K = FD; S.ord.init(ML / 256, D / 256, F.G, F.bid, WGM_G4); pg8::EpiRes<false> E{nullptr, F_XB, modl + 5 * D}; phase_enter(F); pg8::gemm_phase(F.lds, S, E, F.tid);
#if REPEAT == 21
                GRID_BAR(); { pg8::EpiRes<false> E2{nullptr, F_XB, (const float*)(((unsigned char*)F.ws_g) + 128 * 1024)}; pg8::gemm_phase(F.lds, S, E2, F.tid); }
#endif
                phase_enter(F); gemm_ctx_res(F, F_HID, FD, F_WDD + (size_t)(l >> 1) * D * FD, FD, false, modl + 4 * (6 * D) + 5 * D);
#else
                NG g{}; g.A = F_HID; g.lda = FD; g.Bt = F_WDD + (size_t)(l >> 1) * D * FD; g.K = FD; g.nrows = M; g.ncols = D; g.mode = 4; g.xl_src = ((float*)F.out_g); g.xc_src = F_XC; g.gate = modl + 5 * D; gemm_naive(F, g);
#endif
            } else {
#if FAST_GEMM & 32
                LAS int* tab = (LAS int*)(F.lds + 131072 + 1024);
                if (F.tid == 0) { int tp = 0, off = 0; for (int e = 0; e < NE; ++e) { const int c = (int)__hip_atomic_load(F.ctl + CW_CNT + (l >> 1) * 512 + e * 64, RLX_AGENT); tab[e] = tp; tab[16 + e] = c; tab[32 + e] = off; tp += (c + 255) >> 8; off += (c + 255) & ~255; } tab[8] = tp; }
                __syncthreads();
                if (l == 1) {
                pg8::ProbMoeT<false> S; S.A = F_HID; S.Bt = F_WMD; S.list = F_LIST; S.tab_ = tab; S.K = FM; S.bt_rows = D; S.up = false; S.ord.init(__builtin_amdgcn_readfirstlane(tab[8]), D / 256, F.G, F.bid, WGM_DEEPK);
                pg8::EpiBf E{F_Y, D}; phase_enter(F); pg8::gemm_phase(F.lds, S, E, F.tid);
                tail_convert(F, S.ord.nwg, 1, 0, TAIL1_A);
                } else {
                pg8::ProbMoeSplit S; S.A = F_HID; S.Bt = F_WMD; S.list = F_LIST; S.tab_ = tab; S.K = FM; S.bt_rows = D; S.up = false; S.ord.init(__builtin_amdgcn_readfirstlane(tab[8]), D / 256, F.G, F.bid, WGM_DEEPK); S.init_split();
                pg8::EpiBfSplit E{F_Y, D, (float*)F_HN, (unsigned*)(F.ctl + CW_SPLIT)}; phase_enter(F); pg8::gemm_phase(F.lds, S, E, F.tid);
                }
#if REPEAT == 10
                GRID_BAR(); phase_enter(F); pg8::gemm_phase(F.lds, S, E, F.tid);
#endif
#else
                int off = 0;
                for (int e = 0; e < NE; ++e) { const int c = (int)__hip_atomic_load(F.ctl + CW_CNT + (l >> 1) * 512 + e * 64, RLX_AGENT); const int nr = (c + 255) & ~255;
                    NG g{}; g.A = F_HID; g.lda = FM; g.arow0 = off; g.Bt = F_WMD + (size_t)e * D * FM; g.K = FM; g.nrows = nr; g.ncols = D; g.mode = 0; g.O = F_Y; g.ldo = D; g.orow0 = off;
                    if (c > 0) gemm_naive(F, g); off += nr; }
#endif
            }
            SEAM(); } ++ph;
    }
    if (RUNS()) {
#if DIAG
        diag_comb_pre(F, 1, DEPTH - 1);
#endif
        combine_rows(F, 1, DEPTH - 1, true);
        n_phase<false>(F, 0, 2, 0, false);
#if TPROBE
        __syncthreads();
        if (F.tid == 0) { const unsigned n_ = tp_now(); F.MISC[16 + 24] += n_ - F.MISC[15]; unsigned busy = 0, wait = 0;
            for (int c = 0; c < 13; ++c) if ((TP_MASK >> c) & 1) { busy += F.MISC[16 + 2 * c]; wait += F.MISC[17 + 2 * c]; }
            __hip_atomic_fetch_add(F.ctl + CW_TP, busy, RLX_AGENT); __hip_atomic_fetch_add(F.ctl + CW_TP + 64, wait, RLX_AGENT); }
        asm volatile("s_waitcnt vmcnt(0)" ::: "memory");
        GRID_BAR();
        if (F.tid == 0) { const unsigned bt = __hip_atomic_load(F.ctl + CW_TP, RLX_AGENT), wt = __hip_atomic_load(F.ctl + CW_TP + 64, RLX_AGENT);
            const unsigned q = (TP_SEL == 0 ? bt : TP_SEL == 1 ? wt : bt + wt) / 256u * TP_MUL; const unsigned t0 = tp_now(); while (tp_now() - t0 < q) __builtin_amdgcn_s_sleep(32); }
        __syncthreads();
#endif
#if DIAG
        __syncthreads();
        { const unsigned fs = __hip_atomic_load(F.ctl + CW_FLAG + 64, RLX_AGENT), fc = __hip_atomic_load(F.ctl + CW_FLAG + 128, RLX_AGENT); const unsigned fo = __hip_atomic_load(F.ctl + CW_FLAG + 192, RLX_AGENT); const unsigned tot = fs + fc + fo + 1u; const unsigned fl = (fs * 100u / tot) + 1000u * (fc * 100u / tot) + 1000000u * (fo * 100u / tot);     if (fl) { __syncthreads(); const float sc = 1.0f + (float)fl;
            for (int i = F.wave; i < ROWS_PER_WG; i += NWAVES) { const int r = F.bid * ROWS_PER_WG + i; if (r < ML) { for (int c = F.lane; c < D; c += 64) ((float*)F.out_g)[(size_t)r * D + c] *= sc; } } } }
#endif
    } ++ph;
}

extern "C" void kernel_launch(void* const* d_in, const int* in_sizes, int n_in, void* d_out, int out_size, void* d_ws, size_t ws_size, hipStream_t stream) {
    static int grid = 0;
    if (grid == 0) {
        if (n_in != N_IN || in_sizes[0] != ML * D || out_size != ML * D || ws_size < WS_END) { fprintf(stderr, "kernel_launch: unexpected shapes (n_in %d, in0 %d, out %d, ws %zu)\n", n_in, n_in > 0 ? in_sizes[0] : -1, out_size, ws_size); grid = -1; return; }
        int dev = 0, cus = 0, per_cu = 0;
        if (hipGetDevice(&dev) != hipSuccess || hipDeviceGetAttribute(&cus, hipDeviceAttributeMultiprocessorCount, dev) != hipSuccess) { grid = -1; return; }
        if (hipFuncSetAttribute((const void*)fwd_kernel, hipFuncAttributeMaxDynamicSharedMemorySize, LDS_BYTES) != hipSuccess) { fprintf(stderr, "kernel_launch: hipFuncSetAttribute failed\n"); grid = -1; return; }
        if (hipOccupancyMaxActiveBlocksPerMultiprocessor(&per_cu, (const void*)fwd_kernel, NTHREADS, LDS_BYTES) != hipSuccess || per_cu < 1) fprintf(stderr, "kernel_launch: occupancy query reports %d\n", per_cu);
        (void)hipGetLastError();
        grid = cus;
        if (grid != 256) { fprintf(stderr, "kernel_launch: built for 256 CUs, device has %d\n", cus); grid = -1; return; }
    }
    if (grid < 0) return;
    (void)hipMemsetAsync((char*)d_ws + WS_CTL, 0, CTL_ZERO_BYTES, stream);
    Args a{};
    for (int i = 0; i < N_IN; ++i) a.in[i] = (const float*)d_in[i];
    a.out = (float*)d_out; a.ws = (unsigned char*)d_ws;
#if MK_ONE_LAUNCH
    a.ph_lo = 0; a.ph_hi = NPH;
    hipLaunchKernelGGL(fwd_kernel, dim3(grid), dim3(NTHREADS), LDS_BYTES, stream, a);
#else
    for (int p = 0; p < NPH; ++p) { a.ph_lo = p; a.ph_hi = p + 1; hipLaunchKernelGGL(fwd_kernel, dim3(grid), dim3(NTHREADS), LDS_BYTES, stream, a); }
#endif
}
```

```cpp
#include <hip/hip_runtime.h>
#include <cstdio>
#include <cstdint>

#ifndef FAST_GEMM
#define FAST_GEMM 63
#endif
#ifndef FAST_SCAN
#define FAST_SCAN 1
#endif
#ifndef ALT_MOD
#define ALT_MOD 0
#endif
#ifndef REPEAT
#define REPEAT 0
#endif
#ifndef EPI2
#define EPI2 0
#endif
#ifndef STORE_AB
#define STORE_AB 1
#endif
#ifndef MOE_GATHER
#define MOE_GATHER 1
#endif
#ifndef WGM_DEEPK
#define WGM_DEEPK 2
#endif
#ifndef WGM_WIDE
#define WGM_WIDE 4
#endif
#ifndef PG8_SP2
#define PG8_SP2 1
#endif
#ifndef WGM_G1
#define WGM_G1 2
#endif
#ifndef WGM_G2
#define WGM_G2 4
#endif
#ifndef WGM_G4
#define WGM_G4 8
#endif
#ifndef MK_ONE_LAUNCH
#define MK_ONE_LAUNCH 1
#endif

constexpr int D = 1024, NB = 4, SEQ = 8192, CTXL = 256, ML = NB * SEQ, MC = NB * CTXL, M = ML + MC;
constexpr int DIN = 2560, PW = 2048, FD = 2816, FM = 3584, NE = 8, DEPTH = 4;
constexpr int DR = 512;
constexpr int NSLOT = 69632;
constexpr float EPS = 1e-6f;
constexpr int NWAVES = 8, NTHREADS = 512;
constexpr int ROWS_PER_WG = 132;

constexpr size_t MiB = 1u << 20;
constexpr size_t WS_CTL = 0, CTL_ZERO_BYTES = (REPEAT == 20 || REPEAT == 21) ? 256 * 1024 : 64 * 1024;
constexpr size_t WS_MOD = 1 * MiB;
constexpr size_t WS_LRUK = 1 * MiB + 512 * 1024;
constexpr size_t WS_INFO = 2 * MiB;
constexpr size_t WS_LIST = 5 * MiB;
constexpr size_t WS_AGG = 7 * MiB;
constexpr size_t WS_XC = 10 * MiB;
constexpr size_t WS_WGATE = 14 * MiB;
constexpr size_t WS_WIN = 15 * MiB;
constexpr size_t WS_WOUT = 35 * MiB;
constexpr size_t WS_WDGU = 43 * MiB;
constexpr size_t WS_WDD = 65 * MiB;
constexpr size_t WS_WMGU = 76 * MiB;
constexpr size_t WS_WMD = 188 * MiB;
constexpr size_t WS_HN = 244 * MiB;
constexpr size_t WS_Y = 310 * MiB;
constexpr size_t WS_BIG = 446 * MiB;
constexpr size_t WS_P = WS_BIG;
constexpr size_t WS_MIX = WS_BIG + 132 * MiB;
constexpr size_t WS_AB = WS_BIG + 198 * MiB;
constexpr size_t WS_XR = WS_BIG + 198 * MiB;
constexpr size_t WS_HF = WS_BIG + 264 * MiB;
constexpr size_t WS_HB = WS_BIG + 330 * MiB;
constexpr size_t WS_CAR = 922 * MiB;
constexpr size_t WS_XB = 924 * MiB;
constexpr size_t WS_END = 990 * MiB;
constexpr int CW_TMO = 0;
constexpr int CW_CNT = 1024;
constexpr int CW_SPLIT = 3200;
constexpr int CW_BAR = 4096;

constexpr int LDS_BYTES = 155648;
constexpr int GIDX_OFF = 147456;
constexpr int MISC_OFF = 131072 + 8192;

#define GAS __attribute__((address_space(1)))
#define LAS __attribute__((address_space(3)))
typedef unsigned short bf16;
typedef unsigned v4u __attribute__((ext_vector_type(4)));
typedef unsigned v2u __attribute__((ext_vector_type(2)));
typedef float f32x4 __attribute__((ext_vector_type(4)));
typedef short bf16x8 __attribute__((ext_vector_type(8)));
typedef GAS unsigned gu32;
#define RLX_AGENT __ATOMIC_RELAXED, __HIP_MEMORY_SCOPE_AGENT
#define LDS_WAIT() asm volatile("s_waitcnt lgkmcnt(0)" ::: "memory")
#define VM_WAIT() asm volatile("s_waitcnt vmcnt(0)" ::: "memory")
typedef float f32x2_t __attribute__((ext_vector_type(2)));
typedef double f64x2_t __attribute__((ext_vector_type(2)));
typedef __bf16 bf16x2_t __attribute__((ext_vector_type(2)));
__device__ __forceinline__ unsigned f2bf(float f) { return (unsigned)__builtin_bit_cast(unsigned short, (__bf16)f); }
__device__ __forceinline__ unsigned pk2(float lo, float hi) { const f32x2_t v = {lo, hi}; return __builtin_bit_cast(unsigned, __builtin_convertvector(v, bf16x2_t)); }
__device__ __forceinline__ float bf2f(unsigned b) { return __builtin_bit_cast(float, b << 16); }
__device__ __forceinline__ float bflo(unsigned w) { return __builtin_bit_cast(float, w << 16); }
__device__ __forceinline__ float bfhi(unsigned w) { return __builtin_bit_cast(float, w & 0xffff0000u); }
__device__ __forceinline__ float sigm(float x) { return __builtin_amdgcn_rcpf(1.f + __builtin_amdgcn_exp2f(-1.44269504089f * x)); }
__device__ __forceinline__ float sigm_p(float x) { return 1.0f / (1.0f + expf(-x)); }
__device__ __forceinline__ float silu_f(float x) { return x * sigm(x); }
__device__ __forceinline__ float gelu_tanh_f(float x) { return x * sigm(1.5957691216057308f * (x + 0.044715f * x * x * x)); }
__device__ __forceinline__ float wave_sum(float v) {
#define WS_DPP(ctrl, rmask) v += __builtin_bit_cast(float, __builtin_amdgcn_update_dpp(0, __builtin_bit_cast(int, v), (ctrl), (rmask), 0xF, false))
    WS_DPP(0xB1, 0xF);
    WS_DPP(0x4E, 0xF);
    WS_DPP(0x141, 0xF);
    WS_DPP(0x140, 0xF);
    WS_DPP(0x142, 0xA);
    WS_DPP(0x143, 0xC);
#undef WS_DPP
    return __builtin_bit_cast(float, __builtin_amdgcn_readlane(__builtin_bit_cast(int, v), 63));
}

#define XB_TMO      128
#define XB_XCNT(j)  (256  + 64 * (j))
#define XB_XSUB(j)  (1280 + 64 * (j))
#define XB_XGEN(j)  (2304 + 64 * (j))
#define XB_TOP      3328
#define XB_TOPGEN   3392
#define XCD_BAR_WORDS 3456
#define XB_SPIN_CAP (1u << 21)
__device__ __forceinline__ unsigned xb_ld(unsigned* p)              { return __hip_atomic_load(p, __ATOMIC_RELAXED, __HIP_MEMORY_SCOPE_AGENT); }
__device__ __forceinline__ unsigned xb_add(unsigned* p, unsigned v) { return __hip_atomic_fetch_add(p, v, __ATOMIC_RELAXED, __HIP_MEMORY_SCOPE_AGENT); }
__device__ __forceinline__ unsigned xb_xcc_id() { return (unsigned)__builtin_amdgcn_s_getreg((3 << 11) | 20) & 0xFu; }
#define XB_SPIN(cond, bar) do { unsigned _sp = 0; while (cond) { __builtin_amdgcn_s_sleep(1); \
    if ((++_sp & 255u) == 0u) { if (xb_ld(&(bar)[XB_TMO])) break; if (_sp > XB_SPIN_CAP) { atomicAdd(&(bar)[XB_TMO], 1u); break; } } } } while (0)
struct XcdBarrier { unsigned* bar; unsigned x; volatile LAS unsigned* st; };
__device__ __forceinline__ XcdBarrier xcd_barrier_post(unsigned* bar, volatile LAS unsigned* st) {
    XcdBarrier b; b.bar = bar; b.x = xb_xcc_id(); b.st = st;
    if (threadIdx.x == 0) (void)xb_add(&bar[XB_XCNT(b.x)], 1u);
    return b;
}
__device__ __forceinline__ void xcd_barrier_complete(unsigned* bar, unsigned x, unsigned& nloc, unsigned& nx) {
    const unsigned G = gridDim.x * gridDim.y * gridDim.z;
    unsigned sum, cnt, mine, sp = 0u;
    for (;;) {
        sum = 0u; cnt = 0u; mine = 0u;
#pragma unroll
        for (unsigned j = 0; j < 16; ++j) { const unsigned c = xb_ld(&bar[XB_XCNT(j)]); sum += c; cnt += (c > 0u) ? 1u : 0u; mine = (j == x) ? c : mine; }
        if (sum == G) break;
        __builtin_amdgcn_s_sleep(1);
        if ((++sp & 255u) == 0u) { if (xb_ld(&bar[XB_TMO])) break; if (sp > XB_SPIN_CAP) { atomicAdd(&bar[XB_TMO], 1u); break; } }
    }
    nloc = mine > 0u ? mine : 1u; nx = cnt > 0u ? cnt : 1u;
}
__device__ __forceinline__ void xcd_barrier(const XcdBarrier& b) {
    asm volatile("s_waitcnt vmcnt(0)" ::: "memory");
    __syncthreads();
    if (threadIdx.x == 0) {
        unsigned* bar = b.bar;
        __builtin_amdgcn_s_waitcnt(0);
        unsigned nloc = b.st[0], nx = b.st[1];
        if (nloc == 0u) { xcd_barrier_complete(bar, b.x, nloc, nx); b.st[0] = nloc; b.st[1] = nx; }
        const unsigned old = xb_add(&bar[XB_XSUB(b.x)], 1u);
        const unsigned gen = old / nloc;
        if (old + 1u == (gen + 1u) * nloc) {
            __builtin_amdgcn_fence(__ATOMIC_RELEASE, "agent");
            asm volatile("s_waitcnt vmcnt(0)" ::: "memory");
            const unsigned og = xb_add(&bar[XB_TOP], 1u);
            const unsigned tg = og / nx;
            if (og + 1u == (tg + 1u) * nx) xb_add(&bar[XB_TOPGEN], 1u);
            else XB_SPIN(xb_ld(&bar[XB_TOPGEN]) == tg, bar);
            __builtin_amdgcn_fence(__ATOMIC_ACQUIRE, "agent");
            asm volatile("s_waitcnt vmcnt(0)" ::: "memory");
        } else {
            XB_SPIN(xb_ld(&bar[XB_TOPGEN]) == gen, bar);
            __builtin_amdgcn_fence(__ATOMIC_ACQUIRE, "agent");
            asm volatile("s_waitcnt vmcnt(0)" ::: "memory");
        }
    }
    __syncthreads();
}

enum { I_X = 0, I_C, I_CTX, I_CCTX, I_ADAW, I_ADAB, I_GMIX, I_GFFN, I_WIN, I_WOUT, I_CONVW, I_RCW, I_RCB, I_LWA, I_LBA, I_LWI, I_LBI, I_LAM,
       I_DWG, I_DWU, I_DWD, I_RW, I_RB, I_MWG, I_MWU, I_MWD, I_FG, N_IN };
struct Args { const float* in[N_IN]; float* out; unsigned char* ws; int ph_lo, ph_hi; };
struct Frame {
    LAS unsigned char* lds; volatile LAS unsigned* MISC; gu32* ctl;
    int tid, lane, wave, wave0, bid, G;
    GAS float* out_g; GAS unsigned char* ws_g;
};
constexpr int INTAB_OFF = MISC_OFF + 512;
__device__ __forceinline__ const float* in_ptr(const Frame& F, int i) { unsigned ad_ = (unsigned)(INTAB_OFF + 8 * i); asm volatile("" : "+v"(ad_));     const volatile LAS unsigned* t = (const volatile LAS unsigned*)(unsigned long)ad_; const unsigned lo = __builtin_amdgcn_readfirstlane(t[0]), hi = __builtin_amdgcn_readfirstlane(t[1]); return (const float*)(const GAS float*)(((unsigned long long)hi << 32) | lo); }
#define INP(i) in_ptr(F, (i))
#define WSP(T, off) ((T*)(F.ws_g + (off)))
#define F_MOD WSP(float, WS_MOD)
#define F_LRUK WSP(float, WS_LRUK)
#define F_INFO WSP(unsigned, WS_INFO)
#define F_LIST WSP(int, WS_LIST)
#define F_AGG WSP(float, WS_AGG)
#define F_XC WSP(float, WS_XC)
#define F_WGATE WSP(bf16, WS_WGATE)
#define F_WIN WSP(bf16, WS_WIN)
#define F_WOUT WSP(bf16, WS_WOUT)
#define F_WDGU WSP(bf16, WS_WDGU)
#define F_WDD WSP(bf16, WS_WDD)
#define F_WMGU WSP(bf16, WS_WMGU)
#define F_WMD WSP(bf16, WS_WMD)
#define F_HN WSP(bf16, WS_HN)
#define F_Y WSP(bf16, WS_Y)
#define F_HID WSP(bf16, WS_BIG)
#define F_P WSP(bf16, WS_P)
#define F_MIX WSP(bf16, WS_MIX)
#define F_XR WSP(float, WS_XR)
#define F_HF WSP(float, WS_HF)
#define F_HB WSP(float, WS_HB)
#define F_CAR WSP(float, WS_CAR)
#define F_AB WSP(unsigned, WS_AB)
#define F_XB WSP(bf16, WS_XB)

__device__ __forceinline__ void transpose_item(const float* W, int K, int N, bf16* WT, int k0, int n0, int dst_row0, LAS float* scr, int lane) {
    const int n4 = lane & 15, kr = lane >> 4;
    f32x4 v[16];
#pragma unroll
    for (int i = 0; i < 16; ++i) v[i] = __builtin_nontemporal_load((const f32x4*)(W + (size_t)(k0 + 4 * i + kr) * N + n0 + 4 * n4));
#pragma unroll
    for (int i = 0; i < 16; ++i) { LAS float* p = scr + (4 * i + kr) * 65 + 4 * n4; p[0] = v[i].x; p[1] = v[i].y; p[2] = v[i].z; p[3] = v[i].w; }
    LDS_WAIT(); asm volatile("" ::: "memory");
    const int c = lane & 7, nn = lane >> 3;
#pragma unroll
    for (int j = 0; j < 8; ++j) { const int n = nn + 8 * j; const LAS float* s = scr + (8 * c) * 65 + n;
        v4u o; o.x = pk2(s[0 * 65], s[1 * 65]); o.y = pk2(s[2 * 65], s[3 * 65]); o.z = pk2(s[4 * 65], s[5 * 65]); o.w = pk2(s[6 * 65], s[7 * 65]);
        *(GAS v4u*)(WT + (size_t)(dst_row0 + n) * K + k0 + 8 * c) = o; }
    LDS_WAIT(); asm volatile("" ::: "memory");
}
__device__ __forceinline__ int map_win(int n) { if (n < 512) return n; if (n < 1024) { const int j = n - 512; return 512 + 256 * (j >> 7) + (j & 127); } if (n < 1536) { const int j = n - 1024; return 512 + 256 * (j >> 7) + 128 + (j & 127); } return n; }
__device__ __forceinline__ int map_g(int n) { return 256 * (n >> 7) + (n & 127); }
__device__ __forceinline__ int map_u(int n) { return 256 * (n >> 7) + 128 + (n & 127); }

__device__ __forceinline__ bool transpose_group(int& it, const float* src, int nmat, int K, int N, bf16* dst, size_t dst_mat_stride, int mapkind, LAS float* scr, int lane) {
    const int nkb = K / 64, nnb = N / 64, per = nkb * nnb, tot = nmat * per;
    if (it >= tot) { it -= tot; return false; }
    const int mi = it / per, r = it % per, kb = r / nnb, nb = r % nnb, n0 = 64 * nb;
    const int d0 = mapkind == 0 ? n0 : (mapkind == 1 ? map_win(n0) : (mapkind == 2 ? map_g(n0) : map_u(n0)));
    transpose_item(src + (size_t)mi * K * N, K, N, dst + (size_t)mi * dst_mat_stride, 64 * kb, n0, d0, scr, lane);
    return true;
}
constexpr int TAIL0_A = 4200, TAIL0_B = 7600, TAIL0_END = 11800, TAIL1_A = 12000, TAIL1_B = 16200, TAIL1_C = 19600;
constexpr int TAIL0_UP = 18500, TAIL1_UP = 19600;
constexpr int MOE_ITEMS = 3 * NE * (D / 64) * (FM / 64);
__device__ __forceinline__ void convert_moe_range(Frame& F, int j, int lo, int hi, int kblk, int nblk) {
    LAS float* scr = (LAS float*)(F.lds + F.wave * 16640);
    constexpr int I_GU = NE * (D / 64) * (FM / 64);
    for (int it0 = lo + kblk * NWAVES + F.wave; it0 < hi; it0 += nblk * NWAVES) {
        int it = it0;
        if (transpose_group(it, INP(I_MWG) + (size_t)j * NE * D * FM, NE, D, FM, F_WMGU, (size_t)2 * FM * D, 2, scr, F.lane)) continue;
        if (transpose_group(it, INP(I_MWU) + (size_t)j * NE * D * FM, NE, D, FM, F_WMGU, (size_t)2 * FM * D, 3, scr, F.lane)) continue;
        transpose_group(it, INP(I_MWD) + (size_t)j * NE * FM * D, NE, FM, D, F_WMD, (size_t)D * FM, 0, scr, F.lane);
    }
}
__device__ __forceinline__ void tail_convert(Frame& F, int nwg, int j, int lo, int hi) {
    const int rem = nwg % F.G;
    if (rem == 0) convert_moe_range(F, j, lo, hi, F.bid, F.G);
    else if (F.bid >= rem) convert_moe_range(F, j, lo, hi, F.bid - rem, F.G - rem);
}
__device__ __forceinline__ void p0_prologue(Frame& F) {
    LAS float* S5 = (LAS float*)(F.lds + 0);
    LAS float* RED = (LAS float*)(F.lds + 20480);
    for (int i = F.tid; i < 5 * D; i += NTHREADS) { const float v = i < 4 * D ? INP(I_C)[i] : INP(I_CCTX)[i - 4 * D]; S5[i] = silu_f(v); }
    __syncthreads();
    for (int item = F.bid; item < DEPTH * 24; item += F.G) {
        const int l = item / 24, strip = item % 24;
        const float* wp = INP(I_ADAW) + ((size_t)l * D + 128 * F.wave) * (6 * D) + strip * 256 + 4 * F.lane;
        f32x4 a0 = (f32x4){0.f, 0.f, 0.f, 0.f}, a1 = a0, a2 = a0, a3 = a0, a4 = a0;
        const LAS float* s = S5 + 128 * F.wave;
#pragma unroll 16
        for (int kk = 0; kk < 128; ++kk) { const f32x4 wv = *(const f32x4*)(wp + (size_t)kk * (6 * D));
            a0 = a0 + wv * s[kk]; a1 = a1 + wv * s[D + kk]; a2 = a2 + wv * s[2 * D + kk]; a3 = a3 + wv * s[3 * D + kk]; a4 = a4 + wv * s[4 * D + kk]; }
        LAS f32x4* rw = (LAS f32x4*)RED + F.wave * 320 + F.lane;
        rw[0] = a0; rw[64] = a1; rw[128] = a2; rw[192] = a3; rw[256] = a4;
        __syncthreads();
        if (F.tid < 320) { f32x4 t = (f32x4){0.f, 0.f, 0.f, 0.f};
#pragma unroll
            for (int w = 0; w < 8; ++w) t = t + ((const LAS f32x4*)RED)[w * 320 + F.tid];
            const int r = F.tid >> 6, col = strip * 256 + 4 * (F.tid & 63);
            *(f32x4*)(F_MOD + ((size_t)l * 5 + r) * (6 * D) + col) = t + *(const f32x4*)(INP(I_ADAB) + l * 6 * D + col); }
        __syncthreads();
    }
#if ALT_MOD
    for (int idx = F.bid * NTHREADS + F.tid; idx < DEPTH * 5 * 6 * D; idx += F.G * NTHREADS) {
        const int l = idx / (5 * 6 * D), r = (idx / (6 * D)) % 5, col = idx % (6 * D);
        const float* cv = r < 4 ? INP(I_C) + r * D : INP(I_CCTX); const float* aw = INP(I_ADAW) + (size_t)l * D * (6 * D) + col;
        float acc = INP(I_ADAB)[l * 6 * D + col];
        for (int k = 0; k < D; ++k) { const float x = cv[k]; acc += (x / (1.0f + expf(-x))) * aw[(size_t)k * (6 * D)]; }
        F_MOD[idx] = acc; }
#endif
    { const int g = F.bid * NTHREADS + F.tid; if (g < DEPTH * 2 * DR) { const float lam = INP(I_LAM)[g]; F_LRUK[g] = 8.0f * log1pf(expf(-lam)) * 1.44269504089f; } }
    __syncthreads();
    LAS float* scr = (LAS float*)(F.lds + F.wave * 16640);
    constexpr int NMODWG = DEPTH * 24;
    const int gw = (F.bid >= NMODWG ? F.bid - NMODWG : F.G) * NWAVES + F.wave, NGW = (F.G - NMODWG) * NWAVES;
    constexpr int I_IN = DEPTH * (D / 64) * (DIN / 64), I_OUT = DEPTH * (D / 64) * (D / 64), I_DG = 2 * (D / 64) * (FD / 64), I_DD = 2 * (FD / 64) * (D / 64), I_LR = DEPTH * 2 * 8;
    constexpr int NIT = I_IN + I_OUT + 2 * I_DG + I_DD + 2 * I_LR;
    for (int it0 = gw; it0 < NIT && F.bid >= NMODWG; it0 += NGW) {
        int it = it0;
        if (transpose_group(it, INP(I_WIN), DEPTH, D, DIN, F_WIN, (size_t)DIN * D, 1, scr, F.lane)) continue;
        if (transpose_group(it, INP(I_WOUT), DEPTH, D, D, F_WOUT, (size_t)D * D, 0, scr, F.lane)) continue;
        if (transpose_group(it, INP(I_DWG), 2, D, FD, F_WDGU, (size_t)2 * FD * D, 2, scr, F.lane)) continue;
        if (transpose_group(it, INP(I_DWU), 2, D, FD, F_WDGU, (size_t)2 * FD * D, 3, scr, F.lane)) continue;
        if (transpose_group(it, INP(I_DWD), 2, FD, D, F_WDD, (size_t)D * FD, 0, scr, F.lane)) continue;
        if (transpose_group(it, INP(I_LWA), DEPTH * 2 * 8, 64, 64, F_WGATE, (size_t)2 * 64 * 64, 0, scr, F.lane)) continue;
        transpose_group(it, INP(I_LWI), DEPTH * 2 * 8, 64, 64, F_WGATE + 64 * 64, (size_t)2 * 64 * 64, 0, scr, F.lane);
    }
    convert_moe_range(F, 0, TAIL0_END, TAIL0_UP, F.bid, F.G);
}

template <bool ROUTE>
__device__ __forceinline__ void n_phase(Frame& F, int l, int kind, int moe, bool first) {
    LAS float* RWl = (LAS float*)(F.lds + 0);
    LAS float* RT = (LAS float*)(F.lds + 32768);
    LAS int* RK = (LAS int*)(F.lds + 32768 + 4096);
    LAS int* BASE = (LAS int*)(F.lds + 32768 + 8192);
    LAS float* RBl = (LAS float*)(F.lds + 32768 + 8192 + 64);
    if (ROUTE) { const float* rw = INP(I_RW) + (size_t)moe * D * NE; for (int i = F.tid; i < D * NE; i += NTHREADS) RWl[i] = rw[i]; if (F.tid < NE) RBl[F.tid] = INP(I_RB)[moe * NE + F.tid]; }
    __syncthreads();
    const float* gvec = kind == 2 ? INP(I_FG) : (kind == 0 ? INP(I_GMIX) + l * D : INP(I_GFFN) + l * D);
    const float* xin = INP(I_X); const float* cin = INP(I_CTX); const bf16* XBb = F_XB; float* outp = (float*)F.out_g;
    f32x4 mul[4], add[4], vn[4]; v2u vb[4];
    int cur_bb = -1; bool have_vn = false;
    const int row_base = F.bid * ROWS_PER_WG;
    float rbr[8];
#pragma unroll
    for (int e = 0; e < 8; ++e) rbr[e] = ROUTE ? RBl[e] : 0.f;
    f32x4 rwr[4][4][2];
    if (ROUTE) {
#pragma unroll
        for (int j = 0; j < 4; ++j)
#pragma unroll
            for (int q = 0; q < 4; ++q) { const LAS f32x4* rp = (const LAS f32x4*)(RWl + (4 * F.lane + 256 * j + q) * 8); rwr[j][q][0] = rp[0]; rwr[j][q][1] = rp[1]; } }
    for (int i = F.wave; i < ROWS_PER_WG; i += NWAVES) {
        const int r = row_base + i; const bool lat = r < ML;
        if (kind == 2 && !lat) { have_vn = false; continue; }
        if (ROUTE && l == DEPTH - 1 && !lat) {
            if (F.lane == 0) { int m1 = -1; asm volatile("" : "+v"(m1)); RT[i * 4 + 0] = __builtin_bit_cast(float, m1); RT[i * 4 + 1] = __builtin_bit_cast(float, m1); } have_vn = false; continue; }
        if (!have_vn) {
            if (first) { const float* xs0 = lat ? xin + (size_t)r * D : cin + (size_t)(r - ML) * D;
#pragma unroll
                for (int j = 0; j < 4; ++j) vn[j] = *(const f32x4*)(xs0 + 4 * F.lane + 256 * j); }
            else {
#pragma unroll
                for (int j = 0; j < 4; ++j) vb[j] = *(const v2u*)(XBb + (size_t)r * D + 4 * F.lane + 256 * j); }
            have_vn = true; }
        const int bb = lat ? (r >> 13) : 4;
        if (bb != cur_bb) { cur_bb = bb;
#pragma unroll
            for (int j = 0; j < 4; ++j) { const int col = 4 * F.lane + 256 * j; const f32x4 g = *(const f32x4*)(gvec + col);
                if (kind == 2) { mul[j] = g; add[j] = (f32x4){0.f, 0.f, 0.f, 0.f}; }
                else { const float* mp = F_MOD + ((size_t)l * 5 + bb) * (6 * D) + (kind == 0 ? 0 : 3) * D; const f32x4 sh = *(const f32x4*)(mp + col), sc = *(const f32x4*)(mp + D + col);
                    mul[j] = g * (sc + 1.0f); add[j] = sh; } } }
        f32x4 v[4];
        if (!have_vn) {
            if (first) { const float* xs = lat ? xin + (size_t)r * D : cin + (size_t)(r - ML) * D;
#pragma unroll
                for (int j = 0; j < 4; ++j) v[j] = *(const f32x4*)(xs + 4 * F.lane + 256 * j); }
            else {
#pragma unroll
                for (int j = 0; j < 4; ++j) { const v2u w = *(const v2u*)(XBb + (size_t)r * D + 4 * F.lane + 256 * j); v[j] = (f32x4){bflo(w.x), bfhi(w.x), bflo(w.y), bfhi(w.y)}; } } }
        else if (first) {
#pragma unroll
            for (int j = 0; j < 4; ++j) v[j] = vn[j]; }
        else {
#pragma unroll
            for (int j = 0; j < 4; ++j) v[j] = (f32x4){bflo(vb[j].x), bfhi(vb[j].x), bflo(vb[j].y), bfhi(vb[j].y)}; }
        { const int i2 = i + NWAVES, r2 = row_base + i2; have_vn = (i2 < ROWS_PER_WG) && !((kind == 2 || (ROUTE && l == DEPTH - 1)) && r2 >= ML);
          if (have_vn) {
              if (first) { const float* xs2 = r2 < ML ? xin + (size_t)r2 * D : cin + (size_t)(r2 - ML) * D;
#pragma unroll
                  for (int j = 0; j < 4; ++j) vn[j] = *(const f32x4*)(xs2 + 4 * F.lane + 256 * j); }
              else {
#pragma unroll
                  for (int j = 0; j < 4; ++j) vb[j] = *(const v2u*)(XBb + (size_t)r2 * D + 4 * F.lane + 256 * j); } } }
        float ss = 0.f;
#pragma unroll
        for (int j = 0; j < 4; ++j) ss += (v[j].x * v[j].x + v[j].y * v[j].y) + (v[j].z * v[j].z + v[j].w * v[j].w);
        const float rstd = 1.0f / sqrtf(wave_sum(ss) * (1.0f / D) + EPS);
        f32x4 hv[4];
#pragma unroll
        for (int j = 0; j < 4; ++j) hv[j] = v[j] * rstd * mul[j] + add[j];
        if (kind == 2) {
#pragma unroll
            for (int j = 0; j < 4; ++j) *(f32x4*)(outp + (size_t)r * D + 4 * F.lane + 256 * j) = hv[j];
        } else {
            bf16* hr = F_HN + (size_t)r * D;
#pragma unroll
            for (int j = 0; j < 4; ++j) { v2u o; o.x = pk2(hv[j].x, hv[j].y); o.y = pk2(hv[j].z, hv[j].w); *(v2u*)(hr + 4 * F.lane + 256 * j) = o; }
        }
        if (ROUTE) {
            float lg[8];
#pragma unroll
            for (int e = 0; e < 8; ++e) lg[e] = 0.f;
#pragma unroll
            for (int j = 0; j < 4; ++j)
#pragma unroll
                for (int q = 0; q < 4; ++q) { const float hx = hv[j][q]; const f32x4 w0 = rwr[j][q][0], w1 = rwr[j][q][1];
                    lg[0] += hx * w0.x; lg[1] += hx * w0.y; lg[2] += hx * w0.z; lg[3] += hx * w0.w; lg[4] += hx * w1.x; lg[5] += hx * w1.y; lg[6] += hx * w1.z; lg[7] += hx * w1.w; }
#pragma unroll
            for (int e = 0; e < 8; ++e) lg[e] = wave_sum(lg[e]) + rbr[e];
            int e1 = 0; float v1 = lg[0];
#pragma unroll
            for (int e = 1; e < 8; ++e) if (lg[e] > v1) { v1 = lg[e]; e1 = e; }
            int e2 = -1; float v2 = -3.0e38f;
#pragma unroll
            for (int e = 0; e < 8; ++e) if (e != e1 && lg[e] > v2) { v2 = lg[e]; e2 = e; }
            const float g1 = sigm(v1 - v2), g2 = 1.0f - g1;
            if (F.lane == 0) { RT[i * 4 + 0] = __builtin_bit_cast(float, e1); RT[i * 4 + 1] = __builtin_bit_cast(float, e2); RT[i * 4 + 2] = g1; RT[i * 4 + 3] = g2; }
        }
    }
    if (ROUTE) {
        __syncthreads();
        { const int e = F.wave; int c = 0;
          const unsigned long long below = (1ull << F.lane) - 1ull;
#pragma unroll
          for (int ch = 0; ch < (ROWS_PER_WG + 63) / 64; ++ch) { const int i = ch * 64 + F.lane; const bool in = i < ROWS_PER_WG;
              const int a = in ? __builtin_bit_cast(int, RT[i * 4 + 0]) : -2, b = in ? __builtin_bit_cast(int, RT[i * 4 + 1]) : -2;
              const bool ma = (a == e), mb = (b == e);
              const unsigned long long ba = __ballot(ma), bb = __ballot(mb);
              const int before = __popcll(ba & below) + __popcll(bb & below);
              if (ma) RK[i * 2 + 0] = c + before; if (mb) RK[i * 2 + 1] = c + before;
              c += __popcll(ba) + __popcll(bb); }
          if (F.lane == 0) BASE[e] = (int)__hip_atomic_fetch_add(F.ctl + CW_CNT + moe * 512 + e * 64, (unsigned)c, RLX_AGENT); }
        __syncthreads();
        if (F.tid < ROWS_PER_WG) { const int i = F.tid, r = row_base + i;
            const int e1 = __builtin_bit_cast(int, RT[i * 4 + 0]), e2 = __builtin_bit_cast(int, RT[i * 4 + 1]);
            if (e1 >= 0) {
            const int r1 = BASE[e1] + RK[i * 2 + 0], r2 = BASE[e2] + RK[i * 2 + 1];
            unsigned* inf = F_INFO + ((size_t)moe * M + r) * 8;
            v4u o0; o0.x = (unsigned)e1; o0.y = (unsigned)r1; o0.z = (unsigned)e2; o0.w = (unsigned)r2; *(v4u*)inf = o0;
            v4u o1; o1.x = __builtin_bit_cast(unsigned, RT[i * 4 + 2]); o1.y = __builtin_bit_cast(unsigned, RT[i * 4 + 3]); o1.z = 0u; o1.w = 0u; *(v4u*)(inf + 4) = o1;
            F_LIST[(size_t)e1 * M + r1] = r; F_LIST[(size_t)e2 * M + r2] = r; } }
    }
    __syncthreads();
}

struct NG { const bf16* A; int lda; const int* ridx; int nvalid; int arow0; const bf16* Bt; int K; int nrows, ncols, pcol0; int pair, mode;
            bf16* O; int ldo, orow0, ocol0; const float* xl_src; const float* xc_src; const float* gate; };
__device__ __forceinline__ void gemm_naive(Frame& F, const NG& g) {
    const int ntm = g.nrows / 32, ntn = g.ncols / 32, nt = ntm * ntn;
    const int lr = F.lane & 15, lq = F.lane >> 4;
    for (int t = F.bid * NWAVES + F.wave; t < nt; t += F.G * NWAVES) {
        const int tm = t / ntn, tn = t % ntn;
        const bf16* ap[2]; const bf16* bp[2]; const bf16* bp2[2];
#pragma unroll
        for (int mi = 0; mi < 2; ++mi) { const int i = 32 * tm + 16 * mi + lr; const size_t ar = g.ridx ? (size_t)g.ridx[i < g.nvalid ? i : 0] : (size_t)(g.arow0 + i); ap[mi] = g.A + ar * g.lda + 8 * lq; }
#pragma unroll
        for (int ni = 0; ni < 2; ++ni) { const int j = 32 * tn + 16 * ni + lr; const int pc = g.pair ? g.pcol0 + 256 * (j >> 7) + (j & 127) : g.pcol0 + j;
            bp[ni] = g.Bt + (size_t)pc * g.K + 8 * lq; bp2[ni] = bp[ni] + (size_t)128 * g.K; }
        f32x4 acc[2][2], acc2[2][2];
#pragma unroll
        for (int mi = 0; mi < 2; ++mi)
#pragma unroll
            for (int ni = 0; ni < 2; ++ni) { acc[mi][ni] = (f32x4){0.f, 0.f, 0.f, 0.f}; acc2[mi][ni] = (f32x4){0.f, 0.f, 0.f, 0.f}; }
        for (int k0 = 0; k0 < g.K; k0 += 32) {
            bf16x8 a[2], b[2], b2[2];
#pragma unroll
            for (int mi = 0; mi < 2; ++mi) a[mi] = *(const bf16x8*)(ap[mi] + k0);
#pragma unroll
            for (int ni = 0; ni < 2; ++ni) { b[ni] = *(const bf16x8*)(bp[ni] + k0); if (g.pair) b2[ni] = *(const bf16x8*)(bp2[ni] + k0); else b2[ni] = b[ni]; }
#pragma unroll
            for (int mi = 0; mi < 2; ++mi)
#pragma unroll
                for (int ni = 0; ni < 2; ++ni) { acc[mi][ni] = __builtin_amdgcn_mfma_f32_16x16x32_bf16(a[mi], b[ni], acc[mi][ni], 0, 0, 0);
                    if (g.pair) acc2[mi][ni] = __builtin_amdgcn_mfma_f32_16x16x32_bf16(a[mi], b2[ni], acc2[mi][ni], 0, 0, 0); }
        }
#pragma unroll
        for (int mi = 0; mi < 2; ++mi)
#pragma unroll
            for (int ni = 0; ni < 2; ++ni)
#pragma unroll
                for (int q = 0; q < 4; ++q) {
                    const int i = 32 * tm + 16 * mi + 4 * lq + q, j = 32 * tn + 16 * ni + lr; const float v = acc[mi][ni][q], u = acc2[mi][ni][q];
                    const int row = g.orow0 + i;
                    if (g.mode == 4) { const bool lat = row < ML; const int bb = lat ? (row >> 13) : 4;
                        const float* xs = lat ? g.xl_src + (size_t)row * D : g.xc_src + (size_t)(row - ML) * D; float* xd = lat ? ((float*)F.out_g) + (size_t)row * D : F_XC + (size_t)(row - ML) * D;
                        xd[j] = xs[j] + g.gate[(size_t)bb * (6 * D) + j] * v; }
                    else { float o = v; if (g.mode == 1) o = gelu_tanh_f(v); else if (g.mode == 2) o = v * u; else if (g.mode == 3) o = silu_f(v) * u;
                        g.O[(size_t)row * g.ldo + g.ocol0 + j] = (bf16)f2bf(o); }
                }
    }
}

namespace pg8 {
constexpr int BM = 256, BK = 64, HALF = 128, HTB = HALF * BK * 2, NXCD = 8, WGM = 4;
__device__ __forceinline__ int lds_byte(int r, int c) { const int st = (r >> 4) * 2 + (c >> 5), rr = r & 15, cc = c & 31, ob = rr * 64 + cc * 2; return st * 1024 + (ob ^ (((ob >> 9) & 1) << 5)); }
__device__ __forceinline__ void stage_rc(int b, int& R, int& C) { const int st = b / 1024, sb = b % 1024, swz = sb ^ (((sb >> 9) & 1) << 5); R = (st >> 1) * 16 + swz / 64; C = (st & 1) * 32 + (swz % 64) / 2; }
__device__ __forceinline__ int perm32(int rho) { const int n = rho >> 4, i = rho & 15; return 8 * (i >> 2) + 4 * n + (i & 3); }
struct Unit { int pm, pn, orow0, e, kq, spl, ovj, et0, ecnt; };
struct TileOrder {
    int nM, nN, nwg, G, c, wgm;
    __device__ void init(int nM_, int nN_, int G_, int c_, int wgm_ = WGM) { nM = nM_; nN = nN_; nwg = nM * nN; G = G_; c = c_; wgm = wgm_; }
    __device__ __forceinline__ void map(int L, int& pm, int& pn) const {
        int wgid = L; { const int q = nwg / NXCD, r = nwg % NXCD, xcd = wgid % NXCD, off = wgid / NXCD; wgid = (xcd < r ? xcd * (q + 1) : r * (q + 1) + (xcd - r) * q) + off; }
        const int nig = wgm * nN, gid = wgid / nig, fm = gid * wgm, gsz = (nM - fm) < wgm ? (nM - fm) : wgm;
        pm = fm + ((wgid % nig) % gsz); pn = (wgid % nig) / gsz;
    }
    __device__ __forceinline__ bool next(int i, int& pm, int& pn) const { const long L = (long)i * G + c; if (L >= nwg) return false; map((int)L, pm, pn); return true; }
};
__device__ __forceinline__ unsigned cvt_pk_bf16(float lo, float hi) { unsigned r; asm volatile("v_cvt_pk_bf16_f32 %0, %1, %2" : "=v"(r) : "v"(lo), "v"(hi)); return r; }

struct ProbDense {
    static constexpr bool GATHER = false; static constexpr bool SPLITK = false;
    const bf16* A; const bf16* Bt; int K; TileOrder ord;
    __device__ __forceinline__ bool next(int i, Unit& u) const { if (!ord.next(i, u.pm, u.pn)) return false; u.orow0 = u.pm * BM; u.e = 0; return true; }
    __device__ __forceinline__ const char* a_base(const Unit& u) const { return (const char*)A + (size_t)u.pm * BM * K * 2; }
    __device__ __forceinline__ const char* b_base(const Unit& u) const { return (const char*)Bt + (size_t)u.pn * BM * K * 2; }
    __device__ __forceinline__ unsigned row_index(const Unit&, int) const { return 0u; }
};
struct ProbMoe {
    const bf16* A; const bf16* Bt; const int* list; const LAS int* tab_; int K; int bt_rows; bool up; TileOrder ord;
    __device__ __forceinline__ bool next(int i, Unit& u) const {
        if (!ord.next(i, u.pm, u.pn)) return false;
        lookup(u); return true; }
    __device__ __forceinline__ void lookup(Unit& u) const {
        unsigned ta_ = (unsigned)(unsigned long)tab_; asm volatile("" : "+v"(ta_)); const LAS int* tab = (const LAS int*)(unsigned long)ta_;
        typedef int v4i_ __attribute__((ext_vector_type(4)));
        const v4i_ t0 = *(const LAS v4i_*)tab, t1 = *(const LAS v4i_*)(tab + 4), c0 = *(const LAS v4i_*)(tab + 16), c1 = *(const LAS v4i_*)(tab + 20), o0 = *(const LAS v4i_*)(tab + 32), o1 = *(const LAS v4i_*)(tab + 36);
        int e = 0, te = __builtin_amdgcn_readfirstlane(t0.x), ce = __builtin_amdgcn_readfirstlane(c0.x), oe = __builtin_amdgcn_readfirstlane(o0.x);
#define PM_SEL(tq, cq, oq) do { const int t_ = __builtin_amdgcn_readfirstlane(tq), c_ = __builtin_amdgcn_readfirstlane(cq), o_ = __builtin_amdgcn_readfirstlane(oq); const bool ge_ = u.pm >= t_; e += ge_ ? 1 : 0; te = ge_ ? t_ : te; ce = ge_ ? c_ : ce; oe = ge_ ? o_ : oe; } while (0)
        PM_SEL(t0.y, c0.y, o0.y); PM_SEL(t0.z, c0.z, o0.z); PM_SEL(t0.w, c0.w, o0.w); PM_SEL(t1.x, c1.x, o1.x); PM_SEL(t1.y, c1.y, o1.y); PM_SEL(t1.z, c1.z, o1.z); PM_SEL(t1.w, c1.w, o1.w);
#undef PM_SEL
        u.e = e; u.et0 = te; u.ecnt = ce; u.orow0 = oe + (u.pm - te) * BM; }
    __device__ __forceinline__ const char* a_base(const Unit& u) const { return up ? (const char*)A : (const char*)A + (size_t)u.orow0 * K * 2; }
    __device__ __forceinline__ const char* b_base(const Unit& u) const { return (const char*)Bt + ((size_t)u.e * bt_rows + (size_t)u.pn * BM) * K * 2; }
    __device__ __forceinline__ const unsigned* row_ptr(const Unit& u, int lr) const {
        const int loc = (u.pm - u.et0) * BM + lr; const int c = u.ecnt; return (const unsigned*)(list + (size_t)u.e * M + (loc < c ? loc : 0)); }
    __device__ __forceinline__ unsigned row_index(const Unit& u, int lr) const {
        const int loc = (u.pm - u.et0) * BM + lr; const int c = u.ecnt; return (unsigned)list[(size_t)u.e * M + (loc < c ? loc : 0)]; }
};
template <bool G> struct ProbMoeT : ProbMoe { static constexpr bool GATHER = G; static constexpr bool SPLITK = false; };
struct ProbMoeSplit : ProbMoe {
    static constexpr bool GATHER = false; static constexpr bool SPLITK = true;
    int nfull, nmain, novf, spl;
    __device__ __forceinline__ void init_split() { nfull = ord.nwg / ord.G; nmain = nfull * ord.G; novf = ord.nwg - nmain; spl = (novf == 0) ? 1 : (novf * 4 <= ord.G) ? 4 : (novf * 2 <= ord.G) ? 2 : 1; }
    __device__ __forceinline__ bool next(int i, Unit& u) const {
        int L, kq = 0, sp = 1, j = 0;
        if (i < nfull) L = i * ord.G + ord.c;
        else if (i == nfull) { if (ord.c >= novf * spl) return false; j = ord.c % novf; kq = ord.c / novf; sp = spl; L = nmain + j; }
        else return false;
        ord.map(L, u.pm, u.pn); u.kq = kq; u.spl = sp; u.ovj = j;
        lookup(u); return true; }
    __device__ __forceinline__ int ntiles(const Unit& u) const { return K / BK / u.spl; }
    __device__ __forceinline__ const char* a_base(const Unit& u) const { return (const char*)A + ((size_t)u.orow0 * K + (size_t)u.kq * (K / u.spl)) * 2; }
    __device__ __forceinline__ const char* b_base(const Unit& u) const { return (const char*)Bt + (((size_t)u.e * bt_rows + (size_t)u.pn * BM) * K + (size_t)u.kq * (K / u.spl)) * 2; }
};

struct EpiP {
    static constexpr bool PERM = true;
    bf16* P;
    __device__ __forceinline__ void operator()(const f32x4 (&acc)[2][2][4][2], const Unit& u, int wr, int wc, int fr, int fq) const {
        int ld = PW; asm volatile("" : "+s"(ld));
        const int pn = u.pn; const unsigned loff = (unsigned)(fr * ld + 8 * fq) * 2u;
        char* base = (char*)(P + (size_t)(u.orow0 + wr * 64) * ld + wc * 32);
#pragma unroll
        for (int ai = 0; ai < 2; ++ai)
#pragma unroll
            for (int m = 0; m < 4; ++m) { char* rowb = base + (size_t)((ai * HALF + m * 16) * ld) * 2;
                if (pn >= 2 && pn < 6) { const f32x4 a0 = acc[ai][0][m][0] * acc[ai][1][m][0], a1 = acc[ai][0][m][1] * acc[ai][1][m][1];
                    v4u w; w.x = cvt_pk_bf16(a0[0], a0[1]); w.y = cvt_pk_bf16(a0[2], a0[3]); w.z = cvt_pk_bf16(a1[0], a1[1]); w.w = cvt_pk_bf16(a1[2], a1[3]);
                    *(v4u*)(rowb + (size_t)(512 + 128 * (pn - 2)) * 2 + loff) = w; }
                else { const int cbase = (pn < 2) ? 256 * pn : 256 * pn - 512;
#pragma unroll
                    for (int bj = 0; bj < 2; ++bj) { f32x4 v0 = acc[ai][bj][m][0], v1 = acc[ai][bj][m][1];
                        if (pn >= 8) {
#pragma unroll
                            for (int q = 0; q < 4; ++q) { v0[q] = gelu_tanh_f(v0[q]); v1[q] = gelu_tanh_f(v1[q]); } }
                        v4u w; w.x = cvt_pk_bf16(v0[0], v0[1]); w.y = cvt_pk_bf16(v0[2], v0[3]); w.z = cvt_pk_bf16(v1[0], v1[1]); w.w = cvt_pk_bf16(v1[2], v1[3]);
                        *(v4u*)(rowb + (size_t)(cbase + bj * HALF) * 2 + loff) = w; } }
            }
    }
};
struct EpiGLU {
    static constexpr bool PERM = true;
    bf16* O; int ldo;
    __device__ __forceinline__ void operator()(const f32x4 (&acc)[2][2][4][2], const Unit& u, int wr, int wc, int fr, int fq) const {
        int ld = ldo; asm volatile("" : "+s"(ld));
        const unsigned loff = (unsigned)(fr * ld + 8 * fq) * 2u;
        char* base = (char*)(O + (size_t)(u.orow0 + wr * 64) * ld + 128 * u.pn + wc * 32);
#pragma unroll
        for (int ai = 0; ai < 2; ++ai)
#pragma unroll
            for (int m = 0; m < 4; ++m) { char* rowb = base + (size_t)((ai * HALF + m * 16) * ld) * 2;
                const f32x4 g0 = acc[ai][0][m][0], g1 = acc[ai][0][m][1], u0 = acc[ai][1][m][0], u1 = acc[ai][1][m][1];
                const f32x4 t0 = g0 * -1.44269504089f, t1 = g1 * -1.44269504089f; f32x4 e0, e1;
#pragma unroll
                for (int q = 0; q < 4; ++q) { e0[q] = __builtin_amdgcn_exp2f(t0[q]); e1[q] = __builtin_amdgcn_exp2f(t1[q]); }
                const f32x4 d0 = e0 + 1.0f, d1 = e1 + 1.0f, p0 = g0 * u0, p1 = g1 * u1; f32x4 r0, r1;
#pragma unroll
                for (int q = 0; q < 4; ++q) { r0[q] = __builtin_amdgcn_rcpf(d0[q]); r1[q] = __builtin_amdgcn_rcpf(d1[q]); }
                const f32x4 a0 = p0 * r0, a1 = p1 * r1;
                v4u w; w.x = cvt_pk_bf16(a0[0], a0[1]); w.y = cvt_pk_bf16(a0[2], a0[3]); w.z = cvt_pk_bf16(a1[0], a1[1]); w.w = cvt_pk_bf16(a1[2], a1[3]);
                *(v4u*)(rowb + loff) = w; }
    }
};
struct EpiBf {
    static constexpr bool PERM = true;
    bf16* O; int ldo;
    __device__ __forceinline__ void operator()(const f32x4 (&acc)[2][2][4][2], const Unit& u, int wr, int wc, int fr, int fq) const {
        int ld = ldo; asm volatile("" : "+s"(ld));
        const unsigned loff = (unsigned)(fr * ld + 8 * fq) * 2u;
        char* base = (char*)(O + (size_t)(u.orow0 + wr * 64) * ld + 256 * u.pn + wc * 32);
#pragma unroll
        for (int ai = 0; ai < 2; ++ai)
#pragma unroll
            for (int m = 0; m < 4; ++m) { char* rowb = base + (size_t)((ai * HALF + m * 16) * ld) * 2;
#pragma unroll
                for (int bj = 0; bj < 2; ++bj) { const f32x4 v0 = acc[ai][bj][m][0], v1 = acc[ai][bj][m][1];
                    v4u w; w.x = cvt_pk_bf16(v0[0], v0[1]); w.y = cvt_pk_bf16(v0[2], v0[3]); w.z = cvt_pk_bf16(v1[0], v1[1]); w.w = cvt_pk_bf16(v1[2], v1[3]);
                    *(v4u*)(rowb + (size_t)(bj * HALF) * 2 + loff) = w; } }
    }
};
struct EpiBfSplit {
    static constexpr bool PERM = true;
    bf16* O; int ldo; float* part; unsigned* cnt;
    __device__ __forceinline__ void operator()(const f32x4 (&acc)[2][2][4][2], const Unit& u, int wr, int wc, int fr, int fq) const {
        int ld = ldo; asm volatile("" : "+s"(ld));
        const unsigned loff = (unsigned)(fr * ld + 8 * fq) * 2u;
        char* base = (char*)(O + (size_t)(u.orow0 + wr * 64) * ld + 256 * u.pn + wc * 32);
        if (u.spl == 1) {
#pragma unroll
            for (int ai = 0; ai < 2; ++ai)
#pragma unroll
                for (int m = 0; m < 4; ++m) { char* rowb = base + (size_t)((ai * HALF + m * 16) * ld) * 2;
#pragma unroll
                    for (int bj = 0; bj < 2; ++bj) { const f32x4 v0 = acc[ai][bj][m][0], v1 = acc[ai][bj][m][1];
                        v4u w; w.x = cvt_pk_bf16(v0[0], v0[1]); w.y = cvt_pk_bf16(v0[2], v0[3]); w.z = cvt_pk_bf16(v1[0], v1[1]); w.w = cvt_pk_bf16(v1[2], v1[3]);
                        *(v4u*)(rowb + (size_t)(bj * HALF) * 2 + loff) = w; } }
            return;
        }
        const int tid = (wr * 4 + wc) * 64 + fq * 16 + fr;
        f32x4* mine = (f32x4*)part + (size_t)(u.ovj * u.spl + u.kq) * 16384 + tid;
#pragma unroll
        for (int ai = 0; ai < 2; ++ai)
#pragma unroll
            for (int bj = 0; bj < 2; ++bj)
#pragma unroll
                for (int m = 0; m < 4; ++m)
#pragma unroll
                    for (int n = 0; n < 2; ++n) mine[(((ai * 2 + bj) * 4 + m) * 2 + n) * 512] = acc[ai][bj][m][n];
        asm volatile("s_waitcnt vmcnt(0)" ::: "memory");
        __syncthreads();
        if (tid == 0) { __builtin_amdgcn_fence(__ATOMIC_RELEASE, "agent"); (void)__hip_atomic_fetch_add(cnt + u.ovj, 1u, RLX_AGENT);
            unsigned sp = 0; while (__hip_atomic_load(cnt + u.ovj, RLX_AGENT) < (unsigned)u.spl) { __builtin_amdgcn_s_sleep(2); if (++sp > (1u << 22)) break; } }
        __syncthreads();
        __builtin_amdgcn_fence(__ATOMIC_ACQUIRE, "agent");
#pragma unroll
        for (int qd = 0; qd < 4; ++qd) { const int ai = qd >> 1, bj = qd & 1;
            if ((qd % u.spl) != u.kq) continue;
            f32x4 sm[4][2];
#pragma unroll
            for (int m = 0; m < 4; ++m)
#pragma unroll
                for (int n = 0; n < 2; ++n) sm[m][n] = acc[ai][bj][m][n];
            for (int q = 1; q < u.spl; ++q) { int oq = u.kq + q; if (oq >= u.spl) oq -= u.spl;
                const f32x4* pp = (const f32x4*)part + (size_t)(u.ovj * u.spl + oq) * 16384 + tid + qd * 4096; f32x4 tv[4][2];
#pragma unroll
                for (int m = 0; m < 4; ++m)
#pragma unroll
                    for (int n = 0; n < 2; ++n) tv[m][n] = pp[(m * 2 + n) * 512];
#pragma unroll
                for (int m = 0; m < 4; ++m)
#pragma unroll
                    for (int n = 0; n < 2; ++n) sm[m][n] += tv[m][n]; }
#pragma unroll
            for (int m = 0; m < 4; ++m) { char* rowb = base + (size_t)((ai * HALF + m * 16) * ld) * 2; const f32x4 v0 = sm[m][0], v1 = sm[m][1];
                v4u w; w.x = cvt_pk_bf16(v0[0], v0[1]); w.y = cvt_pk_bf16(v0[2], v0[3]); w.z = cvt_pk_bf16(v1[0], v1[1]); w.w = cvt_pk_bf16(v1[2], v1[3]);
                *(v4u*)(rowb + (size_t)(bj * HALF) * 2 + loff) = w; } }
    }
};
template <bool SRCF32> struct EpiRes {
    static constexpr bool PERM = true;
    const float* xf; bf16* XB; const float* gate;
    __device__ __forceinline__ void operator()(const f32x4 (&acc)[2][2][4][2], const Unit& u, int wr, int wc, int fr, int fq) const {
        int ld = D; asm volatile("" : "+s"(ld));
        const int bb = u.orow0 >> 13; const size_t e0u = (size_t)(u.orow0 + wr * 64) * ld + u.pn * BM + wc * 32; const unsigned lofe = (unsigned)(fr * ld + 8 * fq);
        const float* gp = gate + (size_t)bb * (6 * D) + u.pn * BM + wc * 32 + 8 * fq;
        f32x4 gv[2][2];
#pragma unroll
        for (int bj = 0; bj < 2; ++bj)
#pragma unroll
            for (int n = 0; n < 2; ++n) gv[bj][n] = *(const f32x4*)(gp + bj * HALF + 4 * n);
        if constexpr (!SRCF32) {
            v4u xw[2][4][2];
#pragma unroll
            for (int ai = 0; ai < 2; ++ai)
#pragma unroll
                for (int m = 0; m < 4; ++m) { const size_t rou = e0u + (size_t)((ai * HALF + m * 16) * ld);
#pragma unroll
                    for (int bj = 0; bj < 2; ++bj) xw[ai][m][bj] = *(const v4u*)((const char*)(XB + rou + bj * HALF) + (size_t)(lofe * 2u)); }
#pragma unroll
            for (int ai = 0; ai < 2; ++ai)
#pragma unroll
                for (int m = 0; m < 4; ++m) { const size_t rou = e0u + (size_t)((ai * HALF + m * 16) * ld);
#pragma unroll
                    for (int bj = 0; bj < 2; ++bj) { bf16* xbp = (bf16*)((char*)(XB + rou + bj * HALF) + (size_t)(lofe * 2u)); const v4u w = xw[ai][m][bj];
                        const f32x4 x0 = (f32x4){bflo(w.x), bfhi(w.x), bflo(w.y), bfhi(w.y)}, x1 = (f32x4){bflo(w.z), bfhi(w.z), bflo(w.w), bfhi(w.w)};
                        const f32x4 v0 = x0 + gv[bj][0] * acc[ai][bj][m][0], v1 = x1 + gv[bj][1] * acc[ai][bj][m][1];
                        v4u o; o.x = cvt_pk_bf16(v0[0], v0[1]); o.y = cvt_pk_bf16(v0[2], v0[3]); o.z = cvt_pk_bf16(v1[0], v1[1]); o.w = cvt_pk_bf16(v1[2], v1[3]);
                        *(v4u*)xbp = o; } }
            return;
        }
#pragma unroll
        for (int ai = 0; ai < 2; ++ai) {
            f32x4 xs[4][2][2];
#pragma unroll
            for (int m = 0; m < 4; ++m) { const size_t rou = e0u + (size_t)((ai * HALF + m * 16) * ld);
#pragma unroll
                for (int bj = 0; bj < 2; ++bj) {
                    if (SRCF32) { const float* xfp = (const float*)((const char*)(xf + rou + bj * HALF) + (size_t)(lofe * 4u)); xs[m][bj][0] = *(const f32x4*)xfp; xs[m][bj][1] = *(const f32x4*)(xfp + 4); }
                    else { const bf16* xbp = (const bf16*)((const char*)(XB + rou + bj * HALF) + (size_t)(lofe * 2u)); const v4u w = *(const v4u*)xbp; xs[m][bj][0] = __builtin_bit_cast(f32x4, w); } } }
#pragma unroll
            for (int m = 0; m < 4; ++m) { const size_t rou = e0u + (size_t)((ai * HALF + m * 16) * ld);
#pragma unroll
                for (int bj = 0; bj < 2; ++bj) { f32x4 x0, x1; bf16* xbp = (bf16*)((char*)(XB + rou + bj * HALF) + (size_t)(lofe * 2u));
                    if (SRCF32) { x0 = xs[m][bj][0]; x1 = xs[m][bj][1]; }
                    else { const v4u w = __builtin_bit_cast(v4u, xs[m][bj][0]); x0 = (f32x4){bflo(w.x), bfhi(w.x), bflo(w.y), bfhi(w.y)}; x1 = (f32x4){bflo(w.z), bfhi(w.z), bflo(w.w), bfhi(w.w)}; }
                    const f32x4 v0 = x0 + gv[bj][0] * acc[ai][bj][m][0], v1 = x1 + gv[bj][1] * acc[ai][bj][m][1];
                    v4u o; o.x = cvt_pk_bf16(v0[0], v0[1]); o.y = cvt_pk_bf16(v0[2], v0[3]); o.z = cvt_pk_bf16(v1[0], v1[1]); o.w = cvt_pk_bf16(v1[2], v1[3]);
                    *(v4u*)xbp = o; } }
        }
    }
};

template <class Prob, class Epi>
__device__ __forceinline__ void gemm_phase(LAS unsigned char* lds, const Prob& S, const Epi& E, int tid_in) {
    int tid_ = tid_in; asm volatile("" : "+v"(tid_));
    const int tid = tid_, wid = __builtin_amdgcn_readfirstlane(tid >> 6), lane = tid & 63, wr = wid >> 2, wc = wid & 3, fr = lane & 15, fq = lane >> 4;
    const int K = S.K; int nt = K / BK;
    unsigned voffB[2], vA0[2], vA1[2];
#pragma unroll
    for (int i = 0; i < 2; ++i) { int R, C; stage_rc(tid * 16 + i * 8192, R, C); const int Rb = Epi::PERM ? ((R & ~31) + perm32(R & 31)) : R; voffB[i] = (unsigned)(Rb * K + C) * 2u; vA0[i] = (unsigned)(R * K + C) * 2u; vA1[i] = vA0[i]; }
    const size_t kstep = (size_t)(BK * 2);
    const size_t hstep = (size_t)HALF * K * 2;
    const unsigned ldsw = (unsigned)wid * 1024u;
    const int aoff = lds_byte(wr * 64 + fr, fq * 8), boff = lds_byte(wc * 32 + fr, fq * 8);
#define PG8_SA(b, h) (((b) * 2 + (h)) * HTB)
#define PG8_SB(b, h) ((4 + (b) * 2 + (h)) * HTB)
#define PG8_STAGE(bufoff, gbase, voff) do { _Pragma("unroll") for (int _i = 0; _i < 2; ++_i) \
        __builtin_amdgcn_global_load_lds((const unsigned*)((const char*)(gbase) + (voff)[_i]), (LAS unsigned*)(lds + (bufoff) + ldsw + _i * 8192), 16, 0, 0); } while (0)
#define PG8_STAGE_A(bufoff, gbase, h) do { if constexpr (Prob::GATHER) { if (h) PG8_STAGE(bufoff, gbase, vA1); else PG8_STAGE(bufoff, gbase, vA0); } else PG8_STAGE(bufoff, (gbase) + (h) * hstep, vA0); } while (0)
#define PG8_LDA(dst, b, h) do { _Pragma("unroll") for (int m = 0; m < 4; ++m) _Pragma("unroll") for (int k = 0; k < 2; ++k) dst[m][k] = *(const LAS bf16x8*)(lds + PG8_SA(b, h) + aoff + m * 2048 + k * 1024); } while (0)
#define PG8_LDB(dst, b, h) do { _Pragma("unroll") for (int n = 0; n < 2; ++n) _Pragma("unroll") for (int k = 0; k < 2; ++k) dst[n][k] = *(const LAS bf16x8*)(lds + PG8_SB(b, h) + boff + n * 2048 + k * 1024); } while (0)
#define PG8_MMA(ai, bj, At, Bt) do { __builtin_amdgcn_s_setprio(1); _Pragma("unroll") for (int m = 0; m < 4; ++m) _Pragma("unroll") for (int n = 0; n < 2; ++n) _Pragma("unroll") for (int k = 0; k < 2; ++k) \
        acc[ai][bj][m][n] = __builtin_amdgcn_mfma_f32_16x16x32_bf16(Bt[n][k], At[m][k], acc[ai][bj][m][n], 0, 0, 0); __builtin_amdgcn_s_setprio(0); } while (0)
#define PG8_WAIT_V(n) asm volatile("s_waitcnt vmcnt(" #n ")" ::: "memory")
#define PG8_WAIT_L(n) asm volatile("s_waitcnt lgkmcnt(" #n ")" ::: "memory")
#define PG8_BAR __builtin_amdgcn_s_barrier()
#define PG8_SCHED __builtin_amdgcn_sched_barrier(0)
#define PG8_GATHER_VOFF(u) do { _Pragma("unroll") for (int _i = 0; _i < 2; ++_i) { int R_, C_; stage_rc(tid * 16 + _i * 8192, R_, C_); \
        vA0[_i] = (S.row_index(u, R_) * (unsigned)K + (unsigned)C_) * 2u; asm volatile("" : "+v"(vA0[_i]) :: "memory"); } \
        _Pragma("unroll") for (int _i = 0; _i < 2; ++_i) { int R_, C_; stage_rc(tid * 16 + _i * 8192, R_, C_); \
        vA1[_i] = (S.row_index(u, HALF + R_) * (unsigned)K + (unsigned)C_) * 2u; asm volatile("" : "+v"(vA1[_i]) :: "memory"); } } while (0)
#define PG8_GATHER_DMA(u) do { _Pragma("unroll") for (int _h = 0; _h < 2; ++_h) _Pragma("unroll") for (int _i = 0; _i < 2; ++_i) { int R_, C_; stage_rc(tid * 16 + _i * 8192, R_, C_); \
        __builtin_amdgcn_global_load_lds(S.row_ptr(u, _h * HALF + R_), (LAS unsigned*)(lds + GIDX_OFF + (_h * 2 + _i) * 2048 + wid * 256), 4, 0, 0); } } while (0)
#define PG8_GATHER_FROM_LDS() do { _Pragma("unroll") for (int _i = 0; _i < 2; ++_i) { int R_, C_; stage_rc(tid * 16 + _i * 8192, R_, C_); \
        vA0[_i] = (*(const LAS unsigned*)(lds + GIDX_OFF + _i * 2048 + tid * 4) * (unsigned)K + (unsigned)C_) * 2u; vA1[_i] = (*(const LAS unsigned*)(lds + GIDX_OFF + (2 + _i) * 2048 + tid * 4) * (unsigned)K + (unsigned)C_) * 2u; } } while (0)
    Unit cur, nxt; int ui = 0;
    if (!S.next(0, cur)) return;
    f32x4 acc[2][2][4][2];
#pragma unroll
    for (int a = 0; a < 2; ++a)
#pragma unroll
        for (int b = 0; b < 2; ++b)
#pragma unroll
            for (int m = 0; m < 4; ++m)
#pragma unroll
                for (int n = 0; n < 2; ++n) acc[a][b][m][n] = (f32x4){0.f, 0.f, 0.f, 0.f};
    bf16x8 At[4][2], B0[2][2], B1[2][2];
    const char* cA = S.a_base(cur); const char* cB = S.b_base(cur);
    if constexpr (Prob::SPLITK) nt = S.ntiles(cur);
    if constexpr (Prob::GATHER) PG8_GATHER_VOFF(cur);
#if PG8_SP2
    PG8_STAGE(PG8_SB(0, 0), cB, voffB); PG8_STAGE(PG8_SB(0, 1), cB + hstep, voffB); PG8_STAGE_A(PG8_SA(0, 0), cA, 0); PG8_STAGE_A(PG8_SA(0, 1), cA, 1);
    if (wr == 1) PG8_BAR;
    PG8_WAIT_V(2); PG8_BAR;
#else
    PG8_STAGE(PG8_SB(0, 0), cB, voffB); PG8_STAGE_A(PG8_SA(0, 0), cA, 0); PG8_STAGE(PG8_SB(0, 1), cB + hstep, voffB); PG8_STAGE_A(PG8_SA(0, 1), cA, 1);
    if (wr == 1) PG8_BAR;
    PG8_WAIT_V(4); PG8_BAR;
#endif
    PG8_STAGE(PG8_SB(1, 0), cB + kstep, voffB); PG8_STAGE_A(PG8_SA(1, 0), cA + kstep, 0); PG8_STAGE(PG8_SB(1, 1), cB + hstep + kstep, voffB);
    PG8_WAIT_V(6); PG8_BAR;
    for (;;) {
        const bool has_next = S.next(ui + 1, nxt);
        if constexpr (Prob::GATHER) { if (has_next) PG8_GATHER_DMA(nxt); }
        const char* nA = has_next ? S.a_base(nxt) : cA; const char* nB = has_next ? S.b_base(nxt) : cB;
        for (int t = 0; t < nt; t += 2) {
            const bool last = (t == nt - 2);
            const char* a1 = cA + (size_t)(t + 1) * kstep;
            const char* a2 = last ? nA : cA + (size_t)(t + 2) * kstep; const char* b2 = last ? nB : cB + (size_t)(t + 2) * kstep;
            const char* a3 = a2 + kstep; const char* b3 = b2 + kstep;
#if !PG8_SP2
            PG8_LDB(B0, 0, 0); PG8_SCHED; PG8_LDA(At, 0, 0); PG8_STAGE_A(PG8_SA(1, 1), a1, 1);
            PG8_WAIT_L(8); PG8_BAR; PG8_WAIT_L(0); PG8_MMA(0, 0, At, B0); PG8_BAR; PG8_SCHED;
            if constexpr (Prob::GATHER) { if (last && has_next) PG8_GATHER_FROM_LDS(); }
            PG8_LDB(B1, 0, 1); PG8_STAGE(PG8_SB(0, 0), b2, voffB);
            PG8_BAR; PG8_WAIT_L(0); PG8_MMA(0, 1, At, B1); PG8_BAR;
            PG8_LDA(At, 0, 1); PG8_STAGE_A(PG8_SA(0, 0), a2, 0);
            PG8_BAR; PG8_WAIT_L(0); PG8_MMA(1, 0, At, B0); PG8_BAR; PG8_SCHED;
            PG8_STAGE(PG8_SB(0, 1), b2 + hstep, voffB);
            PG8_WAIT_V(6); PG8_BAR; PG8_MMA(1, 1, At, B1); PG8_BAR;
            PG8_LDB(B0, 1, 0); PG8_SCHED; PG8_LDA(At, 1, 0); PG8_STAGE_A(PG8_SA(0, 1), a2, 1);
            PG8_WAIT_L(8); PG8_BAR; PG8_WAIT_L(0); PG8_MMA(0, 0, At, B0); PG8_BAR; PG8_SCHED;
            PG8_LDB(B1, 1, 1); PG8_STAGE(PG8_SB(1, 0), b3, voffB);
            PG8_BAR; PG8_WAIT_L(0); PG8_MMA(0, 1, At, B1); PG8_BAR;
            PG8_LDA(At, 1, 1); PG8_STAGE_A(PG8_SA(1, 0), a3, 0);
            PG8_BAR; PG8_WAIT_L(0); PG8_MMA(1, 0, At, B0); PG8_BAR; PG8_SCHED;
            PG8_STAGE(PG8_SB(1, 1), b3 + hstep, voffB);
            PG8_WAIT_V(6); PG8_BAR; PG8_MMA(1, 1, At, B1); PG8_BAR;
#else
            PG8_LDB(B0, 0, 0); PG8_LDB(B1, 0, 1); PG8_SCHED; PG8_LDA(At, 0, 0); PG8_STAGE_A(PG8_SA(1, 1), a1, 1);
            PG8_WAIT_V(8); PG8_WAIT_L(0); PG8_BAR; PG8_MMA(0, 0, At, B0); PG8_MMA(0, 1, At, B1); PG8_BAR; PG8_SCHED;
            if constexpr (Prob::GATHER) { if (last && has_next) PG8_GATHER_FROM_LDS(); }
            PG8_LDA(At, 0, 1); PG8_STAGE(PG8_SB(0, 0), b2, voffB); PG8_STAGE(PG8_SB(0, 1), b2 + hstep, voffB); PG8_STAGE_A(PG8_SA(0, 0), a2, 0);
            PG8_WAIT_V(8); PG8_WAIT_L(0); PG8_BAR; PG8_MMA(1, 0, At, B0); PG8_MMA(1, 1, At, B1); PG8_BAR; PG8_SCHED;
            PG8_LDB(B0, 1, 0); PG8_LDB(B1, 1, 1); PG8_SCHED; PG8_LDA(At, 1, 0); PG8_STAGE_A(PG8_SA(0, 1), a2, 1);
            PG8_WAIT_V(8); PG8_WAIT_L(0); PG8_BAR; PG8_MMA(0, 0, At, B0); PG8_MMA(0, 1, At, B1); PG8_BAR; PG8_SCHED;
            PG8_LDA(At, 1, 1); PG8_STAGE(PG8_SB(1, 0), b3, voffB); PG8_STAGE(PG8_SB(1, 1), b3 + hstep, voffB); PG8_STAGE_A(PG8_SA(1, 0), a3, 0);
            PG8_WAIT_V(8); PG8_WAIT_L(0); PG8_BAR; PG8_MMA(1, 0, At, B0); PG8_MMA(1, 1, At, B1); PG8_BAR; PG8_SCHED;
#endif
        }
        if (wr == 0) PG8_BAR;
        E(acc, cur, wr, wc, fr, fq);
#if EPI2
        if constexpr (Epi::PERM) E(acc, cur, wr, wc, fr, fq);
#endif
        if (!has_next) break;
#pragma unroll
        for (int a = 0; a < 2; ++a)
#pragma unroll
            for (int b = 0; b < 2; ++b)
#pragma unroll
                for (int m = 0; m < 4; ++m)
#pragma unroll
                    for (int n = 0; n < 2; ++n) { double z0_, z1_; asm volatile("v_mov_b64 %0, 0" : "=v"(z0_)); asm volatile("v_mov_b64 %0, 0" : "=v"(z1_)); const f64x2_t z_ = {z0_, z1_}; acc[a][b][m][n] = __builtin_bit_cast(f32x4, z_); }
        cur = nxt; cA = nA; cB = nB; ++ui;
        if constexpr (Prob::SPLITK) nt = S.ntiles(cur);
        if (wr == 1) PG8_BAR;
    }
    PG8_WAIT_V(0);
    PG8_BAR;
#undef PG8_SA
#undef PG8_SB
#undef PG8_STAGE
#undef PG8_STAGE_A
#undef PG8_LDA
#undef PG8_LDB
#undef PG8_MMA
#undef PG8_WAIT_V
#undef PG8_WAIT_L
#undef PG8_BAR
#undef PG8_SCHED
#undef PG8_GATHER_VOFF
#undef PG8_GATHER_DMA
#undef PG8_GATHER_FROM_LDS
}
}

__device__ __forceinline__ void gemm_ctx_res(Frame& F, const bf16* A, int lda, const bf16* Bt, int K, bool first, const float* gate4) {
    if (F.bid >= 256) return;
    const int tm = F.bid >> 4, tn = F.bid & 15, lr = F.lane & 15, lq = F.lane >> 4;
    const int ks = K / 8, nst = ks / 32;
    const bf16* ap = A + (size_t)(ML + 64 * tm + lr) * lda + F.wave * ks + 8 * lq; const bf16* bp = Bt + (size_t)(64 * tn + lr) * K + F.wave * ks + 8 * lq;
    f32x4 acc[4][4];
#pragma unroll
    for (int mi = 0; mi < 4; ++mi)
#pragma unroll
        for (int ni = 0; ni < 4; ++ni) acc[mi][ni] = (f32x4){0.f, 0.f, 0.f, 0.f};
    for (int st0 = 0; st0 < nst; st0 += 4) {
        bf16x8 af[4][4], bfr[4][4];
#pragma unroll
        for (int s_ = 0; s_ < 4; ++s_) if (st0 + s_ < nst) {
#pragma unroll
            for (int q = 0; q < 4; ++q) { af[s_][q] = *(const bf16x8*)(ap + (size_t)(16 * q) * lda + 32 * (st0 + s_)); bfr[s_][q] = *(const bf16x8*)(bp + (size_t)(16 * q) * K + 32 * (st0 + s_)); } }
        __builtin_amdgcn_sched_barrier(0);
#pragma unroll
        for (int s_ = 0; s_ < 4; ++s_) if (st0 + s_ < nst) {
#pragma unroll
            for (int mi = 0; mi < 4; ++mi)
#pragma unroll
                for (int ni = 0; ni < 4; ++ni) acc[mi][ni] = __builtin_amdgcn_mfma_f32_16x16x32_bf16(af[s_][mi], bfr[s_][ni], acc[mi][ni], 0, 0, 0); }
        __builtin_amdgcn_sched_barrier(0);
    }
    LAS float* Pl = (LAS float*)(F.lds) + F.wave * 4096;
#pragma unroll
    for (int mi = 0; mi < 4; ++mi)
#pragma unroll
        for (int ni = 0; ni < 4; ++ni)
#pragma unroll
            for (int q = 0; q < 4; ++q) Pl[(16 * mi + 4 * lq + q) * 64 + 16 * ni + lr] = acc[mi][ni][q];
    __syncthreads();
    { const int i = F.tid >> 3, j0 = (F.tid & 7) * 8; const LAS float* Ps = (const LAS float*)(F.lds) + i * 64 + j0;
      f32x4 s0 = (f32x4){0.f, 0.f, 0.f, 0.f}, s1 = s0;
#pragma unroll
      for (int w = 0; w < 8; ++w) { s0 = s0 + *(const LAS f32x4*)(Ps + w * 4096); s1 = s1 + *(const LAS f32x4*)(Ps + w * 4096 + 4); }
      const size_t ro = (size_t)(64 * tm + i) * D + 64 * tn + j0; const float* gp = gate4 + 64 * tn + j0;
      const f32x4 g0 = *(const f32x4*)gp, g1 = *(const f32x4*)(gp + 4); bf16* xd = F_XB + (size_t)ML * D + ro; f32x4 x0, x1;
      if (first) { const float* cin = INP(I_CTX); x0 = *(const f32x4*)(cin + ro); x1 = *(const f32x4*)(cin + ro + 4); }
      else { const v4u w = *(const v4u*)xd; x0 = (f32x4){bflo(w.x), bfhi(w.x), bflo(w.y), bfhi(w.y)}; x1 = (f32x4){bflo(w.z), bfhi(w.z), bflo(w.w), bfhi(w.w)}; }
      const f32x4 v0 = x0 + g0 * s0, v1 = x1 + g1 * s1; v4u o; o.x = pk2(v0.x, v0.y); o.y = pk2(v0.z, v0.w); o.z = pk2(v1.x, v1.y); o.w = pk2(v1.z, v1.w); *(v4u*)xd = o; }
    __syncthreads();
}

__device__ __forceinline__ void sa_xr_conv(Frame& F, int l) {
    const float* cw = INP(I_RCW) + (size_t)l * 4 * DR; const float* cb = INP(I_RCB) + (size_t)l * DR;
    for (size_t idx = (size_t)F.bid * NTHREADS + F.tid; idx < (size_t)M * DR; idx += (size_t)F.G * NTHREADS) {
        const int row = (int)(idx >> 9), c = (int)(idx & 511);
        int t, L; if (row < ML) { t = row & (SEQ - 1); L = SEQ; } else { t = (row - ML) & (CTXL - 1); L = CTXL; }
        float a = cb[c];
#pragma unroll
        for (int k = 0; k < 4; ++k) { const int tt = t + k - 2; if (tt >= 0 && tt < L) a += cw[k * DR + c] * bf2f(F_P[(size_t)(row + k - 2) * PW + 1024 + c]); }
        F_XR[idx] = a;
    }
}
__device__ __forceinline__ void sa_mx(Frame& F, int l) {
    const float* cw = INP(I_CONVW) + (size_t)l * 3 * DR; const bf16* Pb = F_P; bf16* MIXb = F_MIX;
    const int gt = F.bid * NTHREADS + F.tid, c0 = (gt & 63) * 8; const int rstep = (F.G * NTHREADS) >> 6;
    float w0[8], w1[8], w2[8];
#pragma unroll
    for (int q = 0; q < 8; ++q) { w0[q] = cw[c0 + q]; w1[q] = cw[DR + c0 + q]; w2[q] = cw[2 * DR + c0 + q]; }
    for (int row0 = gt >> 6; row0 < M; row0 += 4 * rstep) {
        v4u um[4], u0[4], up[4], cbv[4];
#pragma unroll
        for (int k = 0; k < 4; ++k) { const int row = row0 + k * rstep; const v4u z = (v4u){0u, 0u, 0u, 0u}; um[k] = z; u0[k] = z; up[k] = z; cbv[k] = z;
            if (row < M) { int dlt; bool okm, okp;
                if (row < ML) { const int t = row & (SEQ - 1); if (c0 < 256) { dlt = 1; okm = (t & 63) > 0; okp = (t & 63) < 63; } else { dlt = 64; okm = (t >> 6) > 0; okp = (t >> 6) < 127; } }
                else { const int t = (row - ML) & (CTXL - 1); dlt = 1; okm = t > 0; okp = t < CTXL - 1; }
                if (okm) um[k] = *(const v4u*)(Pb + (size_t)(row - dlt) * PW + 512 + c0);
                u0[k] = *(const v4u*)(Pb + (size_t)row * PW + 512 + c0);
                if (okp) up[k] = *(const v4u*)(Pb + (size_t)(row + dlt) * PW + 512 + c0);
                cbv[k] = *(const v4u*)(Pb + (size_t)row * PW + c0); } }
#pragma unroll
        for (int k = 0; k < 4; ++k) { const int row = row0 + k * rstep;
            if (row < M) { v4u o;
#pragma unroll
                for (int q = 0; q < 4; ++q) {
                    const float r0 = bflo(cbv[k][q]) * (w0[2 * q] * bflo(um[k][q]) + w1[2 * q] * bflo(u0[k][q]) + w2[2 * q] * bflo(up[k][q]));
                    const float r1 = bfhi(cbv[k][q]) * (w0[2 * q + 1] * bfhi(um[k][q]) + w1[2 * q + 1] * bfhi(u0[k][q]) + w2[2 * q + 1] * bfhi(up[k][q]));
                    o[q] = pk2(r0, r1); }
                *(v4u*)(MIXb + (size_t)row * D + c0) = o; } }
    }
}
__device__ __forceinline__ void sa_mx_alt(Frame& F, int l) {
    const float* cw = INP(I_CONVW) + (size_t)l * 3 * DR; const bf16* P = F_P; bf16* MIXb = F_MIX;
    for (size_t idx = (size_t)F.bid * NTHREADS + F.tid; idx < (size_t)M * DR; idx += (size_t)F.G * NTHREADS) {
        const int row = (int)(idx / DR), c = (int)(idx % DR);
        float acc = 0.f;
        if (row < ML) { const int b = row / SEQ, t = row % SEQ, gr = t / 64, gc = t % 64;
            for (int k = 0; k < 3; ++k) {
                if (c < 256) { const int g2 = gc + k - 1; if (g2 >= 0 && g2 < 64) acc += cw[k * DR + c] * bf2f(P[(size_t)(b * SEQ + gr * 64 + g2) * PW + 512 + c]); }
                else { const int r2 = gr + k - 1; if (r2 >= 0 && r2 < SEQ / 64) acc += cw[k * DR + c] * bf2f(P[(size_t)(b * SEQ + r2 * 64 + gc) * PW + 512 + c]); } } }
        else { const int b = (row - ML) / CTXL, t = (row - ML) % CTXL;
            for (int k = 0; k < 3; ++k) { const int t2 = t + k - 1; if (t2 >= 0 && t2 < CTXL) acc += cw[k * DR + c] * bf2f(P[(size_t)(ML + b * CTXL + t2) * PW + 512 + c]); } }
        MIXb[(size_t)row * D + c] = (bf16)f2bf(bf2f(P[(size_t)row * PW + c]) * acc);
    }
}
__device__ __forceinline__ void sb_scan_naive(Frame& F, int l) {
    if (F.bid >= 64 || F.wave != 0) return;
    const int b = F.bid >> 4, h = (F.bid >> 1) & 7, d = F.bid & 1, j = F.lane;
    volatile LAS float* xs = (volatile LAS float*)(F.lds + 0);
    LAS float* WA = (LAS float*)(F.lds + 1024);
    LAS float* WI = (LAS float*)(F.lds + 1024 + 16384);
    { const float* pa = INP(I_LWA) + ((size_t)((l * 2 + d) * 8 + h) * 64) * 64 + j; const float* pi = INP(I_LWI) + ((size_t)((l * 2 + d) * 8 + h) * 64) * 64 + j;
      for (int i = 0; i < 64; ++i) { WA[i * 64 + j] = pa[i * 64]; WI[i * 64 + j] = pi[i * 64]; } }
    LDS_WAIT(); __builtin_amdgcn_wave_barrier();
    const float ba = INP(I_LBA)[(l * 2 + d) * DR + 64 * h + j], bi = INP(I_LBI)[(l * 2 + d) * DR + 64 * h + j], k2 = F_LRUK[(l * 2 + d) * DR + 64 * h + j];
    float* HX = d ? F_HB : F_HF;
    float hst = 0.f;
    for (int seg = 0; seg < 2; ++seg) {
        const int L = seg == 0 ? CTXL : SEQ; const int rowbase = seg == 0 ? ML + b * CTXL : b * SEQ;
        for (int s0 = 0; s0 < L; s0 += 4) {
            float xv[4];
#pragma unroll
            for (int q = 0; q < 4; ++q) { const int t = d ? L - 1 - (s0 + q) : s0 + q; xv[q] = F_XR[(size_t)(rowbase + t) * DR + 64 * h + j]; }
#pragma unroll
            for (int q = 0; q < 4; ++q) {
                const int t = d ? L - 1 - (s0 + q) : s0 + q; const float x = xv[q];
                xs[j] = x; LDS_WAIT(); __builtin_amdgcn_wave_barrier();
                float za = ba, zi = bi;
#pragma unroll 16
                for (int i = 0; i < 64; ++i) { const float xi = xs[i]; za += xi * WA[i * 64 + j]; zi += xi * WI[i * 64 + j]; }
                __builtin_amdgcn_wave_barrier();
                const float r_ = sigm(za), ig = sigm(zi);
                const float a = __builtin_amdgcn_exp2f(-k2 * r_);
                const float mult = sqrtf(fmaxf(1.0f - a * a, 0.f));
                hst = a * hst + mult * ig * x;
                HX[(size_t)(rowbase + t) * DR + 64 * h + j] = hst;
            }
        }
    }
}
__device__ __forceinline__ void sc_combine(Frame& F) {
    for (size_t idx = (size_t)F.bid * NTHREADS + F.tid; idx < (size_t)M * (DR / 2); idx += (size_t)F.G * NTHREADS) {
        const int row = (int)(idx >> 8), c = (int)(idx & 255) * 2;
        const unsigned gg = *(const unsigned*)(F_P + (size_t)row * PW + 1536 + c);
        const size_t o = (size_t)row * DR + c;
        const float r0 = (F_HF[o] + F_HB[o]) * bflo(gg), r1 = (F_HF[o + 1] + F_HB[o + 1]) * bfhi(gg);
        *(unsigned*)(F_MIX + (size_t)row * D + 512 + c) = pk2(r0, r1);
    }
}

constexpr int NPOS = 66;
constexpr int S_XRB = 0, S_WG = 16384, S_A = 49152, S_B = 81920, S_HS = 114688, S_AGGW = 133120;
struct SUnit { int b, p, L, t0, rowbase; };
__device__ __forceinline__ void s_unit(int u, SUnit& U) { const int idx = u >> 3; U.b = idx / NPOS; U.p = idx - U.b * NPOS; const bool isctx = U.p < 2; U.L = isctx ? CTXL : SEQ; U.t0 = isctx ? 128 * U.p : 128 * (U.p - 2); U.rowbase = isctx ? ML + U.b * CTXL : U.b * SEQ; }
template <bool APPLY>
__device__ __forceinline__ void s_phase(Frame& F, int l) {
    const int tid = F.tid, lane = F.lane, wave = F.wave; LAS unsigned char* lds = F.lds;
    const int h = F.bid & 7;
    const bf16* Pb = F_P; bf16* MIXb = F_MIX; float* AGGb = F_AGG; const float* CARb = F_CAR; unsigned* ABb = F_AB;
    const float* rcw = INP(I_RCW) + (size_t)l * 4 * DR + 64 * h; const float* rcb = INP(I_RCB) + (size_t)l * DR + 64 * h;
    LAS float* Al = (LAS float*)(lds + S_A); LAS float* Bl = (LAS float*)(lds + S_B); LAS unsigned short* HS = (LAS unsigned short*)(lds + S_HS); LAS float* AGGW = (LAS float*)(lds + S_AGGW);
    { const bf16* WGb = F_WGATE;
#pragma unroll
      for (int i = 0; i < 4; ++i) { const int q = tid + 512 * i, d = q >> 10, qq = q & 1023, gate = qq >> 9, n = (qq >> 3) & 63, ch = qq & 7;
          const v4u v = *(const v4u*)(WGb + (size_t)(((l * 2 + d) * 8 + h) * 2) * 4096 + (size_t)qq * 8);
          *(LAS v4u*)(lds + S_WG + d * 16384 + gate * 8192 + n * 128 + ((ch ^ (n & 7)) * 16)) = v; } }
    float k2r[2][4], bar[2][4], bir[2][4];
    { const float* lba = INP(I_LBA) + (size_t)l * 2 * DR + 64 * h; const float* lbi = INP(I_LBI) + (size_t)l * 2 * DR + 64 * h; const float* LRUKb = F_LRUK + (size_t)l * 2 * DR + 64 * h;
#pragma unroll
      for (int d = 0; d < 2; ++d)
#pragma unroll
          for (int ct = 0; ct < 4; ++ct) { const int chl = 16 * ct + (lane & 15); k2r[d][ct] = LRUKb[d * DR + chl]; bar[d][ct] = lba[d * DR + chl]; bir[d][ct] = lbi[d * DR + chl]; } }
    const int t = tid >> 2, cg = tid & 3;
    v4u rA[4], rB[4], g0, g1; float car0 = 0.f, car1 = 0.f; unsigned rmask = 0u;
#define S_PREFETCH(u_) do { SUnit V; s_unit((u_), V); const int tt_ = V.t0 + t; rmask = 0u; \
        _Pragma("unroll") for (int k = 0; k < 4; ++k) { const int ts = tt_ + k - 2; if (ts >= 0 && ts < V.L) { const bf16* rp = Pb + (size_t)(V.rowbase + ts) * PW + 1024 + 64 * h + 16 * cg; rA[k] = *(const v4u*)rp; rB[k] = *(const v4u*)(rp + 8); rmask |= 1u << k; } } \
        if (APPLY) { const bf16* gp = Pb + (size_t)(V.rowbase + tt_) * PW + 1536 + 64 * h + 16 * cg; g0 = *(const v4u*)gp; g1 = *(const v4u*)(gp + 8); \
            const int pb_ = V.p < 2 ? 1 - V.p : 67 - V.p; car0 = CARb[(size_t)((V.b * 2 + 0) * NPOS + V.p) * DR + 64 * h + lane]; car1 = CARb[(size_t)((V.b * 2 + 1) * NPOS + pb_) * DR + 64 * h + lane]; } } while (0)
    int u = F.bid;
    if (u < NB * NPOS * 8) S_PREFETCH(u);
    __syncthreads();
    for (; u < NB * NPOS * 8; u += F.G) {
        SUnit U; s_unit(u, U); const int tt = U.t0 + t;
        { float xr[16];
#pragma unroll
          for (int q = 0; q < 4; ++q) { const f32x4 bv = *(const f32x4*)(rcb + 16 * cg + 4 * q); xr[4 * q] = bv.x; xr[4 * q + 1] = bv.y; xr[4 * q + 2] = bv.z; xr[4 * q + 3] = bv.w; }
#pragma unroll
          for (int k = 0; k < 4; ++k) { if (rmask & (1u << k)) { const v4u r0 = rA[k], r1 = rB[k];
#pragma unroll
                  for (int q = 0; q < 4; ++q) { const f32x4 wv = *(const f32x4*)(rcw + k * DR + 16 * cg + 4 * q); const unsigned wa = q < 2 ? r0[2 * q] : r1[2 * q - 4], wb = q < 2 ? r0[2 * q + 1] : r1[2 * q - 3];
                      xr[4 * q] += wv.x * bflo(wa); xr[4 * q + 1] += wv.y * bfhi(wa); xr[4 * q + 2] += wv.z * bflo(wb); xr[4 * q + 3] += wv.w * bfhi(wb); } } }
          v4u o0, o1; o0.x = pk2(xr[0], xr[1]); o0.y = pk2(xr[2], xr[3]); o0.z = pk2(xr[4], xr[5]); o0.w = pk2(xr[6], xr[7]); o1.x = pk2(xr[8], xr[9]); o1.y = pk2(xr[10], xr[11]); o1.z = pk2(xr[12], xr[13]); o1.w = pk2(xr[14], xr[15]);
          *(LAS v4u*)(lds + S_XRB + t * 128 + (((2 * cg) ^ (t & 7)) * 16)) = o0; *(LAS v4u*)(lds + S_XRB + t * 128 + (((2 * cg + 1) ^ (t & 7)) * 16)) = o1; }
        const v4u cg0 = g0, cg1 = g1; const float ccar0 = car0, ccar1 = car1;
        if (u + F.G < NB * NPOS * 8) S_PREFETCH(u + F.G);
        __syncthreads();
#pragma unroll
        for (int d = 0; d < 2; ++d) {
            const int pos = d == 0 ? U.p : (U.p < 2 ? 1 - U.p : 67 - U.p);
            f32x4 za[4], zi[4];
            { bf16x8 af[2]; const int row = 16 * wave + (lane & 15);
#pragma unroll
              for (int ks = 0; ks < 2; ++ks) { const int chk = (lane >> 4) + 4 * ks; af[ks] = *(const LAS bf16x8*)(lds + S_XRB + row * 128 + ((chk ^ (row & 7)) * 16)); }
#pragma unroll
              for (int ct = 0; ct < 4; ++ct) { const int chl = 16 * ct + (lane & 15); const float ba_ = bar[d][ct], bi_ = bir[d][ct]; za[ct] = (f32x4){ba_, ba_, ba_, ba_}; zi[ct] = (f32x4){bi_, bi_, bi_, bi_};
#pragma unroll
                  for (int ks = 0; ks < 2; ++ks) { const int chk = (lane >> 4) + 4 * ks; const int wo = d * 16384 + chl * 128 + ((chk ^ (chl & 7)) * 16);
                      const bf16x8 fa = *(const LAS bf16x8*)(lds + S_WG + wo), fi = *(const LAS bf16x8*)(lds + S_WG + 8192 + wo);
                      za[ct] = __builtin_amdgcn_mfma_f32_16x16x32_bf16(af[ks], fa, za[ct], 0, 0, 0); zi[ct] = __builtin_amdgcn_mfma_f32_16x16x32_bf16(af[ks], fi, zi[ct], 0, 0, 0); } } }
#pragma unroll
            for (int ct = 0; ct < 4; ++ct) { const int chl = 16 * ct + (lane & 15); const float k2 = k2r[d][ct];
#pragma unroll
                for (int q = 0; q < 4; ++q) { const int tk = 16 * wave + 4 * (lane >> 4) + q;
                    const float x = bf2f(*(const LAS unsigned short*)(lds + S_XRB + tk * 128 + ((((chl >> 3)) ^ (tk & 7)) * 16) + (chl & 7) * 2));
                    const float r_ = sigm(za[ct][q]), ig = sigm(zi[ct][q]); const unsigned laq = f2bf(-k2 * r_); const float a = __builtin_amdgcn_exp2f(bf2f(laq)); const float mult = __builtin_amdgcn_sqrtf(fmaxf(1.0f - a * a, 0.f));
                    const unsigned bq = f2bf(mult * ig * x);
                    Al[tk * 64 + chl] = a; Bl[tk * 64 + chl] = bf2f(bq);
                    if (STORE_AB && !APPLY) ABb[((size_t)d * M + U.rowbase + U.t0 + tk) * DR + 64 * h + chl] = laq | (bq << 16); } }
            __syncthreads();
            { float Pl = 1.f, Hl = 0.f;
#pragma unroll
              for (int s_ = 0; s_ < 16; ++s_) { const int tk = 16 * wave + (d ? 15 - s_ : s_); const float a = Al[tk * 64 + lane], bb = Bl[tk * 64 + lane]; Hl = a * Hl + bb; Pl *= a; }
              AGGW[(wave * 64 + lane) * 2] = Pl; AGGW[(wave * 64 + lane) * 2 + 1] = Hl; }
            __syncthreads();
            if (!APPLY) {
                if (wave == 0) { float Pc = 1.f, Hc = 0.f;
#pragma unroll
                    for (int k = 0; k < 8; ++k) { const int w2 = d ? 7 - k : k; const float pw = AGGW[(w2 * 64 + lane) * 2], hw = AGGW[(w2 * 64 + lane) * 2 + 1]; Hc = pw * Hc + hw; Pc *= pw; }
                    float* ag = AGGb + ((size_t)((U.b * 2 + d) * NPOS + pos) * DR + 64 * h + lane) * 2; ag[0] = Pc; ag[1] = Hc; }
            } else {
                float hst = d ? ccar1 : ccar0;
#pragma unroll
                for (int k = 0; k < 8; ++k) { const int w2 = d ? 7 - k : k; const bool before = d ? (w2 > wave) : (w2 < wave);
                    if (before) { const float pw = AGGW[(w2 * 64 + lane) * 2], hw = AGGW[(w2 * 64 + lane) * 2 + 1]; hst = pw * hst + hw; } }
#pragma unroll
                for (int s_ = 0; s_ < 16; ++s_) { const int tk = 16 * wave + (d ? 15 - s_ : s_); const float a = Al[tk * 64 + lane], bb = Bl[tk * 64 + lane]; hst = a * hst + bb;
                    if (d == 0) HS[tk * 64 + lane] = (unsigned short)f2bf(hst); else HS[tk * 64 + lane] = (unsigned short)f2bf(bf2f(HS[tk * 64 + lane]) + hst); }
            }
            __syncthreads();
        }
        if (APPLY) {
            const LAS v4u* hp = (const LAS v4u*)(HS + t * 64 + 16 * cg); const v4u h0 = hp[0], h1 = hp[1];
            v4u o0, o1;
#pragma unroll
            for (int q = 0; q < 4; ++q) { o0[q] = pk2(bflo(h0[q]) * bflo(cg0[q]), bfhi(h0[q]) * bfhi(cg0[q])); o1[q] = pk2(bflo(h1[q]) * bflo(cg1[q]), bfhi(h1[q]) * bfhi(cg1[q])); }
            bf16* op = MIXb + (size_t)(U.rowbase + tt) * D + 512 + 64 * h + 16 * cg; *(v4u*)op = o0; *(v4u*)(op + 8) = o1;
            __syncthreads();
        }
    }
#undef S_PREFETCH
}
__device__ __forceinline__ void s1_phase(Frame& F, int l) {
    const int tid = F.tid, lane = F.lane, wave = F.wave; LAS unsigned char* lds = F.lds;
    const int h = F.bid & 7;
    const bf16* Pb = F_P; float* AGGb = F_AGG; unsigned* ABb = F_AB;
    const float* rcw = INP(I_RCW) + (size_t)l * 4 * DR + 64 * h; const float* rcb = INP(I_RCB) + (size_t)l * DR + 64 * h;
    LAS float* AGW = (LAS float*)(lds + S_A);
    { const bf16* WGb = F_WGATE;
#pragma unroll
      for (int i = 0; i < 4; ++i) { const int q = tid + 512 * i, d = q >> 10, qq = q & 1023, gate = qq >> 9, n = (qq >> 3) & 63, ch = qq & 7;
          const v4u v = *(const v4u*)(WGb + (size_t)(((l * 2 + d) * 8 + h) * 2) * 4096 + (size_t)qq * 8);
          *(LAS v4u*)(lds + S_WG + d * 16384 + gate * 8192 + n * 128 + ((ch ^ (n & 7)) * 16)) = v; } }
    LAS float* CWl = (LAS float*)(lds + S_B); LAS float* CBl = CWl + 256;
    if (tid < 256) CWl[tid] = rcw[(tid >> 6) * DR + (tid & 63)]; else if (tid < 320) CBl[tid - 256] = rcb[tid - 256];
    float k2r[2][4], bar[2][4], bir[2][4];
    { const float* lba = INP(I_LBA) + (size_t)l * 2 * DR + 64 * h; const float* lbi = INP(I_LBI) + (size_t)l * 2 * DR + 64 * h; const float* LRUKb = F_LRUK + (size_t)l * 2 * DR + 64 * h;
#pragma unroll
      for (int d = 0; d < 2; ++d)
#pragma unroll
          for (int ct = 0; ct < 4; ++ct) { const int chl = 16 * ct + (lane & 15); k2r[d][ct] = LRUKb[d * DR + chl]; bar[d][ct] = lba[d * DR + chl]; bir[d][ct] = lbi[d * DR + chl]; } }
    const int t = tid >> 2, cg = tid & 3, grp = lane >> 4;
    v4u rA[4], rB[4]; unsigned rmask = 0u;
#define S1_PREFETCH(u_) do { SUnit V; s_unit((u_), V); const int tt_ = V.t0 + t; rmask = 0u; \
        _Pragma("unroll") for (int k = 0; k < 4; ++k) { const int ts = tt_ + k - 2; if (ts >= 0 && ts < V.L) { const bf16* rp = Pb + (size_t)(V.rowbase + ts) * PW + 1024 + 64 * h + 16 * cg; rA[k] = *(const v4u*)rp; rB[k] = *(const v4u*)(rp + 8); rmask |= 1u << k; } } } while (0)
    int u = F.bid;
    if (u < NB * NPOS * 8) S1_PREFETCH(u);
    __syncthreads();
    for (; u < NB * NPOS * 8; u += F.G) {
        SUnit U; s_unit(u, U);
        { float xr[16];
#pragma unroll
          for (int q = 0; q < 4; ++q) { const f32x4 bv = *(const LAS f32x4*)(CBl + 16 * cg + 4 * q); xr[4 * q] = bv.x; xr[4 * q + 1] = bv.y; xr[4 * q + 2] = bv.z; xr[4 * q + 3] = bv.w; }
#pragma unroll
          for (int k = 0; k < 4; ++k) { if (rmask & (1u << k)) { const v4u r0 = rA[k], r1 = rB[k];
#pragma unroll
                  for (int q = 0; q < 4; ++q) { const f32x4 wv = *(const LAS f32x4*)(CWl + k * 64 + 16 * cg + 4 * q); const unsigned wa = q < 2 ? r0[2 * q] : r1[2 * q - 4], wb = q < 2 ? r0[2 * q + 1] : r1[2 * q - 3];
                      xr[4 * q] += wv.x * bflo(wa); xr[4 * q + 1] += wv.y * bfhi(wa); xr[4 * q + 2] += wv.z * bflo(wb); xr[4 * q + 3] += wv.w * bfhi(wb); } } }
          v4u o0, o1; o0.x = pk2(xr[0], xr[1]); o0.y = pk2(xr[2], xr[3]); o0.z = pk2(xr[4], xr[5]); o0.w = pk2(xr[6], xr[7]); o1.x = pk2(xr[8], xr[9]); o1.y = pk2(xr[10], xr[11]); o1.z = pk2(xr[12], xr[13]); o1.w = pk2(xr[14], xr[15]);
          *(LAS v4u*)(lds + S_XRB + t * 128 + (((2 * cg) ^ (t & 7)) * 16)) = o0; *(LAS v4u*)(lds + S_XRB + t * 128 + (((2 * cg + 1) ^ (t & 7)) * 16)) = o1; }
        if (u + F.G < NB * NPOS * 8) S1_PREFETCH(u + F.G);
        __syncthreads();
        bf16x8 af[2]; { const int row = 16 * wave + (lane & 15);
#pragma unroll
          for (int ks = 0; ks < 2; ++ks) { const int chk = grp + 4 * ks; af[ks] = *(const LAS bf16x8*)(lds + S_XRB + row * 128 + ((chk ^ (row & 7)) * 16)); } }
        float xv[4][4];
#pragma unroll
        for (int ct = 0; ct < 4; ++ct) { const int chl = 16 * ct + (lane & 15);
#pragma unroll
            for (int q = 0; q < 4; ++q) { const int tk = 16 * wave + 4 * grp + q; xv[ct][q] = bf2f(*(const LAS unsigned short*)(lds + S_XRB + tk * 128 + ((((chl >> 3)) ^ (tk & 7)) * 16) + (chl & 7) * 2)); } }
#pragma unroll
        for (int d = 0; d < 2; ++d) {
            unsigned* abrow = ABb + ((size_t)d * M + U.rowbase + U.t0 + 16 * wave + 4 * grp) * DR + 64 * h + (lane & 15);
#pragma unroll
            for (int ct = 0; ct < 4; ++ct) { const int chl = 16 * ct + (lane & 15); const float ba_ = bar[d][ct], bi_ = bir[d][ct], k2 = k2r[d][ct];
                f32x4 za = (f32x4){ba_, ba_, ba_, ba_}, zi = (f32x4){bi_, bi_, bi_, bi_};
#pragma unroll
                for (int ks = 0; ks < 2; ++ks) { const int chk = grp + 4 * ks; const int wo = d * 16384 + chl * 128 + ((chk ^ (chl & 7)) * 16);
                    const bf16x8 fa = *(const LAS bf16x8*)(lds + S_WG + wo), fi = *(const LAS bf16x8*)(lds + S_WG + 8192 + wo);
                    za = __builtin_amdgcn_mfma_f32_16x16x32_bf16(af[ks], fa, za, 0, 0, 0); zi = __builtin_amdgcn_mfma_f32_16x16x32_bf16(af[ks], fi, zi, 0, 0, 0); }
                float Pl = 1.f, Hl = 0.f;
#pragma unroll
                for (int qq = 0; qq < 4; ++qq) { const int q = d ? 3 - qq : qq;
                    const float r_ = sigm(za[q]), ig = sigm(zi[q]); const unsigned w = pk2(-k2 * r_, 0.f) & 0xffffu; const float a = __builtin_amdgcn_exp2f(bf2f(w)); const float mult = __builtin_amdgcn_sqrtf(fmaxf(1.0f - a * a, 0.f));
                    const unsigned bq = f2bf(mult * ig * xv[ct][q]); abrow[(size_t)q * DR + 16 * ct] = w | (bq << 16);
                    Hl = a * Hl + bf2f(bq); Pl *= a; }
                { const float Pp = __shfl_xor(Pl, 16), Hp = __shfl_xor(Hl, 16); const bool first = d ? ((grp & 1) != 0) : ((grp & 1) == 0);
                  const float Pn = Pl * Pp, Hn = first ? (Pp * Hl + Hp) : (Pl * Hp + Hl); Pl = Pn; Hl = Hn; }
                { const float Pp = __shfl_xor(Pl, 32), Hp = __shfl_xor(Hl, 32); const bool first = d ? ((grp & 2) != 0) : ((grp & 2) == 0);
                  const float Pn = Pl * Pp, Hn = first ? (Pp * Hl + Hp) : (Pl * Hp + Hl); Pl = Pn; Hl = Hn; }
                if (lane < 16) { AGW[((d * 8 + wave) * 64 + chl) * 2] = Pl; AGW[((d * 8 + wave) * 64 + chl) * 2 + 1] = Hl; }
            }
        }
        __syncthreads();
        if (wave < 2) { const int d = wave; const int pos = d == 0 ? U.p : (U.p < 2 ? 1 - U.p : 67 - U.p); float Pc = 1.f, Hc = 0.f;
#pragma unroll
            for (int k = 0; k < 8; ++k) { const int w2 = d ? 7 - k : k; const float pw = AGW[((d * 8 + w2) * 64 + lane) * 2], hw = AGW[((d * 8 + w2) * 64 + lane) * 2 + 1]; Hc = pw * Hc + hw; Pc *= pw; }
            float* ag = AGGb + ((size_t)((U.b * 2 + d) * NPOS + pos) * DR + 64 * h + lane) * 2; ag[0] = Pc; ag[1] = Hc; }
    }
#undef S1_PREFETCH
}
__device__ __forceinline__ void s3r_phase(Frame& F) {
    const int lane = F.lane, wave = F.wave; LAS unsigned char* lds = F.lds;
    const int h = F.bid & 7;
    const GAS bf16* Pb = (const GAS bf16*)F_P; GAS bf16* MIXb = (GAS bf16*)F_MIX; const GAS float* CARb = (const GAS float*)F_CAR; const GAS unsigned* ABb = (const GAS unsigned*)F_AB;
    LAS float* AGW = (LAS float*)(lds + S_A);
    unsigned wf[16], wb[16]; unsigned short gq[16]; float car0 = 0.f, car1 = 0.f;
#define S3R_PREFETCH(u_) do { SUnit V; s_unit((u_), V); const size_t r0_ = (size_t)(V.rowbase + V.t0 + 16 * wave); const int c_ = 64 * h + lane; \
        _Pragma("unroll") for (int s_ = 0; s_ < 16; ++s_) { wf[s_] = __builtin_nontemporal_load(ABb + (r0_ + s_) * DR + c_); wb[s_] = __builtin_nontemporal_load(ABb + ((size_t)M + r0_ + s_) * DR + c_); gq[s_] = Pb[(r0_ + s_) * PW + 1536 + c_]; } \
        const int pb_ = V.p < 2 ? 1 - V.p : 67 - V.p; car0 = CARb[(size_t)((V.b * 2 + 0) * NPOS + V.p) * DR + c_]; car1 = CARb[(size_t)((V.b * 2 + 1) * NPOS + pb_) * DR + c_]; } while (0)
    int u = F.bid, par = 0;
    if (u < NB * NPOS * 8) S3R_PREFETCH(u);
    for (; u < NB * NPOS * 8; u += F.G, par ^= 1) {
        SUnit U; s_unit(u, U);
        float af[16], bfv[16], ab[16], bb[16], gv[16];
#pragma unroll
        for (int s_ = 0; s_ < 16; ++s_) { af[s_] = __builtin_amdgcn_exp2f(bflo(wf[s_])); bfv[s_] = bfhi(wf[s_]); ab[s_] = __builtin_amdgcn_exp2f(bflo(wb[s_])); bb[s_] = bfhi(wb[s_]); gv[s_] = bf2f(gq[s_]); }
        const float c0 = car0, c1 = car1;
        if (u + F.G < NB * NPOS * 8) S3R_PREFETCH(u + F.G);
        { float P0 = 1.f, H0 = 0.f, P1 = 1.f, H1 = 0.f;
#pragma unroll
          for (int s_ = 0; s_ < 16; ++s_) { H0 = af[s_] * H0 + bfv[s_]; P0 *= af[s_]; H1 = ab[15 - s_] * H1 + bb[15 - s_]; P1 *= ab[15 - s_]; }
          LAS float* aw = AGW + (size_t)par * 2048;
          aw[((0 * 8 + wave) * 64 + lane) * 2] = P0; aw[((0 * 8 + wave) * 64 + lane) * 2 + 1] = H0; aw[((1 * 8 + wave) * 64 + lane) * 2] = P1; aw[((1 * 8 + wave) * 64 + lane) * 2 + 1] = H1; }
        __syncthreads();
        float hf[16];
        { const LAS float* aw = AGW + (size_t)par * 2048; float hst = c0;
#pragma unroll
          for (int k = 0; k < 8; ++k) { if (k < wave) { const float pw = aw[((0 * 8 + k) * 64 + lane) * 2], hw = aw[((0 * 8 + k) * 64 + lane) * 2 + 1]; hst = pw * hst + hw; } }
#pragma unroll
          for (int s_ = 0; s_ < 16; ++s_) { hst = af[s_] * hst + bfv[s_]; hf[s_] = hst; }
          hst = c1;
#pragma unroll
          for (int k = 7; k >= 0; --k) { if (k > wave) { const float pw = aw[((1 * 8 + k) * 64 + lane) * 2], hw = aw[((1 * 8 + k) * 64 + lane) * 2 + 1]; hst = pw * hst + hw; } }
          GAS bf16* op = MIXb + (size_t)(U.rowbase + U.t0 + 16 * wave) * D + 512 + 64 * h + lane;
#pragma unroll
          for (int s_ = 15; s_ >= 0; --s_) { hst = ab[s_] * hst + bb[s_]; op[(size_t)s_ * D] = (bf16)f2bf((hf[s_] + hst) * gv[s_]); } }
    }
#undef S3R_PREFETCH
}
__device__ __forceinline__ void s3_phase(Frame& F) {
    const int tid = F.tid, lane = F.lane, wave = F.wave; LAS unsigned char* lds = F.lds;
    const int h = F.bid & 7;
    const bf16* Pb = F_P; bf16* MIXb = F_MIX; const float* CARb = F_CAR; const unsigned* ABb = F_AB;
    LAS float* Al = (LAS float*)(lds + S_A); LAS float* Bl = (LAS float*)(lds + S_B); LAS unsigned short* HS = (LAS unsigned short*)(lds + S_HS); LAS float* AGGW = (LAS float*)(lds + S_AGGW);
    const int t = tid >> 2, cg = tid & 3;
    v4u ab[2][4], g0, g1; float car0 = 0.f, car1 = 0.f;
#define S3_PREFETCH(u_) do { SUnit V; s_unit((u_), V); const int tt_ = V.t0 + t; \
        _Pragma("unroll") for (int d = 0; d < 2; ++d) { const unsigned* ap = ABb + ((size_t)d * M + V.rowbase + tt_) * DR + 64 * h + 16 * cg; \
            _Pragma("unroll") for (int q = 0; q < 4; ++q) ab[d][q] = *(const v4u*)(ap + 4 * q); } \
        { const bf16* gp = Pb + (size_t)(V.rowbase + tt_) * PW + 1536 + 64 * h + 16 * cg; g0 = *(const v4u*)gp; g1 = *(const v4u*)(gp + 8); \
          const int pb_ = V.p < 2 ? 1 - V.p : 67 - V.p; car0 = CARb[(size_t)((V.b * 2 + 0) * NPOS + V.p) * DR + 64 * h + lane]; car1 = CARb[(size_t)((V.b * 2 + 1) * NPOS + pb_) * DR + 64 * h + lane]; } } while (0)
    int u = F.bid;
    if (u < NB * NPOS * 8) S3_PREFETCH(u);
    for (; u < NB * NPOS * 8; u += F.G) {
        SUnit U; s_unit(u, U); const int tt = U.t0 + t;
        v4u cab[2][4];
#pragma unroll
        for (int d = 0; d < 2; ++d)
#pragma unroll
            for (int q = 0; q < 4; ++q) cab[d][q] = ab[d][q];
        const v4u cg0 = g0, cg1 = g1; const float ccar0 = car0, ccar1 = car1;
        if (u + F.G < NB * NPOS * 8) S3_PREFETCH(u + F.G);
#pragma unroll
        for (int d = 0; d < 2; ++d) {
#pragma unroll
            for (int q = 0; q < 4; ++q) { f32x4 av, bv;
#pragma unroll
                for (int e = 0; e < 4; ++e) { const unsigned w = cab[d][q][e]; av[e] = __builtin_amdgcn_exp2f(bflo(w)); bv[e] = bfhi(w); }
                *(LAS f32x4*)(Al + t * 64 + 16 * cg + 4 * q) = av; *(LAS f32x4*)(Bl + t * 64 + 16 * cg + 4 * q) = bv; }
            __syncthreads();
            { float Pl = 1.f, Hl = 0.f;
#pragma unroll
              for (int s_ = 0; s_ < 16; ++s_) { const int tk = 16 * wave + (d ? 15 - s_ : s_); const float a = Al[tk * 64 + lane], bb = Bl[tk * 64 + lane]; Hl = a * Hl + bb; Pl *= a; }
              AGGW[(wave * 64 + lane) * 2] = Pl; AGGW[(wave * 64 + lane) * 2 + 1] = Hl; }
            __syncthreads();
            { float hst = d ? ccar1 : ccar0;
#pragma unroll
              for (int k = 0; k < 8; ++k) { const int w2 = d ? 7 - k : k; const bool before = d ? (w2 > wave) : (w2 < wave);
                  if (before) { const float pw = AGGW[(w2 * 64 + lane) * 2], hw = AGGW[(w2 * 64 + lane) * 2 + 1]; hst = pw * hst + hw; } }
#pragma unroll
              for (int s_ = 0; s_ < 16; ++s_) { const int tk = 16 * wave + (d ? 15 - s_ : s_); const float a = Al[tk * 64 + lane], bb = Bl[tk * 64 + lane]; hst = a * hst + bb;
                  if (d == 0) HS[tk * 64 + lane] = (unsigned short)f2bf(hst); else HS[tk * 64 + lane] = (unsigned short)f2bf(bf2f(HS[tk * 64 + lane]) + hst); } }
            __syncthreads();
        }
        { const LAS v4u* hp = (const LAS v4u*)(HS + t * 64 + 16 * cg); const v4u h0 = hp[0], h1 = hp[1];
          v4u o0, o1;
#pragma unroll
          for (int q = 0; q < 4; ++q) { o0[q] = pk2(bflo(h0[q]) * bflo(cg0[q]), bfhi(h0[q]) * bfhi(cg0[q])); o1[q] = pk2(bflo(h1[q]) * bflo(cg1[q]), bfhi(h1[q]) * bfhi(cg1[q])); }
          bf16* op = MIXb + (size_t)(U.rowbase + tt) * D + 512 + 64 * h + 16 * cg; *(v4u*)op = o0; *(v4u*)(op + 8) = o1; }
        __syncthreads();
    }
#undef S3_PREFETCH
}
__device__ __forceinline__ void s3_stream(Frame& F) {
    const GAS unsigned* ABb = (const GAS unsigned*)F_AB; const GAS float* CARb = (const GAS float*)F_CAR; const GAS bf16* Pb = (const GAS bf16*)F_P; GAS bf16* MIXb = (GAS bf16*)F_MIX; const int lane = F.lane;
    for (int u = F.bid * NWAVES + F.wave; u < NB * NPOS * 8; u += F.G * NWAVES) {
        const int h = u & 7, idx = u >> 3, b = idx / NPOS, p = idx - b * NPOS; const bool isctx = p < 2;
        const int row0 = (isctx ? ML + b * CTXL + 128 * p : b * SEQ + 128 * (p - 2)); const int pb = p < 2 ? 1 - p : 67 - p; const int c = 64 * h + lane;
        const GAS unsigned* abf = ABb + (size_t)row0 * DR + c; const GAS unsigned* abb = ABb + ((size_t)M + row0) * DR + c;
        const GAS bf16* gp = Pb + (size_t)row0 * PW + 1536 + c; GAS bf16* op = MIXb + (size_t)row0 * D + 512 + c;
        float hf[128];
        float hst = CARb[(size_t)((b * 2 + 0) * NPOS + p) * DR + c];
#pragma unroll
        for (int bt = 0; bt < 8; ++bt) { unsigned w[16];
#pragma unroll
            for (int i = 0; i < 16; ++i) w[i] = abf[(size_t)(16 * bt + i) * DR];
#pragma unroll
            for (int i = 0; i < 16; ++i) { hst = __builtin_amdgcn_exp2f(bflo(w[i])) * hst + bfhi(w[i]); hf[16 * bt + i] = hst; } }
        hst = CARb[(size_t)((b * 2 + 1) * NPOS + pb) * DR + c];
#pragma unroll
        for (int bt = 7; bt >= 0; --bt) { unsigned w[16]; unsigned short g[16]; float o[16];
#pragma unroll
            for (int i = 0; i < 16; ++i) { w[i] = abb[(size_t)(16 * bt + i) * DR]; g[i] = gp[(size_t)(16 * bt + i) * PW]; }
#pragma unroll
            for (int i = 15; i >= 0; --i) { hst = __builtin_amdgcn_exp2f(bflo(w[i])) * hst + bfhi(w[i]); o[i] = (hf[16 * bt + i] + hst) * bf2f(g[i]); }
#pragma unroll
            for (int i = 0; i < 16; ++i) op[(size_t)(16 * bt + i) * D] = (bf16)f2bf(o[i]); }
    }
}
__device__ __forceinline__ void s2_carry(Frame& F) {
    const int gw = F.bid * NWAVES + F.wave; if (gw >= NB * 2 * 8) return;
    const int b = gw >> 4, d = (gw >> 3) & 1, h = gw & 7;
    const float* ag = F_AGG + ((size_t)(b * 2 + d) * NPOS * DR + 64 * h + F.lane) * 2; float* car = F_CAR + (size_t)(b * 2 + d) * NPOS * DR + 64 * h + F.lane;
    float hst = 0.f;
    { f32x2_t av[NPOS];
#pragma unroll
      for (int k = 0; k < NPOS; ++k) av[k] = *(const f32x2_t*)(ag + (size_t)k * DR * 2);
#pragma unroll
      for (int k = 0; k < NPOS; ++k) { car[(size_t)k * DR] = hst; hst = av[k].x * hst + av[k].y; } }
}

__device__ __forceinline__ void moe_dispatch(Frame& F, int moe) {
    LAS int* tab = (LAS int*)(F.lds + 131072 + 1024);
    if (F.tid == 0) { int off = 0; for (int e = 0; e < NE; ++e) { const int c = (int)__hip_atomic_load(F.ctl + CW_CNT + moe * 512 + e * 64, RLX_AGENT); tab[16 + e] = c; tab[32 + e] = off; off += (c + 255) & ~255; } tab[40] = off; }
    __syncthreads();
    const int total = tab[40]; const bf16* HNb = F_HN; bf16* HS = F_Y; const int* list = F_LIST;
    for (int s0 = (F.bid * NWAVES + F.wave) * 4; s0 < total; s0 += F.G * NWAVES * 4) {
        v4u a[4], b[4];
#pragma unroll
        for (int q = 0; q < 4; ++q) { const int s_ = s0 + q; a[q] = (v4u){0u, 0u, 0u, 0u}; b[q] = a[q];
            int e = 0;
#pragma unroll
            for (int k = 1; k < NE; ++k) e += (s_ >= tab[32 + k]) ? 1 : 0;
            const int rank = s_ - tab[32 + e];
            if (s_ < total && rank < tab[16 + e]) { const int tok = list[(size_t)e * M + rank]; const bf16* src = HNb + (size_t)tok * D + 16 * F.lane; a[q] = *(const v4u*)src; b[q] = *(const v4u*)(src + 8); } }
#pragma unroll
        for (int q = 0; q < 4; ++q) { const int s_ = s0 + q; if (s_ < total) { bf16* dst = HS + (size_t)s_ * D + 16 * F.lane; *(v4u*)dst = a[q]; *(v4u*)(dst + 8) = b[q]; } }
    }
}
__device__ __forceinline__ void moe_tab_build(Frame& F, int moe, LAS int* tab) {
    if (F.wave == 0) { int c = 0; if (F.lane < NE) c = (int)__hip_atomic_load(F.ctl + CW_CNT + moe * 512 + F.lane * 64, RLX_AGENT);
        int tp = 0, off = 0, mytp = 0, myoff = 0;
#pragma unroll
        for (int e = 0; e < NE; ++e) { const int ce = __builtin_amdgcn_readlane(c, e); if (F.lane == e) { mytp = tp; myoff = off; } tp += (ce + 255) >> 8; off += (ce + 255) & ~255; }
        if (F.lane < NE) { tab[F.lane] = mytp; tab[16 + F.lane] = c; tab[32 + F.lane] = myoff; }
        if (F.lane == 0) tab[8] = tp; }
}
__device__ __forceinline__ void combine_rows(Frame& F, int moe, int lc, bool latent_only, int nl = -1) {
    LAS int* OFFS = (LAS int*)(F.lds + 32768 + 8192 + 128);
    if (F.wave == 0) { int c = 0; if (F.lane < NE) c = (int)__hip_atomic_load(F.ctl + CW_CNT + moe * 512 + F.lane * 64, RLX_AGENT);
        int o = 0, myo = 0;
#pragma unroll
        for (int e = 0; e < NE; ++e) { const int ce = __builtin_amdgcn_readlane(c, e); if (F.lane == e) myo = o; o += (ce + 255) & ~255; }
        if (F.lane < NE) OFFS[F.lane] = myo; }
    __syncthreads();
    const unsigned* INFOb = F_INFO + (size_t)moe * M * 8; const bf16* Yb = F_Y; const float* MODb = F_MOD + (size_t)lc * 5 * (6 * D) + 5 * D;
    bf16* XBb = F_XB;
    f32x4 gfin[4];
#pragma unroll
    for (int j = 0; j < 4; ++j) gfin[j] = latent_only ? *(const f32x4*)(INP(I_FG) + 4 * F.lane + 256 * j) : (f32x4){0.f, 0.f, 0.f, 0.f};
    f32x4 nmul[4], nadd[4]; int nbb = -1;
    unsigned ni0[2] = {0u, 0u}, ni1[2] = {0u, 0u}, ni2[2] = {0u, 0u}, ni3[2] = {0u, 0u}, ni4[2] = {0u, 0u}, ni5[2] = {0u, 0u};
#define CR_INFO(i0_) do { _Pragma("unroll") for (int k = 0; k < 2; ++k) { const int i = (i0_) + k * NWAVES; const int r_ = F.bid * ROWS_PER_WG + i; \
        if ((i < ROWS_PER_WG) && !(latent_only && r_ >= ML)) { const unsigned* inf = INFOb + (size_t)r_ * 8; ni0[k] = inf[0]; ni1[k] = inf[1]; ni2[k] = inf[2]; ni3[k] = inf[3]; ni4[k] = inf[4]; ni5[k] = inf[5]; } } } while (0)
    CR_INFO(F.wave);
    for (int i0 = F.wave; i0 < ROWS_PER_WG; i0 += 2 * NWAVES) {
        int rr[2]; bool on[2]; int e1[2], q1[2], e2[2], q2[2]; float g1[2], g2[2];
#pragma unroll
        for (int k = 0; k < 2; ++k) { const int i = i0 + k * NWAVES; rr[k] = F.bid * ROWS_PER_WG + i; on[k] = (i < ROWS_PER_WG) && !(latent_only && rr[k] >= ML);
            if (on[k]) { e1[k] = (int)ni0[k]; q1[k] = (int)ni1[k]; e2[k] = (int)ni2[k]; q2[k] = (int)ni3[k]; g1[k] = __builtin_bit_cast(float, ni4[k]); g2[k] = __builtin_bit_cast(float, ni5[k]); } }
        v2u xw[2][4], ya[2][4], yb[2][4]; f32x4 gvv[2][4];
#pragma unroll
        for (int k = 0; k < 2; ++k) if (on[k]) {
            const int s1 = OFFS[__builtin_amdgcn_readfirstlane(e1[k])] + __builtin_amdgcn_readfirstlane(q1[k]), s2 = OFFS[__builtin_amdgcn_readfirstlane(e2[k])] + __builtin_amdgcn_readfirstlane(q2[k]);
            const bf16* y1 = Yb + (size_t)s1 * D, * y2 = Yb + (size_t)s2 * D; const bf16* xs = XBb + (size_t)rr[k] * D;
            const int bb = rr[k] < ML ? (rr[k] >> 13) : 4; const float* gf = MODb + (size_t)bb * (6 * D);
#pragma unroll
            for (int j = 0; j < 4; ++j) { const int col = 4 * F.lane + 256 * j; xw[k][j] = *(const v2u*)(xs + col); ya[k][j] = *(const v2u*)(y1 + col); yb[k][j] = *(const v2u*)(y2 + col); gvv[k][j] = *(const f32x4*)(gf + col); } }
        if (i0 + 2 * NWAVES < ROWS_PER_WG) CR_INFO(i0 + 2 * NWAVES);
#pragma unroll
        for (int k = 0; k < 2; ++k) if (on[k]) {
            bf16* xs = XBb + (size_t)rr[k] * D; const float ga = g1[k], gb = g2[k]; f32x4 xn[4];
#pragma unroll
            for (int j = 0; j < 4; ++j) { const f32x4 gv = gvv[k][j]; const v2u x = xw[k][j], a = ya[k][j], b = yb[k][j];
                const f32x4 xv = (f32x4){bflo(x.x), bfhi(x.x), bflo(x.y), bfhi(x.y)};
                f32x4 yy; yy.x = ga * bflo(a.x) + gb * bflo(b.x); yy.y = ga * bfhi(a.x) + gb * bfhi(b.x); yy.z = ga * bflo(a.y) + gb * bflo(b.y); yy.w = ga * bfhi(a.y) + gb * bfhi(b.y);
                xn[j] = xv + gv * yy; }
            if (latent_only) {
                float ss = 0.f;
#pragma unroll
                for (int j = 0; j < 4; ++j) ss += (xn[j].x * xn[j].x + xn[j].y * xn[j].y) + (xn[j].z * xn[j].z + xn[j].w * xn[j].w);
                const float rstd = 1.0f / sqrtf(wave_sum(ss) * (1.0f / D) + EPS); float* orow = (float*)F.out_g + (size_t)rr[k] * D;
#pragma unroll
                for (int j = 0; j < 4; ++j) *(f32x4*)(orow + 4 * F.lane + 256 * j) = xn[j] * rstd * gfin[j];
            } else {
#pragma unroll
                for (int j = 0; j < 4; ++j) { v2u o; o.x = pk2(xn[j].x, xn[j].y); o.y = pk2(xn[j].z, xn[j].w); *(v2u*)(xs + 4 * F.lane + 256 * j) = o; }
                if (nl >= 0) {
                    const int bb = rr[k] < ML ? (rr[k] >> 13) : 4;
                    if (bb != nbb) { nbb = bb; const float* gvec = INP(I_GMIX) + nl * D; const float* mp = F_MOD + ((size_t)nl * 5 + bb) * (6 * D);
#pragma unroll
                        for (int j = 0; j < 4; ++j) { const int col = 4 * F.lane + 256 * j; const f32x4 g = *(const f32x4*)(gvec + col), sh = *(const f32x4*)(mp + col), sc = *(const f32x4*)(mp + D + col); nmul[j] = g * (sc + 1.0f); nadd[j] = sh; } }
                    float ss = 0.f;
#pragma unroll
                    for (int j = 0; j < 4; ++j) ss += (xn[j].x * xn[j].x + xn[j].y * xn[j].y) + (xn[j].z * xn[j].z + xn[j].w * xn[j].w);
                    const float rstd = 1.0f / sqrtf(wave_sum(ss) * (1.0f / D) + EPS); bf16* hr = F_HN + (size_t)rr[k] * D;
#pragma unroll
                    for (int j = 0; j < 4; ++j) { const f32x4 hv = xn[j] * rstd * nmul[j] + nadd[j]; v2u o; o.x = pk2(hv.x, hv.y); o.y = pk2(hv.z, hv.w); *(v2u*)(hr + 4 * F.lane + 256 * j) = o; } } } }
    }
#undef CR_INFO
    asm volatile("s_waitcnt vmcnt(0)" ::: "memory");
    __syncthreads();
    if (F.tid == 0) { __builtin_amdgcn_fence(__ATOMIC_RELEASE, "agent"); __builtin_amdgcn_fence(__ATOMIC_ACQUIRE, "agent"); asm volatile("s_waitcnt vmcnt(0)" ::: "memory"); }
    __syncthreads();
}
#define DIAG 0
#ifndef TPROBE
#define TPROBE 0
#endif
#ifndef TP_MASK
#define TP_MASK 0x1FFF
#endif
#ifndef TP_SEL
#define TP_SEL 1
#endif
#ifndef TP_MUL
#define TP_MUL 4
#endif
constexpr int CW_TP = 3072;
__device__ __forceinline__ unsigned tp_now() { return (unsigned)__builtin_amdgcn_s_memrealtime(); }
__device__ __forceinline__ int tp_class(int ph) { if (ph == 0) return 0; const int q = ph - 1, l = q / 10, s_ = q - l * 10; if (l >= DEPTH) return 12; if (s_ <= 6) return 1 + s_; return (s_ == 8 ? 8 : 9) + 2 * (l & 1); }
__device__ __forceinline__ bool phase_enter(Frame& F) { int ln = (int)__builtin_amdgcn_mbcnt_hi(~0u, __builtin_amdgcn_mbcnt_lo(~0u, 0u)); asm volatile("" : "+v"(ln)); int wv = F.wave0; asm volatile("" : "+s"(wv));
    F.lane = ln; F.wave = wv; F.tid = wv * 64 + ln;     int bi_ = blockIdx.x; asm volatile("" : "+s"(bi_)); F.bid = bi_; GAS unsigned char* w = F.ws_g; asm volatile("" : "+s"(w)); F.ws_g = w; GAS float* o = F.out_g; asm volatile("" : "+s"(o)); F.out_g = o; return true; }
__device__ __forceinline__ bool phase_runs(int lo, int hi, int ph) { asm volatile("" : "+s"(ph)); return lo <= ph && ph < hi; }
constexpr int PH_PER_LAYER = 10, NPH = 1 + DEPTH * PH_PER_LAYER + 1;
__global__ void __launch_bounds__(NTHREADS, 2) fwd_kernel(Args args) {
    extern __shared__ __attribute__((aligned(16))) unsigned char lds_raw[];
    Frame F;
    F.lds = (LAS unsigned char*)0;
    if (args.ph_lo < -1) lds_raw[0] = 0;
    F.MISC = (volatile LAS unsigned*)(F.lds + MISC_OFF);
    F.tid = threadIdx.x; F.lane = F.tid & 63; F.wave = __builtin_amdgcn_readfirstlane(F.tid >> 6); F.wave0 = F.wave; F.bid = blockIdx.x; F.G = gridDim.x;
    F.out_g = (GAS float*)args.out; F.ws_g = (GAS unsigned char*)args.ws; unsigned char* ws = args.ws;
    F.ctl = (gu32*)(ws + WS_CTL);
    for (int u = F.tid; u < 64; u += NTHREADS) F.MISC[u] = 0u;
    if (F.tid == 0) { volatile LAS unsigned long long* tb = (volatile LAS unsigned long long*)(F.lds + INTAB_OFF);
#pragma unroll
        for (int i = 0; i < N_IN; ++i) tb[i] = (unsigned long long)args.in[i]; }
    __syncthreads();
#if MK_ONE_LAUNCH
    XcdBarrier bar = xcd_barrier_post((unsigned*)(F.ctl + CW_BAR), F.MISC + 8);
#define GRID_BAR() xcd_barrier(bar)
#else
#define GRID_BAR() do { if (F.tid == 0) __hip_atomic_store(F.ctl + CW_TMO, 0xBADBA0u, RLX_AGENT); } while (0)
#endif
    const int lo = args.ph_lo, hi = args.ph_hi;
    int ph = 0;
#if TPROBE
    if (F.tid == 0) F.MISC[15] = tp_now();
#endif
#define RUNS() (phase_runs(lo, hi, ph) && phase_enter(F))
#if TPROBE
#define SEAM() do { if (ph + 1 < hi) { const int c_ = tp_class(ph); __syncthreads(); if (F.tid == 0) { const unsigned n_ = tp_now(); F.MISC[16 + 2 * c_] += n_ - F.MISC[15]; F.MISC[14] = n_; } GRID_BAR(); \
    if (F.tid == 0) { const unsigned n_ = tp_now(); F.MISC[17 + 2 * c_] += n_ - F.MISC[14]; F.MISC[15] = n_; } } } while (0)
#else
#define SEAM() do { if (ph + 1 < hi) GRID_BAR(); } while (0)
#endif

    if (RUNS()) { p0_prologue(F);
#if REPEAT == 1
        GRID_BAR(); p0_prologue(F);
#endif
        SEAM(); } ++ph;
    for (int l = 0; l < DEPTH; ++l) {
        const bool first = (l == 0);
        const float* modl = F_MOD + (size_t)l * 5 * (6 * D);
        if (RUNS()) {
#if DIAG
            if (l == 2) { diag_comb_pre(F, 0, 1); }
            if (l == 0) {  }
#endif
            if (l == 2) combine_rows(F, 0, 1, false, 2);
            else n_phase<false>(F, l, 0, 0, first);
#if REPEAT == 2
            if (l != 2) { GRID_BAR(); n_phase<false>(F, l, 0, 0, first); }
#endif
#if REPEAT == 12
            if (l == 2) { GRID_BAR(); convert_moe_range(F, 1, 0, MOE_ITEMS, F.bid, F.G); }
#endif
#if DIAG
            if (l == 2) { __syncthreads(); diag_comb_post(F, false, 7); }
#endif

            SEAM(); } ++ph;
        if (RUNS()) {
#if FAST_GEMM & 1
            { pg8::ProbDense S; S.A = F_HN; S.Bt = F_WIN + (size_t)l * DIN * D; S.K = D; S.ord.init(M / 256, DIN / 256, F.G, F.bid, WGM_G1); pg8::EpiP E{F_P}; pg8::gemm_phase(F.lds, S, E, F.tid);
              if (l == 0) tail_convert(F, S.ord.nwg, 0, 0, TAIL0_A); else if (l == 1) tail_convert(F, S.ord.nwg, 0, TAIL0_B, TAIL0_END); else if (l == 2) tail_convert(F, S.ord.nwg, 1, TAIL1_A, TAIL1_B);
#if REPEAT == 6
              GRID_BAR(); pg8::gemm_phase(F.lds, S, E, F.tid);
#endif
            }
#else
            NG g{}; g.A = F_HN; g.lda = D; g.ridx = nullptr; g.nvalid = 0; g.arow0 = 0; g.Bt = F_WIN + (size_t)l * DIN * D; g.K = D; g.nrows = M; g.O = F_P; g.ldo = PW; g.orow0 = 0;
            g.ncols = 512; g.pcol0 = 0; g.pair = 0; g.mode = 0; g.ocol0 = 0; gemm_naive(F, g);
            g.pcol0 = 512; g.pair = 1; g.mode = 2; g.ocol0 = 512; gemm_naive(F, g);
            g.pcol0 = 1536; g.pair = 0; g.mode = 0; g.ocol0 = 1024; gemm_naive(F, g);
            g.pcol0 = 2048; g.pair = 0; g.mode = 1; g.ocol0 = 1536; gemm_naive(F, g);
#endif
            SEAM(); } ++ph;
        if (RUNS()) {
#if FAST_SCAN
            s1_phase(F, l);
#if REPEAT == 3
            GRID_BAR(); s1_phase(F, l);
#endif
#if REPEAT == 13
            GRID_BAR(); sa_mx(F, l);
#endif
#else
            sa_xr_conv(F, l); sa_mx(F, l);
#endif
            SEAM(); } ++ph;
        if (RUNS()) {
#if FAST_SCAN
            s2_carry(F); sa_mx(F, l);
#if REPEAT == 4
            GRID_BAR(); s2_carry(F);
#endif
#else
            sb_scan_naive(F, l);
#endif
            SEAM(); } ++ph;
        if (RUNS()) {
#if FAST_SCAN
            s3r_phase(F);
#if REPEAT == 5
            GRID_BAR(); s3r_phase(F);
#endif
#else
            sc_combine(F);
#endif
            SEAM(); } ++ph;
        if (RUNS()) {
#if FAST_GEMM & 2
            { pg8::ProbDense S; S.A = F_MIX; S.Bt = F_WOUT + (size_t)l * D * D; S.K = D; S.ord.init(ML / 256, D / 256, F.G, F.bid, WGM_G2);
              if (first) { pg8::EpiRes<true> E{INP(I_X), F_XB, modl + 2 * D}; pg8::gemm_phase(F.lds, S, E, F.tid); } else { pg8::EpiRes<false> E{nullptr, F_XB, modl + 2 * D}; pg8::gemm_phase(F.lds, S, E, F.tid); }
#if REPEAT == 20
              GRID_BAR(); { pg8::EpiRes<false> E{nullptr, F_XB, (const float*)(((unsigned char*)F.ws_g) + 128 * 1024)}; pg8::gemm_phase(F.lds, S, E, F.tid); }
#endif
            }
            if (l != DEPTH - 1) gemm_ctx_res(F, F_MIX, D, F_WOUT + (size_t)l * D * D, D, first, modl + 4 * (6 * D) + 2 * D);
#else
            NG g{}; g.A = F_MIX; g.lda = D; g.Bt = F_WOUT + (size_t)l * D * D; g.K = D; g.nrows = M; g.ncols = D; g.mode = 4; g.xl_src = xl_src; g.xc_src = xc_src; g.gate = modl + 2 * D;
            gemm_naive(F, g);
#endif
            SEAM(); } ++ph;
        if (RUNS()) { if (l & 1) n_phase<true>(F, l, 1, l >> 1, false); else { n_phase<false>(F, l, 1, 0, false); if (l == 2) convert_moe_range(F, 1, TAIL1_C, TAIL1_UP, F.bid, F.G);
#if REPEAT == 11
            GRID_BAR(); n_phase<false>(F, l, 1, 0, false);
#endif
            } SEAM(); } ++ph;
        if (RUNS()) { if ((l & 1) && !MOE_GATHER) {
            moe_dispatch(F, l >> 1);
#if REPEAT == 7
            GRID_BAR(); moe_dispatch(F, l >> 1);
#endif
            SEAM(); } } ++ph;
        if (RUNS()) {
#if DIAG
#endif
            if (!(l & 1)) {
#if FAST_GEMM & 4
                pg8::ProbDense S; S.A = F_HN; S.Bt = F_WDGU + (size_t)(l >> 1) * 2 * FD * D; S.K = D; S.ord.init(M / 256, 2 * FD / 256, F.G, F.bid, WGM_WIDE); pg8::EpiGLU E{F_HID, FD}; pg8::gemm_phase(F.lds, S, E, F.tid);
                if (l == 0) tail_convert(F, S.ord.nwg, 0, TAIL0_A, TAIL0_B); else tail_convert(F, S.ord.nwg, 1, TAIL1_B, TAIL1_C);
#if REPEAT == 8
                GRID_BAR(); pg8::gemm_phase(F.lds, S, E, F.tid);
#endif
#else
                NG g{}; g.A = F_HN; g.lda = D; g.Bt = F_WDGU + (size_t)(l >> 1) * 2 * FD * D; g.K = D; g.nrows = M; g.ncols = FD; g.pair = 1; g.mode = 3; g.O = F_HID; g.ldo = FD; gemm_naive(F, g);
#endif
            } else {
#if FAST_GEMM & 16
                LAS int* tab = (LAS int*)(F.lds + 131072 + 1024);
                moe_tab_build(F, l >> 1, tab);
                __syncthreads();
                pg8::ProbMoeT<(MOE_GATHER != 0)> S; S.A = MOE_GATHER ? F_HN : F_Y  ; S.Bt = F_WMGU; S.list = F_LIST; S.tab_ = tab; S.K = D; S.bt_rows = 2 * FM; S.up = (MOE_GATHER != 0); S.ord.init(__builtin_amdgcn_readfirstlane(tab[8]), 2 * FM / 256, F.G, F.bid, WGM_WIDE);
                pg8::EpiGLU E{F_HID, FM}; pg8::gemm_phase(F.lds, S, E, F.tid);
#if !(REPEAT == 9)
                tail_convert(F, S.ord.nwg, l >> 1, (l == 1) ? TAIL0_UP : TAIL1_UP, MOE_ITEMS);
#endif
#if REPEAT == 9
                GRID_BAR(); pg8::gemm_phase(F.lds, S, E, F.tid);
#endif
#else
                int off = 0;
                for (int e = 0; e < NE; ++e) { const int c = (int)__hip_atomic_load(F.ctl + CW_CNT + (l >> 1) * 512 + e * 64, RLX_AGENT); const int nr = (c + 255) & ~255;
                    NG g{}; g.A = F_HN; g.lda = D; g.ridx = F_LIST + (size_t)e * M; g.nvalid = c; g.Bt = F_WMGU + (size_t)e * 2 * FM * D; g.K = D; g.nrows = nr; g.ncols = FM; g.pair = 1; g.mode = 3; g.O = F_HID; g.ldo = FM; g.orow0 = off;
                    if (c > 0) gemm_naive(F, g); off += nr; }
#endif
            }
            SEAM(); } ++ph;
        if (RUNS()) {
            if (!(l & 1)) {
#if FAST_GEMM & 8
                pg8::ProbDense S; S.A = F_HID; S.Bt = F_WDD + (size_t)(l >> 1) * D * FD; S.K = FD; S.ord.init(ML / 256, D / 256, F.G, F.bid, WGM_G4); pg8::EpiRes<false> E{nullptr, F_XB, modl + 5 * D}; phase_enter(F); pg8::gemm_phase(F.lds, S, E, F.tid);
#if REPEAT == 21
                GRID_BAR(); { pg8::EpiRes<false> E2{nullptr, F_XB, (const float*)(((unsigned char*)F.ws_g) + 128 * 1024)}; pg8::gemm_phase(F.lds, S, E2, F.tid); }
#endif
                phase_enter(F); gemm_ctx_res(F, F_HID, FD, F_WDD + (size_t)(l >> 1) * D * FD, FD, false, modl + 4 * (6 * D) + 5 * D);
#else
                NG g{}; g.A = F_HID; g.lda = FD; g.Bt = F_WDD + (size_t)(l >> 1) * D * FD; g.K = FD; g.nrows = M; g.ncols = D; g.mode = 4; g.xl_src = ((float*)F.out_g); g.xc_src = F_XC; g.gate = modl + 5 * D; gemm_naive(F, g);
#endif
            } else {
#if FAST_GEMM & 32
                LAS int* tab = (LAS int*)(F.lds + 131072 + 1024);
                moe_tab_build(F, l >> 1, tab);
                __syncthreads();
                if (l == 1) {
                pg8::ProbMoeT<false> S; S.A = F_HID; S.Bt = F_WMD; S.list = F_LIST; S.tab_ = tab; S.K = FM; S.bt_rows = D; S.up = false; S.ord.init(__builtin_amdgcn_readfirstlane(tab[8]), D / 256, F.G, F.bid, WGM_DEEPK);
                pg8::EpiBf E{F_Y, D}; phase_enter(F); pg8::gemm_phase(F.lds, S, E, F.tid);
                tail_convert(F, S.ord.nwg, 1, 0, TAIL1_A);
                } else {
                pg8::ProbMoeSplit S; S.A = F_HID; S.Bt = F_WMD; S.list = F_LIST; S.tab_ = tab; S.K = FM; S.bt_rows = D; S.up = false; S.ord.init(__builtin_amdgcn_readfirstlane(tab[8]), D / 256, F.G, F.bid, WGM_DEEPK); S.init_split();
                pg8::EpiBfSplit E{F_Y, D, (float*)F_HN, (unsigned*)(F.ctl + CW_SPLIT)}; phase_enter(F); pg8::gemm_phase(F.lds, S, E, F.tid);
                }
#if REPEAT == 10
                GRID_BAR(); phase_enter(F); pg8::gemm_phase(F.lds, S, E, F.tid);
#endif
#else
                int off = 0;
                for (int e = 0; e < NE; ++e) { const int c = (int)__hip_atomic_load(F.ctl + CW_CNT + (l >> 1) * 512 + e * 64, RLX_AGENT); const int nr = (c + 255) & ~255;
                    NG g{}; g.A = F_HID; g.lda = FM; g.arow0 = off; g.Bt = F_WMD + (size_t)e * D * FM; g.K = FM; g.nrows = nr; g.ncols = D; g.mode = 0; g.O = F_Y; g.ldo = D; g.orow0 = off;
                    if (c > 0) gemm_naive(F, g); off += nr; }
#endif
            }
            SEAM(); } ++ph;
    }
    if (RUNS()) {
#if DIAG
        diag_comb_pre(F, 1, DEPTH - 1);
#endif
        combine_rows(F, 1, DEPTH - 1, true);
#if TPROBE
        __syncthreads();
        if (F.tid == 0) { const unsigned n_ = tp_now(); F.MISC[16 + 24] += n_ - F.MISC[15]; unsigned busy = 0, wait = 0;
            for (int c = 0; c < 13; ++c) if ((TP_MASK >> c) & 1) { busy += F.MISC[16 + 2 * c]; wait += F.MISC[17 + 2 * c]; }
            __hip_atomic_fetch_add(F.ctl + CW_TP, busy, RLX_AGENT); __hip_atomic_fetch_add(F.ctl + CW_TP + 64, wait, RLX_AGENT); }
        asm volatile("s_waitcnt vmcnt(0)" ::: "memory");
        GRID_BAR();
        if (F.tid == 0) { const unsigned bt = __hip_atomic_load(F.ctl + CW_TP, RLX_AGENT), wt = __hip_atomic_load(F.ctl + CW_TP + 64, RLX_AGENT);
            const unsigned q = (TP_SEL == 0 ? bt : TP_SEL == 1 ? wt : bt + wt) / 256u * TP_MUL; const unsigned t0 = tp_now(); while (tp_now() - t0 < q) __builtin_amdgcn_s_sleep(32); }
        __syncthreads();
#endif
#if DIAG
        __syncthreads();
        { const unsigned fs = __hip_atomic_load(F.ctl + CW_FLAG + 64, RLX_AGENT), fc = __hip_atomic_load(F.ctl + CW_FLAG + 128, RLX_AGENT); const unsigned fo = __hip_atomic_load(F.ctl + CW_FLAG + 192, RLX_AGENT); const unsigned tot = fs + fc + fo + 1u; const unsigned fl = (fs * 100u / tot) + 1000u * (fc * 100u / tot) + 1000000u * (fo * 100u / tot);     if (fl) { __syncthreads(); const float sc = 1.0f + (float)fl;
            for (int i = F.wave; i < ROWS_PER_WG; i += NWAVES) { const int r = F.bid * ROWS_PER_WG + i; if (r < ML) { for (int c = F.lane; c < D; c += 64) ((float*)F.out_g)[(size_t)r * D + c] *= sc; } } } }
#endif
    } ++ph;
}

extern "C" void kernel_launch(void* const* d_in, const int* in_sizes, int n_in, void* d_out, int out_size, void* d_ws, size_t ws_size, hipStream_t stream) {
    static int grid = 0;
    if (grid == 0) {
        if (n_in != N_IN || in_sizes[0] != ML * D || out_size != ML * D || ws_size < WS_END) { fprintf(stderr, "kernel_launch: unexpected shapes (n_in %d, in0 %d, out %d, ws %zu)\n", n_in, n_in > 0 ? in_sizes[0] : -1, out_size, ws_size); grid = -1; return; }
        int dev = 0, cus = 0, per_cu = 0;
        if (hipGetDevice(&dev) != hipSuccess || hipDeviceGetAttribute(&cus, hipDeviceAttributeMultiprocessorCount, dev) != hipSuccess) { grid = -1; return; }
        if (hipFuncSetAttribute((const void*)fwd_kernel, hipFuncAttributeMaxDynamicSharedMemorySize, LDS_BYTES) != hipSuccess) { fprintf(stderr, "kernel_launch: hipFuncSetAttribute failed\n"); grid = -1; return; }
        if (hipOccupancyMaxActiveBlocksPerMultiprocessor(&per_cu, (const void*)fwd_kernel, NTHREADS, LDS_BYTES) != hipSuccess || per_cu < 1) fprintf(stderr, "kernel_launch: occupancy query reports %d\n", per_cu);
        (void)hipGetLastError();
        grid = cus;
        if (grid != 256) { fprintf(stderr, "kernel_launch: built for 256 CUs, device has %d\n", cus); grid = -1; return; }
    }
    if (grid < 0) return;
    (void)hipMemsetAsync((char*)d_ws + WS_CTL, 0, CTL_ZERO_BYTES, stream);
    Args a{};
    for (int i = 0; i < N_IN; ++i) a.in[i] = (const float*)d_in[i];
    a.out = (float*)d_out; a.ws = (unsigned char*)d_ws;
#if MK_ONE_LAUNCH
    a.ph_lo = 0; a.ph_hi = NPH;
    hipLaunchKernelGGL(fwd_kernel, dim3(grid), dim3(NTHREADS), LDS_BYTES, stream, a);
#else
    for (int p = 0; p < NPH; ++p) { a.ph_lo = p; a.ph_hi = p + 1; hipLaunchKernelGGL(fwd_kernel, dim3(grid), dim3(NTHREADS), LDS_BYTES, stream, a); }
#endif
}
```
